# Optimizing an MI355X kernel written in HIP

```python
import math
import jax, jax.numpy as jnp
from jax import lax
import numpy as np

D_MODEL = 2048
BATCH = 16
SEQ = 2048
DEPTH = 1
DEC_BATCH = 8
DEC_SEQ = 64
PAST_LEN = 1024

CHUNK = 64
Q_BLOCK = 128
N_MEM = 256
EPS = 1e-6
SSD_D_INNER = D_MODEL
SSD_HEAD_DIM = 64
SSD_HEADS = SSD_D_INNER // SSD_HEAD_DIM
SSD_GROUPS = 4
SSD_D_STATE = 128
SSD_CONV = 4
SSD_CONV_CH = SSD_D_INNER + 2 * SSD_GROUPS * SSD_D_STATE
FOX_HEADS = 16
FOX_HEAD_DIM = 128
FOX_WIDTH = FOX_HEADS * FOX_HEAD_DIM
FORGET_BIAS_INIT = 3.0
MEM_HEADS = 4
MEM_HEAD_DIM = 512
MEM_WIDTH = MEM_HEADS * MEM_HEAD_DIM
SIZES = [SSD_D_INNER, SSD_CONV_CH, SSD_HEADS, FOX_WIDTH, FOX_WIDTH, FOX_WIDTH, FOX_WIDTH, FOX_HEADS,
         MEM_WIDTH, MEM_WIDTH, D_MODEL, D_MODEL, D_MODEL]
IN_WIDTH = sum(SIZES)
SPLITS = [int(v) for v in np.cumsum(SIZES)[:-1]]

kernel_name = 'hybrid_ssd_fox_mem_stream_step'


def rmsnorm(x, g):
    xf = x.astype(jnp.float32)
    y = xf * lax.rsqrt(jnp.mean(xf * xf, axis=-1, keepdims=True) + EPS)
    return (y * g.astype(jnp.float32)).astype(x.dtype)


def causal_conv(x_pad, w, b):
    T = x_pad.shape[1] - (SSD_CONV - 1)
    out = b
    for i in range(SSD_CONV):
        out = out + x_pad[:, i:i + T] * w[i]
    return out


def ssd_scan(x, dt, A, Bm, Cm, h0, chunk):
    f32 = jnp.float32
    b, T, H, P = x.shape
    G, N = Bm.shape[2], Bm.shape[3]
    J = H // G
    nc = T // chunk
    xc = x.astype(f32).reshape(b, nc, chunk, G, J, P)
    Bc = Bm.astype(f32).reshape(b, nc, chunk, G, N)
    Cc = Cm.astype(f32).reshape(b, nc, chunk, G, N)
    dtc = dt.reshape(b, nc, chunk, G, J)
    acum = jnp.cumsum(dtc * A.reshape(G, J), axis=2)
    tri = (jnp.arange(chunk)[:, None] >= jnp.arange(chunk)[None, :])[:, :, None, None]
    diff = acum[:, :, :, None] - acum[:, :, None]
    ldec = jnp.exp(jnp.where(tri, diff, -jnp.inf))
    cb = jnp.einsum('bclgn,bcsgn->bclsg', Cc, Bc)
    m = cb[..., None] * ldec * dtc[:, :, None]
    y_diag = jnp.einsum('bclsgj,bcsgjp->bclgjp', m, xc)
    w_end = jnp.exp(acum[:, :, -1:] - acum) * dtc
    states = jnp.einsum('bcsgn,bcsgjp->bcgjpn', Bc, xc * w_end[..., None])
    chunk_dec = jnp.exp(acum[:, :, -1])

    def step(h, inp):
        dec, st = inp
        return h * dec[..., None, None] + st, h

    h_init = h0.astype(f32).reshape(b, G, J, P, N)
    h_final, h_in = lax.scan(step, h_init, (jnp.moveaxis(chunk_dec, 1, 0), jnp.moveaxis(states, 1, 0)))
    h_in = jnp.moveaxis(h_in, 0, 1)
    y_off = jnp.einsum('bclgn,bcgjpn->bclgjp', Cc, h_in) * jnp.exp(acum)[..., None]
    y = (y_diag + y_off).reshape(b, T, H, P)
    return y, h_final.reshape(b, H, P, N)


def fox_attend(q, k, v, cq, ck, q_pos, k_pos):
    s = jnp.einsum('bqhd,bkhd->bhqk', q, k).astype(jnp.float32) * (FOX_HEAD_DIM ** -0.5)
    s = s + jnp.transpose(cq, (0, 2, 1))[..., None] - jnp.transpose(ck, (0, 2, 1))[:, :, None, :]
    mask = k_pos[None, :] <= q_pos[:, None]
    p = jax.nn.softmax(jnp.where(mask, s, -jnp.inf), axis=-1).astype(v.dtype)
    return jnp.einsum('bhqk,bkhd->bqhd', p, v)


def mem_kv(mem, g_mem, w_mem_kv):
    b = mem.shape[0]
    kv = rmsnorm(mem, g_mem) @ w_mem_kv
    k, v = jnp.split(kv, [MEM_WIDTH], axis=-1)
    return (k.reshape(b, N_MEM, MEM_HEADS, MEM_HEAD_DIM), v.reshape(b, N_MEM, MEM_HEADS, MEM_HEAD_DIM))


def mem_attend(q, k, v):
    s = jnp.einsum('bqhd,bkhd->bhqk', q, k).astype(jnp.float32) * (MEM_HEAD_DIM ** -0.5)
    p = jax.nn.softmax(s, axis=-1).astype(v.dtype)
    return jnp.einsum('bhqk,bkhd->bqhd', p, v)


def mixer_layer(x, conv_buf, h0, k_past, v_past, logf_past, mem_k, mem_v,
                g_norm, w_in, w_conv, b_conv, dt_bias, a_log, d_skip, g_ssd_out, b_forget,
                w_o_ssd, w_o_fox, w_o_mem, w_out, ssd_chunk, q_block):
    f32 = jnp.float32
    b, T, _ = x.shape
    P = k_past.shape[1]
    h = rmsnorm(x, g_norm)
    u = h @ w_in
    z, xbc, dt_raw, fq, fk, fv, fg, ff, mq, mg, gs, gf, gm = jnp.split(u, SPLITS, axis=-1)

    xbc_pad = jnp.concatenate([conv_buf.astype(xbc.dtype), xbc], axis=1)
    new_conv = xbc_pad[:, -(SSD_CONV - 1):]
    xbc_c = jax.nn.silu(causal_conv(xbc_pad, w_conv, b_conv))
    xs, Bm, Cm = jnp.split(xbc_c, [SSD_D_INNER, SSD_D_INNER + SSD_GROUPS * SSD_D_STATE], axis=-1)
    dt = jax.nn.softplus(dt_raw.astype(f32) + dt_bias.astype(f32))
    A = -jnp.exp(a_log.astype(f32))
    xh = xs.reshape(b, T, SSD_HEADS, SSD_HEAD_DIM)
    y, h_final = ssd_scan(xh, dt, A, Bm.reshape(b, T, SSD_GROUPS, SSD_D_STATE),
                          Cm.reshape(b, T, SSD_GROUPS, SSD_D_STATE), h0, ssd_chunk)
    y = (y + d_skip.astype(f32)[:, None] * xh.astype(f32)).reshape(b, T, SSD_D_INNER).astype(x.dtype)
    y_ssd = rmsnorm(y * jax.nn.silu(z), g_ssd_out)

    q = fq.reshape(b, T, FOX_HEADS, FOX_HEAD_DIM)
    k_new = fk.reshape(b, T, FOX_HEADS, FOX_HEAD_DIM)
    v_new = fv.reshape(b, T, FOX_HEADS, FOX_HEAD_DIM)
    logf_new = jax.nn.log_sigmoid(ff.astype(f32) + b_forget.astype(f32))
    k_all = jnp.concatenate([k_past.astype(k_new.dtype), k_new], axis=1)
    v_all = jnp.concatenate([v_past.astype(v_new.dtype), v_new], axis=1)
    c_all = jnp.cumsum(jnp.concatenate([logf_past.astype(f32), logf_new], axis=1), axis=1)
    k_pos = jnp.arange(P + T)
    q_pos = P + jnp.arange(T)
    cq = c_all[:, P:]
    if q_block is None:
        o = fox_attend(q, k_all, v_all, cq, c_all, q_pos, k_pos)
    else:
        nb = T // q_block
        qb = q.reshape(b, nb, q_block, FOX_HEADS, FOX_HEAD_DIM).transpose(1, 0, 2, 3, 4)
        cqb = cq.reshape(b, nb, q_block, FOX_HEADS).transpose(1, 0, 2, 3)
        pb = q_pos.reshape(nb, q_block)
        o = lax.map(lambda a: fox_attend(a[0], k_all, v_all, a[1], c_all, a[2], k_pos), (qb, cqb, pb))
        o = o.transpose(1, 0, 2, 3, 4)
    y_fox = o.reshape(b, T, FOX_WIDTH) * jax.nn.silu(fg)

    om = mem_attend(mq.reshape(b, T, MEM_HEADS, MEM_HEAD_DIM), mem_k.astype(mq.dtype), mem_v.astype(mq.dtype))
    y_mem = om.reshape(b, T, MEM_WIDTH) * jax.nn.silu(mg)

    merged = (jax.nn.sigmoid(gs) * (y_ssd @ w_o_ssd) + jax.nn.sigmoid(gf) * (y_fox @ w_o_fox)
              + jax.nn.sigmoid(gm) * (y_mem @ w_o_mem))
    x_out = x + merged @ w_out
    return x_out, new_conv, h_final, k_new, v_new, logf_new


def setup_inputs(seed: int = 0) -> dict:
    key = jax.random.key(seed)
    ks = jax.random.split(key, 32)
    f32 = jnp.float32

    def nrm(k, shape, scale):
        return jax.random.normal(k, shape, f32) * scale

    L = DEPTH
    dt0 = jnp.exp(jax.random.uniform(ks[14], (L, SSD_HEADS), f32, math.log(1e-3), math.log(1e-1)))
    return {
        'x_prompt': nrm(ks[0], (BATCH, SEQ, D_MODEL), 1.0),
        'x_sample': nrm(ks[1], (DEC_BATCH, DEC_SEQ, D_MODEL), 1.0),
        'mem_prompt': nrm(ks[2], (BATCH, N_MEM, D_MODEL), 1.0),
        'cache_fox_k': nrm(ks[3], (L, DEC_BATCH, PAST_LEN, FOX_HEADS, FOX_HEAD_DIM), 1.0),
        'cache_fox_v': nrm(ks[4], (L, DEC_BATCH, PAST_LEN, FOX_HEADS, FOX_HEAD_DIM), 1.0),
        'cache_fox_logf': jax.nn.log_sigmoid(FORGET_BIAS_INIT + nrm(ks[5], (L, DEC_BATCH, PAST_LEN, FOX_HEADS), 1.0)),
        'state_ssd': nrm(ks[6], (L, DEC_BATCH, SSD_HEADS, SSD_HEAD_DIM, SSD_D_STATE), 0.1),
        'state_ssd_conv': nrm(ks[7], (L, DEC_BATCH, SSD_CONV - 1, SSD_CONV_CH), 1.0),
        'cache_mem_k': nrm(ks[8], (L, DEC_BATCH, N_MEM, MEM_HEADS, MEM_HEAD_DIM), 1.0),
        'cache_mem_v': nrm(ks[9], (L, DEC_BATCH, N_MEM, MEM_HEADS, MEM_HEAD_DIM), 1.0),
        'g_norm': 1.0 + nrm(ks[10], (L, D_MODEL), 0.01),
        'w_in': nrm(ks[11], (L, D_MODEL, IN_WIDTH), D_MODEL ** -0.5),
        'w_conv': nrm(ks[12], (L, SSD_CONV, SSD_CONV_CH), SSD_CONV ** -0.5),
        'b_conv': nrm(ks[13], (L, SSD_CONV_CH), 0.01),
        'dt_bias': dt0 + jnp.log(-jnp.expm1(-dt0)),
        'a_log': jnp.log(jax.random.uniform(ks[15], (L, SSD_HEADS), f32, 1.0, 16.0)),
        'd_skip': 1.0 + nrm(ks[16], (L, SSD_HEADS), 0.01),
        'g_ssd_out': 1.0 + nrm(ks[17], (L, SSD_D_INNER), 0.01),
        'b_forget': FORGET_BIAS_INIT + nrm(ks[18], (L, FOX_HEADS), 0.5),
        'g_mem': 1.0 + nrm(ks[19], (L, D_MODEL), 0.01),
        'w_mem_kv': nrm(ks[20], (L, D_MODEL, 2 * MEM_WIDTH), D_MODEL ** -0.5),
        'w_o_ssd': nrm(ks[21], (L, SSD_D_INNER, D_MODEL), SSD_D_INNER ** -0.5),
        'w_o_fox': nrm(ks[22], (L, FOX_WIDTH, D_MODEL), FOX_WIDTH ** -0.5),
        'w_o_mem': nrm(ks[23], (L, MEM_WIDTH, D_MODEL), MEM_WIDTH ** -0.5),
        'w_out': nrm(ks[24], (L, D_MODEL, D_MODEL), D_MODEL ** -0.5),
        'g_final': 1.0 + nrm(ks[25], (D_MODEL,), 0.01),
    }


def reference(x_prompt, x_sample, mem_prompt, cache_fox_k, cache_fox_v, cache_fox_logf, state_ssd,
              state_ssd_conv, cache_mem_k, cache_mem_v, g_norm, w_in, w_conv, b_conv, dt_bias, a_log,
              d_skip, g_ssd_out, b_forget, g_mem, w_mem_kv, w_o_ssd, w_o_fox, w_o_mem, w_out, g_final):
    f32 = jnp.float32
    xp, xs = x_prompt, x_sample
    bp = xp.shape[0]
    fk_p, fv_p, fl_p, ssd_p, conv_p, mk_p, mv_p = [], [], [], [], [], [], []
    fk_s, fv_s, fl_s, ssd_s, conv_s = [], [], [], [], []
    for l in range(DEPTH):
        lw = (g_norm[l], w_in[l], w_conv[l], b_conv[l], dt_bias[l], a_log[l], d_skip[l], g_ssd_out[l],
              b_forget[l], w_o_ssd[l], w_o_fox[l], w_o_mem[l], w_out[l])
        mk, mv = mem_kv(mem_prompt, g_mem[l], w_mem_kv[l])
        xp, c_new, h_new, k_new, v_new, lf_new = mixer_layer(
            xp, jnp.zeros((bp, SSD_CONV - 1, SSD_CONV_CH), xp.dtype),
            jnp.zeros((bp, SSD_HEADS, SSD_HEAD_DIM, SSD_D_STATE), f32),
            jnp.zeros((bp, 0, FOX_HEADS, FOX_HEAD_DIM), xp.dtype),
            jnp.zeros((bp, 0, FOX_HEADS, FOX_HEAD_DIM), xp.dtype),
            jnp.zeros((bp, 0, FOX_HEADS), f32), mk, mv, *lw, CHUNK, Q_BLOCK)
        fk_p.append(k_new); fv_p.append(v_new); fl_p.append(lf_new)
        ssd_p.append(h_new); conv_p.append(c_new); mk_p.append(mk); mv_p.append(mv)
        xs, c_new, h_new, k_new, v_new, lf_new = mixer_layer(
            xs, state_ssd_conv[l], state_ssd[l], cache_fox_k[l], cache_fox_v[l], cache_fox_logf[l],
            cache_mem_k[l], cache_mem_v[l], *lw, xs.shape[1], None)
        fk_s.append(k_new); fv_s.append(v_new); fl_s.append(lf_new)
        ssd_s.append(h_new); conv_s.append(c_new)
    y_prompt = rmsnorm(xp, g_final)
    y_sample = rmsnorm(xs, g_final)
    return (y_prompt, y_sample,
            jnp.stack(fk_p), jnp.stack(fv_p), jnp.stack(fl_p), jnp.stack(ssd_p), jnp.stack(conv_p),
            jnp.stack(mk_p), jnp.stack(mv_p),
            jnp.stack(fk_s), jnp.stack(fv_s), jnp.stack(fl_s), jnp.stack(ssd_s), jnp.stack(conv_s))
```

```cpp
#include <hip/hip_runtime.h>
#include <hip/hip_cooperative_groups.h>
#include <cstdio>
#include <cstdint>
namespace cg = cooperative_groups;

#define LAS __attribute__((address_space(3)))
#define DI __device__ __forceinline__
typedef unsigned short bf16_t;
typedef short bf16x8 __attribute__((ext_vector_type(8)));
typedef short s16x4 __attribute__((ext_vector_type(4)));
typedef float f32x4 __attribute__((ext_vector_type(4)));
typedef float f32x16 __attribute__((ext_vector_type(16)));
typedef unsigned u32x4 __attribute__((ext_vector_type(4)));
typedef unsigned u32x2 __attribute__((ext_vector_type(2)));

constexpr int DM = 2048;
constexpr int MP = 32768, MS = 512, MT = MP + MS, MPADR = MT + 256;
constexpr int NIN = 23808;
constexpr int LDS_BYTES = 147456;
constexpr float EPS = 1e-6f;

constexpr long O_YP = 0;
constexpr long O_YS = 67108864L;
constexpr long O_FKP = O_YS + 1048576L;
constexpr long O_FVP = O_FKP + 67108864L;
constexpr long O_FLP = O_FVP + 67108864L;
constexpr long O_SSDP = O_FLP + 524288L;
constexpr long O_CONVP = O_SSDP + 4194304L;
constexpr long O_MKP = O_CONVP + 147456L;
constexpr long O_MVP = O_MKP + 8388608L;
constexpr long O_FKS = O_MVP + 8388608L;
constexpr long O_FVS = O_FKS + 1048576L;
constexpr long O_FLS = O_FVS + 1048576L;
constexpr long O_SSDS = O_FLS + 8192L;
constexpr long O_CONVS = O_SSDS + 2097152L;

constexpr size_t al256(size_t x) { return (x + 255) & ~(size_t)255; }
constexpr size_t W_CTL = 0;
constexpr size_t W_R1 = 4096;
constexpr size_t W_RM = al256(W_R1 + (size_t)MT * 4);
constexpr size_t W_RS = al256(W_RM + 4096 * 4);
constexpr size_t W_XB = al256(W_RS + (size_t)MT * 4);
constexpr size_t W_MB = al256(W_XB + (size_t)MT * DM * 2);
constexpr size_t W_WIN = al256(W_MB + (size_t)4096 * DM * 2);
constexpr size_t W_WMEM = al256(W_WIN + (size_t)NIN * DM * 2);
constexpr size_t W_WO = al256(W_WMEM + (size_t)4096 * DM * 2);
constexpr size_t W_WOUT = al256(W_WO + (size_t)2048 * 6144 * 2);
constexpr size_t W_ZB = al256(W_WOUT + (size_t)2048 * 2048 * 2);
constexpr size_t W_XBCP = al256(W_ZB + (size_t)MT * DM * 2);
constexpr size_t W_XBCS = al256(W_XBCP + (size_t)16 * 2051 * 3072 * 2);
constexpr size_t W_DT = al256(W_XBCS + (size_t)8 * 67 * 3072 * 2);
constexpr size_t W_FQ = al256(W_DT + (size_t)MT * 32 * 4);
constexpr size_t W_FK = al256(W_FQ + (size_t)MPADR * DM * 2);
constexpr size_t W_FV = al256(W_FK + (size_t)MP * DM * 2);
constexpr size_t W_KS = al256(W_FV + (size_t)MP * DM * 2);
constexpr size_t W_VS = al256(W_KS + (size_t)8 * 1088 * DM * 2);
constexpr size_t W_FG = al256(W_VS + (size_t)8 * 1088 * DM * 2);
constexpr size_t W_MQ = al256(W_FG + (size_t)MPADR * DM * 2);
constexpr size_t W_MG = al256(W_MQ + (size_t)MPADR * DM * 2);
constexpr size_t W_G3 = al256(W_MG + (size_t)MT * DM * 2);
constexpr size_t W_LFT = al256(W_G3 + (size_t)MT * 6144 * 2);
constexpr size_t W_LFS = al256(W_LFT + (size_t)256 * 2048 * 4);
constexpr size_t W_MKP = al256(W_LFS + (size_t)128 * 1088 * 4);
constexpr size_t W_VTP = al256(W_MKP + (size_t)4096 * DM * 2);
constexpr size_t W_MKS = al256(W_VTP + (size_t)4096 * DM * 2);
constexpr size_t W_VTS = al256(W_MKS + (size_t)2048 * DM * 2);
constexpr size_t W_PM = al256(W_VTS + (size_t)2048 * DM * 2);
constexpr size_t W_PSUM = al256(W_PM + (size_t)MPADR * 1024 * 2);
constexpr size_t W_Y3 = al256(W_PSUM + (size_t)MT * 16 * 4);
constexpr size_t W_SSQP = al256(W_Y3 + (size_t)MT * 6144 * 2);
constexpr size_t W_MRG = al256(W_SSQP + (size_t)MT * 32 * 4);
constexpr size_t W_PARTO = al256(W_MRG + (size_t)MT * DM * 2);
constexpr size_t W_TMP = al256(W_PARTO + (size_t)MT * 32 * 4);
constexpr size_t W_END = al256(W_TMP + (size_t)MT * DM * 4);

struct Params { const float* in[26]; float* out; unsigned char* ws; };

DI unsigned pk2(float lo, float hi) { unsigned r; asm volatile("v_cvt_pk_bf16_f32 %0, %1, %2" : "=v"(r) : "v"(lo), "v"(hi)); return r; }
DI float bf2f(unsigned short b) { return __uint_as_float(((unsigned)b) << 16); }
DI float bflo(unsigned w) { return __uint_as_float(w << 16); }
DI float bfhi(unsigned w) { return __uint_as_float(w & 0xffff0000u); }
DI float sigmoidf_(float x) { return 1.f / (1.f + __expf(-x)); }
DI float siluf_(float x) { return x / (1.f + __expf(-x)); }
DI float softplusf_(float x) { return x > 20.f ? x : log1pf(__expf(x)); }
DI float wave_sum(float v) {
#pragma unroll
  for (int o = 1; o < 64; o <<= 1) v += __shfl_xor(v, o);
  return v;
}
DI bf16x8 pack8(f32x4 a, f32x4 b) {
  u32x4 w = {pk2(a[0], a[1]), pk2(a[2], a[3]), pk2(b[0], b[1]), pk2(b[2], b[3])};
  return __builtin_bit_cast(bf16x8, w);
}
DI bf16x8 cat8(u32x2 lo, u32x2 hi) { u32x4 w = {lo[0], lo[1], hi[0], hi[1]}; return __builtin_bit_cast(bf16x8, w); }
#define MFMA16(a, b, c) __builtin_amdgcn_mfma_f32_16x16x32_bf16((a), (b), (c), 0, 0, 0)

namespace pg8 {
constexpr int BM = 256, BK = 64, HALF = 128, HTB = HALF * BK * 2, STAGE_BYTES = 8 * HTB, NXCD = 8, WGM = 8;
DI int lds_byte(int r, int c) { const int st = (r >> 4) * 2 + (c >> 5), rr = r & 15, cc = c & 31, ob = rr * 64 + cc * 2; return st * 1024 + (ob ^ (((ob >> 9) & 1) << 5)); }
DI void stage_rc(int b, int& R, int& C) { const int st = b / 1024, sb = b % 1024, swz = sb ^ (((sb >> 9) & 1) << 5); R = (st >> 1) * 16 + swz / 64; C = (st & 1) * 32 + (swz % 64) / 2; }

struct Unit { const char* A; const char* B; int row0, col0, kind, nvalid, aux; };
struct Gemm { int lda, ldb, K; };

DI void tile_order(int L, int nM, int nN, int& pm, int& pn) {
  const int nwg = nM * nN; int wgid = L;
  { const int q = nwg / NXCD, r = nwg % NXCD, xcd = wgid % NXCD, off = wgid / NXCD; wgid = (xcd < r ? xcd * (q + 1) : r * (q + 1) + (xcd - r) * q) + off; }
  const int nig = WGM * nN, gid = wgid / nig, fm = gid * WGM, gsz = (nM - fm) < WGM ? (nM - fm) : WGM;
  pm = fm + ((wgid % nig) % gsz); pn = (wgid % nig) / gsz;
}

template <class Epi, class Sched>
DI void gemm_phase(LAS unsigned char* lds, const Gemm g, const Sched& S, const Epi& E) {
  int tid = threadIdx.x; asm volatile("" : "+v"(tid));
  const int wid = __builtin_amdgcn_readfirstlane(tid >> 6), lane = tid & 63, wr = wid >> 2, wc = wid & 3, fr = lane & 15, fq = lane >> 4;
  int K = g.K; asm volatile("" : "+s"(K));
  const int nt = K / BK;
  unsigned voffA[2], voffB[2];
#pragma unroll
  for (int i = 0; i < 2; ++i) { int R, C; stage_rc(tid * 16 + i * 8192, R, C);
    voffA[i] = (unsigned)(R * g.lda + C) * 2u; voffB[i] = (unsigned)(R * g.ldb + C) * 2u; }
  const size_t kstep = (size_t)(BK * 2);
  const size_t hstepA = (size_t)HALF * g.lda * 2, hstepB = (size_t)HALF * g.ldb * 2;
  const unsigned ldsw = (unsigned)wid * 1024u;
  const int aoff = lds_byte(wr * 64 + fr, fq * 8), boff = lds_byte(wc * 32 + fr, fq * 8);
#define PG8_SA(b, h) (((b) * 2 + (h)) * HTB)
#define PG8_SB(b, h) ((4 + (b) * 2 + (h)) * HTB)
#define PG8_STAGE(bufoff, gbase, voff) do { _Pragma("unroll") for (int _i = 0; _i < 2; ++_i) \
        __builtin_amdgcn_global_load_lds((const unsigned*)((const char*)(gbase) + (voff)[_i]), (LAS unsigned*)(lds + (bufoff) + ldsw + _i * 8192), 16, 0, 0); } while (0)
#define PG8_LDA(dst, b, h) do { _Pragma("unroll") for (int m = 0; m < 4; ++m) _Pragma("unroll") for (int k = 0; k < 2; ++k) dst[m][k] = *(const LAS bf16x8*)(lds + PG8_SA(b, h) + aoff + m * 2048 + k * 1024); } while (0)
#define PG8_LDB(dst, b, h) do { _Pragma("unroll") for (int n = 0; n < 2; ++n) _Pragma("unroll") for (int k = 0; k < 2; ++k) dst[n][k] = *(const LAS bf16x8*)(lds + PG8_SB(b, h) + boff + n * 2048 + k * 1024); } while (0)
#define PG8_MMA(ai, bj, At, Bt) do { __builtin_amdgcn_s_setprio(1); _Pragma("unroll") for (int m = 0; m < 4; ++m) _Pragma("unroll") for (int n = 0; n < 2; ++n) _Pragma("unroll") for (int k = 0; k < 2; ++k) \
        acc[ai][bj][m][n] = __builtin_amdgcn_mfma_f32_16x16x32_bf16(Bt[n][k], At[m][k], acc[ai][bj][m][n], 0, 0, 0); __builtin_amdgcn_s_setprio(0); } while (0)
#define PG8_WAIT_V(n) asm volatile("s_waitcnt vmcnt(" #n ")" ::: "memory")
#define PG8_WAIT_L(n) asm volatile("s_waitcnt lgkmcnt(" #n ")" ::: "memory")
#define PG8_BAR __builtin_amdgcn_s_barrier()
#define PG8_SCHED __builtin_amdgcn_sched_barrier(0)
  Unit cur, nxt; int ui = 0;
  if (!S.next(0, cur)) return;
  f32x4 acc[2][2][4][2];
#pragma unroll
  for (int a = 0; a < 2; ++a)
#pragma unroll
    for (int b = 0; b < 2; ++b)
#pragma unroll
      for (int m = 0; m < 4; ++m)
#pragma unroll
        for (int n = 0; n < 2; ++n) acc[a][b][m][n] = (f32x4){0.f, 0.f, 0.f, 0.f};
  bf16x8 At[4][2], B0[2][2], B1[2][2];
  const char* cA = cur.A; const char* cB = cur.B;
  PG8_STAGE(PG8_SB(0, 0), cB, voffB); PG8_STAGE(PG8_SA(0, 0), cA, voffA); PG8_STAGE(PG8_SB(0, 1), cB + hstepB, voffB); PG8_STAGE(PG8_SA(0, 1), cA + hstepA, voffA);
  if (wr == 1) PG8_BAR;
  PG8_WAIT_V(4); PG8_BAR;
  PG8_STAGE(PG8_SB(1, 0), cB + kstep, voffB); PG8_STAGE(PG8_SA(1, 0), cA + kstep, voffA); PG8_STAGE(PG8_SB(1, 1), cB + hstepB + kstep, voffB);
  PG8_WAIT_V(6); PG8_BAR;
  for (;;) {
    const bool has_next = S.next(ui + 1, nxt);
    const char* nA = has_next ? nxt.A : cA; const char* nB = has_next ? nxt.B : cB;
    for (int t = 0; t < nt; t += 2) {
      const bool last = (t == nt - 2);
      if constexpr (Epi::HOOK) { if (t == 32 || t == 64) E.rescale(acc, cur, t >> 5, wr, wc, fr, fq); }
      const char* a1 = cA + (size_t)(t + 1) * kstep;
      const char* a2 = last ? nA : cA + (size_t)(t + 2) * kstep; const char* b2 = last ? nB : cB + (size_t)(t + 2) * kstep;
      const char* a3 = a2 + kstep; const char* b3 = b2 + kstep;
      PG8_LDB(B0, 0, 0); PG8_SCHED; PG8_LDA(At, 0, 0); PG8_STAGE(PG8_SA(1, 1), a1 + hstepA, voffA);
      PG8_WAIT_L(8); PG8_BAR; PG8_WAIT_L(0); PG8_MMA(0, 0, At, B0); PG8_BAR; PG8_SCHED;
      PG8_LDB(B1, 0, 1); PG8_STAGE(PG8_SB(0, 0), b2, voffB);
      PG8_BAR; PG8_WAIT_L(0); PG8_MMA(0, 1, At, B1); PG8_BAR;
      PG8_LDA(At, 0, 1); PG8_STAGE(PG8_SA(0, 0), a2, voffA);
      PG8_BAR; PG8_WAIT_L(0); PG8_MMA(1, 0, At, B0); PG8_BAR; PG8_SCHED;
      PG8_STAGE(PG8_SB(0, 1), b2 + hstepB, voffB);
      PG8_WAIT_V(6); PG8_BAR; PG8_MMA(1, 1, At, B1); PG8_BAR;
      PG8_LDB(B0, 1, 0); PG8_SCHED; PG8_LDA(At, 1, 0); PG8_STAGE(PG8_SA(0, 1), a2 + hstepA, voffA);
      PG8_WAIT_L(8); PG8_BAR; PG8_WAIT_L(0); PG8_MMA(0, 0, At, B0); PG8_BAR; PG8_SCHED;
      PG8_LDB(B1, 1, 1); PG8_STAGE(PG8_SB(1, 0), b3, voffB);
      PG8_BAR; PG8_WAIT_L(0); PG8_MMA(0, 1, At, B1); PG8_BAR;
      PG8_LDA(At, 1, 1); PG8_STAGE(PG8_SA(1, 0), a3, voffA);
      PG8_BAR; PG8_WAIT_L(0); PG8_MMA(1, 0, At, B0); PG8_BAR; PG8_SCHED;
      PG8_STAGE(PG8_SB(1, 1), b3 + hstepB, voffB);
      PG8_WAIT_V(6); PG8_BAR; PG8_MMA(1, 1, At, B1); PG8_BAR;
    }
    E(acc, cur, wr, wc, fr, fq);
    if (!has_next) break;
#pragma unroll
    for (int a = 0; a < 2; ++a)
#pragma unroll
      for (int b = 0; b < 2; ++b)
#pragma unroll
        for (int m = 0; m < 4; ++m)
#pragma unroll
          for (int n = 0; n < 2; ++n) acc[a][b][m][n] = (f32x4){0.f, 0.f, 0.f, 0.f};
    cur = nxt; cA = nA; cB = nB; ++ui;
  }
  PG8_WAIT_V(0);
  if (wr == 0) PG8_BAR;
  PG8_BAR;
#undef PG8_SA
#undef PG8_SB
#undef PG8_STAGE
#undef PG8_LDA
#undef PG8_LDB
#undef PG8_MMA
#undef PG8_WAIT_V
#undef PG8_WAIT_L
#undef PG8_BAR
#undef PG8_SCHED
}
}
using pg8::Unit;
typedef const f32x4 (&AccRef)[2][2][4][2];

DI void st_bf4(bf16_t* p, f32x4 v) { u32x2 w = {pk2(v[0], v[1]), pk2(v[2], v[3])}; *(u32x2*)p = w; }
DI f32x4 ld_bf4(const bf16_t* p) { u32x2 w = *(const u32x2*)p; return (f32x4){bflo(w[0]), bfhi(w[0]), bflo(w[1]), bfhi(w[1])}; }

struct EpiIn {
  static constexpr bool HOOK = false;
  Params P;
  DI void rescale(f32x4 (&)[2][2][4][2], const Unit&, int, int, int, int, int) const {}
  DI void operator()(AccRef acc, const Unit& u, int wr, int wc, int fr, int fq) const {
    unsigned char* ws = P.ws; float* out = P.out;
    if (u.kind == 1) {
      const float* RM = (const float*)(ws + W_RM);
      const bool isV = u.col0 >= 2048; const int cb = isV ? u.col0 - 2048 : u.col0;
      float* fo = out + (isV ? O_MVP : O_MKP);
      bf16_t* MKP = (bf16_t*)(ws + W_MKP); bf16_t* VTP = (bf16_t*)(ws + W_VTP);
#pragma unroll
      for (int ai = 0; ai < 2; ++ai)
#pragma unroll
        for (int m = 0; m < 4; ++m) {
          const int row = u.row0 + ai * 128 + wr * 64 + m * 16 + fr; const float r = RM[row];
#pragma unroll
          for (int bj = 0; bj < 2; ++bj)
#pragma unroll
            for (int n = 0; n < 2; ++n) {
              const int c = cb + bj * 128 + wc * 32 + n * 16 + 4 * fq;
              const f32x4 v = acc[ai][bj][m][n] * r;
              *(f32x4*)(fo + (size_t)row * 2048 + c) = v;
              if (!isV) st_bf4(MKP + (size_t)row * 2048 + c, v);
              else { const int b = row >> 8, key = row & 255, h = c >> 9, d = c & 511;
                bf16_t* vt = VTP + ((size_t)((b * 4 + h) * 512 + d)) * 256 + key;
                const unsigned w0 = pk2(v[0], v[1]), w1 = pk2(v[2], v[3]);
                vt[0] = (bf16_t)(w0 & 0xffff); vt[256] = (bf16_t)(w0 >> 16); vt[512] = (bf16_t)(w1 & 0xffff); vt[768] = (bf16_t)(w1 >> 16); }
            }
        }
      return;
    }
    const float* R1 = (const float*)(ws + W_R1);
    const bool sample = u.row0 >= MP;
    const int T = sample ? 64 : 2048;
    const int col0 = u.col0;
    if (col0 >= 23552) {
      if (wc > 1) return;
      const float* dtb = P.in[14]; const float* bfg = P.in[18];
      float* DT = (float*)(ws + W_DT);
      float* LFT = (float*)(ws + W_LFT); float* LFS = (float*)(ws + W_LFS);
#pragma unroll
      for (int ai = 0; ai < 2; ++ai)
#pragma unroll
        for (int m = 0; m < 4; ++m) {
          const int row = u.row0 + ai * 128 + wr * 64 + m * 16 + fr; const float r = R1[row];
          const int rs = row - MP; const int b = sample ? (rs >> 6) : (row >> 11), t = sample ? (rs & 63) : (row & 2047);
#pragma unroll
          for (int n = 0; n < 2; ++n) {
            const int c = wc * 32 + n * 16 + 4 * fq;
            const f32x4 v = acc[ai][0][m][n] * r;
            if (c < 32) { f32x4 o;
#pragma unroll
              for (int e = 0; e < 4; ++e) o[e] = softplusf_(v[e] + dtb[c + e]);
              *(f32x4*)(DT + (size_t)row * 32 + c) = o; }
            else if (c < 48) { const int h0 = c - 32; f32x4 o;
#pragma unroll
              for (int e = 0; e < 4; ++e) o[e] = -softplusf_(-(v[e] + bfg[h0 + e]));
              float* lo = sample ? out + O_FLS + (size_t)rs * 16 + h0 : out + O_FLP + (size_t)row * 16 + h0;
              *(f32x4*)lo = o;
#pragma unroll
              for (int e = 0; e < 4; ++e) { if (sample) LFS[(size_t)(b * 16 + h0 + e) * 1088 + 1024 + t] = o[e]; else LFT[(size_t)(b * 16 + h0 + e) * 2048 + t] = o[e]; }
            }
          }
        }
      return;
    }
    int act = 0, ld = 2048, c0, rowmode = 0; bf16_t* dst; float* fout = nullptr; float* convout = nullptr;
    if (col0 < 2048) { act = 1; dst = (bf16_t*)(ws + W_ZB); c0 = col0; }
    else if (col0 < 5120) { rowmode = 1; ld = 3072; dst = (bf16_t*)(ws + (sample ? W_XBCS : W_XBCP)); c0 = col0 - 2048; convout = out + (sample ? O_CONVS : O_CONVP); }
    else if (col0 < 7168) { dst = (bf16_t*)(ws + W_FQ); c0 = col0 - 5120; }
    else if (col0 < 9216) { rowmode = 2; dst = (bf16_t*)(ws + (sample ? W_KS : W_FK)); c0 = col0 - 7168; fout = out + (sample ? O_FKS : O_FKP); }
    else if (col0 < 11264) { rowmode = 2; dst = (bf16_t*)(ws + (sample ? W_VS : W_FV)); c0 = col0 - 9216; fout = out + (sample ? O_FVS : O_FVP); }
    else if (col0 < 13312) { act = 1; dst = (bf16_t*)(ws + W_FG); c0 = col0 - 11264; }
    else if (col0 < 15360) { dst = (bf16_t*)(ws + W_MQ); c0 = col0 - 13312; }
    else if (col0 < 17408) { act = 1; dst = (bf16_t*)(ws + W_MG); c0 = col0 - 15360; }
    else { act = 2; ld = 6144; dst = (bf16_t*)(ws + W_G3); c0 = col0 - 17408; }
#pragma unroll
    for (int ai = 0; ai < 2; ++ai)
#pragma unroll
      for (int m = 0; m < 4; ++m) {
        const int row = u.row0 + ai * 128 + wr * 64 + m * 16 + fr; const float r = R1[row];
        const int rs = row - MP; const int b = sample ? (rs >> 6) : (row >> 11), t = sample ? (rs & 63) : (row & 2047);
        size_t drow = (size_t)row;
        if (rowmode == 1) drow = sample ? (size_t)(b * 67 + 3 + t) : (size_t)(b * 2051 + 3 + t);
        else if (rowmode == 2) drow = sample ? (size_t)(b * 1088 + 1024 + t) : (size_t)row;
        const size_t frow = sample ? (size_t)rs : (size_t)row;
#pragma unroll
        for (int bj = 0; bj < 2; ++bj)
#pragma unroll
          for (int n = 0; n < 2; ++n) {
            const int c = c0 + bj * 128 + wc * 32 + n * 16 + 4 * fq;
            f32x4 v = acc[ai][bj][m][n] * r;
            if (fout) *(f32x4*)(fout + frow * 2048 + c) = v;
            if (convout && t >= T - 3) *(f32x4*)(convout + (size_t)(b * 3 + t - (T - 3)) * 3072 + c) = v;
            if (act == 1) {
#pragma unroll
              for (int e = 0; e < 4; ++e) v[e] = siluf_(v[e]);
            } else if (act == 2) {
#pragma unroll
              for (int e = 0; e < 4; ++e) v[e] = sigmoidf_(v[e]);
            }
            st_bf4(dst + drow * ld + c, v);
          }
      }
  }
};
struct SchedP1 {
  int c, G; const char* XB; const char* WIN; const char* MB; const char* WMEM;
  DI bool next(int i, Unit& u) const {
    const int L = i * G + c;
    constexpr int N1 = 130 * 93;
    if (L < N1) { int pm, pn; pg8::tile_order(L, 130, 93, pm, pn);
      u.A = XB + (size_t)pm * 256 * 2048 * 2; u.B = WIN + (size_t)pn * 256 * 2048 * 2; u.row0 = pm * 256; u.col0 = pn * 256; u.kind = 0; u.nvalid = 256; u.aux = 0; return true; }
    const int L2 = L - N1; if (L2 >= 256) return false;
    int pm, pn; pg8::tile_order(L2, 16, 16, pm, pn);
    u.A = MB + (size_t)pm * 256 * 2048 * 2; u.B = WMEM + (size_t)pn * 256 * 2048 * 2; u.row0 = pm * 256; u.col0 = pn * 256; u.kind = 1; u.nvalid = 256; u.aux = 0; return true;
  }
};

struct EpiS {
  static constexpr bool HOOK = false;
  Params P;
  DI void rescale(f32x4 (&)[2][2][4][2], const Unit&, int, int, int, int, int) const {}
  DI void operator()(AccRef acc, const Unit& u, int wr, int wc, int fr, int fq) const {
    bf16_t* PM = (bf16_t*)(P.ws + W_PM); float* PSUM = (float*)(P.ws + W_PSUM);
    const float c2 = 0.044194173824159216f * 1.4426950408889634f;
    const int h = u.aux;
#pragma unroll
    for (int ai = 0; ai < 2; ++ai)
#pragma unroll
      for (int m = 0; m < 4; ++m) {
        const int rr = ai * 128 + wr * 64 + m * 16 + fr; const int row = u.row0 + rr; const bool ok = rr < u.nvalid;
        float s = 0.f;
#pragma unroll
        for (int bj = 0; bj < 2; ++bj)
#pragma unroll
          for (int n = 0; n < 2; ++n) {
            const int c = bj * 128 + wc * 32 + n * 16 + 4 * fq;
            f32x4 e;
#pragma unroll
            for (int k = 0; k < 4; ++k) { e[k] = __builtin_amdgcn_exp2f(fminf(acc[ai][bj][m][n][k] * c2, 100.f)); s += e[k]; }
            if (ok) st_bf4(PM + (size_t)row * 1024 + h * 256 + c, e);
          }
        s += __shfl_xor(s, 16); s += __shfl_xor(s, 32);
        if (ok && fq == 0) PSUM[(size_t)row * 16 + h * 4 + wc] = s;
      }
  }
};
struct SchedS {
  int c, G; const char* MQ; const char* MKP; const char* MKS;
  DI bool next(int i, Unit& u) const {
    const int L = i * G + c; if (L >= 544) return false;
    u.col0 = 0; u.kind = 0;
    if (L < 512) { const int b = L >> 5, h = (L >> 3) & 3, mt = L & 7; u.row0 = b * 2048 + mt * 256; u.nvalid = 256; u.aux = h;
      u.A = MQ + ((size_t)u.row0 * 2048 + h * 512) * 2; u.B = MKP + ((size_t)(b * 256) * 2048 + h * 512) * 2; }
    else { const int j = L - 512, b = j >> 2, h = j & 3; u.row0 = MP + b * 64; u.nvalid = 64; u.aux = h;
      u.A = MQ + ((size_t)u.row0 * 2048 + h * 512) * 2; u.B = MKS + ((size_t)(b * 256) * 2048 + h * 512) * 2; }
    return true;
  }
};
struct EpiPV {
  static constexpr bool HOOK = false;
  Params P;
  DI void rescale(f32x4 (&)[2][2][4][2], const Unit&, int, int, int, int, int) const {}
  DI void operator()(AccRef acc, const Unit& u, int wr, int wc, int fr, int fq) const {
    const float* PSUM = (const float*)(P.ws + W_PSUM); const bf16_t* MG = (const bf16_t*)(P.ws + W_MG); bf16_t* Y3 = (bf16_t*)(P.ws + W_Y3);
    const int h = u.aux >> 9;
#pragma unroll
    for (int ai = 0; ai < 2; ++ai)
#pragma unroll
      for (int m = 0; m < 4; ++m) {
        int rr = ai * 128 + wr * 64 + m * 16 + fr; asm volatile("" : "+v"(rr)); const int row = u.row0 + rr;
        __builtin_amdgcn_sched_barrier(0);
        if (rr < u.nvalid) {
          const f32x4 ps = *(const f32x4*)(PSUM + (size_t)row * 16 + h * 4);
          const float inv = 1.f / ((ps[0] + ps[1]) + (ps[2] + ps[3]));
#pragma unroll
          for (int bj = 0; bj < 2; ++bj)
#pragma unroll
            for (int n = 0; n < 2; ++n) {
              const int c = u.aux + bj * 128 + wc * 32 + n * 16 + 4 * fq;
              const f32x4 gte = ld_bf4(MG + (size_t)row * 2048 + c);
              st_bf4(Y3 + (size_t)row * 6144 + 4096 + c, acc[ai][bj][m][n] * gte * inv);
            }
        }
      }
  }
};
struct SchedPV {
  int c, G; const char* PM; const char* VTP; const char* VTS;
  DI bool next(int i, Unit& u) const {
    const int L = i * G + c; if (L >= 1088) return false;
    u.col0 = 0; u.kind = 0;
    if (L < 1024) { const int b = L >> 6, h = (L >> 4) & 3, mt = (L >> 1) & 7, n2 = L & 1; u.row0 = b * 2048 + mt * 256; u.nvalid = 256; u.aux = h * 512 + n2 * 256;
      u.A = PM + ((size_t)u.row0 * 1024 + h * 256) * 2; u.B = VTP + ((size_t)((b * 4 + h) * 512 + n2 * 256) * 256) * 2; }
    else { const int j = L - 1024, b = j >> 3, h = (j >> 1) & 3, n2 = j & 1; u.row0 = MP + b * 64; u.nvalid = 64; u.aux = h * 512 + n2 * 256;
      u.A = PM + ((size_t)u.row0 * 1024 + h * 256) * 2; u.B = VTS + ((size_t)((b * 4 + h) * 512 + n2 * 256) * 256) * 2; }
    return true;
  }
};

struct EpiMerge {
  static constexpr bool HOOK = false;
  Params P;
  DI void rescale(f32x4 (&)[2][2][4][2], const Unit&, int, int, int, int, int) const {}
  DI void operator()(AccRef acc, const Unit& u, int wr, int wc, int fr, int fq) const {
    const bf16_t* G3 = (const bf16_t*)(P.ws + W_G3); bf16_t* MRG = (bf16_t*)(P.ws + W_MRG); float* TMP = (float*)(P.ws + W_TMP);
    const float* RS = (const float*)(P.ws + W_RS);
    const int seg = u.kind;
#pragma unroll
    for (int ai = 0; ai < 2; ++ai)
#pragma unroll
      for (int m = 0; m < 4; ++m) {
        int row = u.row0 + ai * 128 + wr * 64 + m * 16 + fr; asm volatile("" : "+v"(row));
        const float rs = (seg == 0) ? RS[row] : 1.f;
#pragma unroll
        for (int bj = 0; bj < 2; ++bj)
#pragma unroll
          for (int n = 0; n < 2; ++n) {
            const int c = u.col0 + bj * 128 + wc * 32 + n * 16 + 4 * fq;
            const f32x4 gte = ld_bf4(G3 + (size_t)row * 6144 + seg * 2048 + c);
            f32x4 v = acc[ai][bj][m][n] * gte * rs;
            float* tp = TMP + (size_t)row * 2048 + c;
            if (seg > 0) v += *(const f32x4*)tp;
            if (seg < 2) *(f32x4*)tp = v; else st_bf4(MRG + (size_t)row * 2048 + c, v);
          }
        __builtin_amdgcn_sched_barrier(0);
      }
  }
};
struct SchedMerge {
  int c, G; const char* A; const char* B;
  DI bool next(int i, Unit& u) const {
    const int ti = i / 3, seg = i - ti * 3; const int L = ti * G + c; if (L >= 130 * 8) return false;
    int pm, pn; pg8::tile_order(L, 130, 8, pm, pn);
    u.A = A + ((size_t)pm * 256 * 6144 + seg * 2048) * 2; u.B = B + ((size_t)pn * 256 * 6144 + seg * 2048) * 2; u.row0 = pm * 256; u.col0 = pn * 256; u.kind = seg; u.nvalid = 256; u.aux = pn; return true;
  }
};
struct SchedTile {
  int c, G, nM, nN; const char* A; const char* B; size_t astep, bstep;
  DI bool next(int i, Unit& u) const {
    const int L = i * G + c; if (L >= nM * nN) return false;
    int pm, pn; pg8::tile_order(L, nM, nN, pm, pn);
    u.A = A + (size_t)pm * astep; u.B = B + (size_t)pn * bstep; u.row0 = pm * 256; u.col0 = pn * 256; u.kind = 0; u.nvalid = 256; u.aux = pn; return true;
  }
};
struct EpiOut {
  static constexpr bool HOOK = false;
  Params P;
  DI void rescale(f32x4 (&)[2][2][4][2], const Unit&, int, int, int, int, int) const {}
  DI void operator()(AccRef acc, const Unit& u, int wr, int wc, int fr, int fq) const {
    float* out = P.out; float* PARTO = (float*)(P.ws + W_PARTO);
    const bool sample = u.row0 >= MP;
    const float* xin = sample ? P.in[1] - (size_t)MP * 2048 : P.in[0];
#pragma unroll
    for (int ai = 0; ai < 2; ++ai)
#pragma unroll
      for (int m = 0; m < 4; ++m) {
        const int row = u.row0 + ai * 128 + wr * 64 + m * 16 + fr;
        float s = 0.f;
#pragma unroll
        for (int bj = 0; bj < 2; ++bj)
#pragma unroll
          for (int n = 0; n < 2; ++n) {
            const int c = u.col0 + bj * 128 + wc * 32 + n * 16 + 4 * fq;
            const f32x4 xo = acc[ai][bj][m][n] + *(const f32x4*)(xin + (size_t)row * 2048 + c);
            *(f32x4*)(out + (size_t)row * 2048 + c) = xo;
            s += xo[0] * xo[0] + xo[1] * xo[1] + xo[2] * xo[2] + xo[3] * xo[3];
          }
        s += __shfl_xor(s, 16); s += __shfl_xor(s, 32);
        if (fq == 0) PARTO[(size_t)row * 32 + u.aux * 4 + wc] = s;
      }
  }
};

DI void row_to_bf16(const float* src, bf16_t* dst, float* rs, int lane) {
  const f32x4* s = (const f32x4*)src + lane; f32x4 v[8]; float ss = 0.f;
#pragma unroll
  for (int j = 0; j < 8; ++j) { v[j] = s[64 * j]; ss += (v[j][0] * v[j][0] + v[j][1] * v[j][1]) + (v[j][2] * v[j][2] + v[j][3] * v[j][3]); }
  if (rs) { ss = wave_sum(ss); if (lane == 0) *rs = rsqrtf(ss * (1.f / 2048.f) + EPS); }
  u32x2* d = (u32x2*)dst + lane;
#pragma unroll
  for (int j = 0; j < 8; ++j) { u32x2 w = {pk2(v[j][0], v[j][1]), pk2(v[j][2], v[j][3])}; d[64 * j] = w; }
}
DI void transpose_item(const float* W, int ldw, int scol0, int nvalid, const float* scale, bf16_t* WT, int ldd, int drow0, int dcol0, int kb, LAS float* scr, int lane) {
  const int k0 = 64 * kb;
#pragma unroll 8
  for (int i = 0; i < 32; ++i) { const int kk = 2 * i + (lane >> 5), n = lane & 31;
    float v = 0.f; if (n < nvalid) { v = W[(size_t)(k0 + kk) * ldw + scol0 + n]; if (scale) v *= scale[k0 + kk]; }
    scr[kk * 33 + n] = v; }
  asm volatile("s_waitcnt lgkmcnt(0)" ::: "memory");
  const int c = lane & 7;
#pragma unroll
  for (int j = 0; j < 4; ++j) { const int n = (lane >> 3) + 8 * j; const LAS float* s = scr + (8 * c) * 33 + n;
    u32x4 o; o[0] = pk2(s[0 * 33], s[1 * 33]); o[1] = pk2(s[2 * 33], s[3 * 33]); o[2] = pk2(s[4 * 33], s[5 * 33]); o[3] = pk2(s[6 * 33], s[7 * 33]);
    *(u32x4*)(WT + (size_t)(drow0 + n) * ldd + dcol0 + k0 + 8 * c) = o; }
  asm volatile("s_waitcnt lgkmcnt(0)" ::: "memory");
}
DI void phase0(const Params& P, LAS unsigned char* lds) {
  unsigned char* ws = P.ws;
  int tid = threadIdx.x; asm volatile("" : "+v"(tid));
  const int wid = tid >> 6, lane = tid & 63;
  const int gw = blockIdx.x * 8 + wid, NGW = gridDim.x * 8;
  if (blockIdx.x == 0 && tid < 64) ((unsigned*)(ws + W_CTL))[tid] = 0u;
  constexpr int NR = MT + 4096 + 8192 + 8192 + 2048;
  for (int r = gw; r < NR; r += NGW) {
    if (r < MP) row_to_bf16(P.in[0] + (size_t)r * 2048, (bf16_t*)(ws + W_XB) + (size_t)r * 2048, (float*)(ws + W_R1) + r, lane);
    else if (r < MT) row_to_bf16(P.in[1] + (size_t)(r - MP) * 2048, (bf16_t*)(ws + W_XB) + (size_t)r * 2048, (float*)(ws + W_R1) + r, lane);
    else if (r < MT + 4096) { const int q = r - MT; row_to_bf16(P.in[2] + (size_t)q * 2048, (bf16_t*)(ws + W_MB) + (size_t)q * 2048, (float*)(ws + W_RM) + q, lane); }
    else if (r < MT + 4096 + 8192) { const int q = r - MT - 4096, b = q >> 10, j = q & 1023; row_to_bf16(P.in[3] + (size_t)q * 2048, (bf16_t*)(ws + W_KS) + (size_t)(b * 1088 + j) * 2048, nullptr, lane); }
    else if (r < MT + 4096 + 16384) { const int q = r - MT - 4096 - 8192, b = q >> 10, j = q & 1023; row_to_bf16(P.in[4] + (size_t)q * 2048, (bf16_t*)(ws + W_VS) + (size_t)(b * 1088 + j) * 2048, nullptr, lane); }
    else { const int q = r - MT - 4096 - 16384; row_to_bf16(P.in[8] + (size_t)q * 2048, (bf16_t*)(ws + W_MKS) + (size_t)q * 2048, nullptr, lane); }
  }
  LAS float* scr = (LAS float*)(lds + wid * 8448);
  constexpr int I_IN = 744 * 32, I_MEM = 128 * 32, I_O = 64 * 32;
  constexpr int NITEMS = I_IN + I_MEM + 4 * I_O;
  for (int it = gw; it < NITEMS; it += NGW) {
    int r = it;
    if (r < I_IN) { const int nb = r >> 5, kb = r & 31, d = nb * 32; int src, nv = 32;
      if (d < 5120) src = d; else if (d < 13312) src = d + 32; else if (d < 23552) src = d + 48;
      else if (d == 23552) src = 5120; else if (d == 23584) { src = 13344; nv = 16; } else { src = 0; nv = 0; }
      transpose_item(P.in[11], 23600, src, nv, P.in[10], (bf16_t*)(ws + W_WIN), 2048, d, 0, kb, scr, lane); continue; }
    r -= I_IN;
    if (r < I_MEM) { const int nb = r >> 5, kb = r & 31; transpose_item(P.in[20], 4096, nb * 32, 32, P.in[19], (bf16_t*)(ws + W_WMEM), 2048, nb * 32, 0, kb, scr, lane); continue; }
    r -= I_MEM;
    if (r < I_O) { const int nb = r >> 5, kb = r & 31; transpose_item(P.in[21], 2048, nb * 32, 32, P.in[17], (bf16_t*)(ws + W_WO), 6144, nb * 32, 0, kb, scr, lane); continue; }
    r -= I_O;
    if (r < I_O) { const int nb = r >> 5, kb = r & 31; transpose_item(P.in[22], 2048, nb * 32, 32, nullptr, (bf16_t*)(ws + W_WO), 6144, nb * 32, 2048, kb, scr, lane); continue; }
    r -= I_O;
    if (r < I_O) { const int nb = r >> 5, kb = r & 31; transpose_item(P.in[23], 2048, nb * 32, 32, nullptr, (bf16_t*)(ws + W_WO), 6144, nb * 32, 4096, kb, scr, lane); continue; }
    r -= I_O;
    { const int nb = r >> 5, kb = r & 31; transpose_item(P.in[24], 2048, nb * 32, 32, nullptr, (bf16_t*)(ws + W_WOUT), 2048, nb * 32, 0, kb, scr, lane); }
  }
  const long gt = (long)blockIdx.x * 512 + tid, NT = (long)gridDim.x * 512;
  for (long i = gt; i < 8L * 32 * 2048; i += NT) {
    const int hd = (int)(i & 2047), kg = (int)((i >> 11) & 31), b = (int)(i >> 16);
    const float* s = P.in[9] + ((size_t)(b * 256 + kg * 8) * 2048 + hd);
    u32x4 o; o[0] = pk2(s[0], s[2048]); o[1] = pk2(s[2 * 2048], s[3 * 2048]); o[2] = pk2(s[4 * 2048], s[5 * 2048]); o[3] = pk2(s[6 * 2048], s[7 * 2048]);
    *(u32x4*)((bf16_t*)(ws + W_VTS) + ((size_t)(b * 2048 + hd)) * 256 + kg * 8) = o;
  }
  for (long i = gt; i < 8L * 1024 * 16; i += NT) { const int h = (int)(i & 15), j = (int)((i >> 4) & 1023), b = (int)(i >> 14);
    ((float*)(ws + W_LFS))[(size_t)(b * 16 + h) * 1088 + j] = P.in[5][i]; }
  for (long i = gt; i < 8L * 3 * 3072; i += NT) { const int c = (int)(i % 3072), r = (int)((i / 3072) % 3), b = (int)(i / 9216);
    ((bf16_t*)(ws + W_XBCS))[(size_t)(b * 67 + r) * 3072 + c] = (bf16_t)(pk2(P.in[7][i], 0.f) & 0xffff); }
  for (long i = gt; i < 16L * 3 * 3072; i += NT) { const int c = (int)(i % 3072), r = (int)((i / 3072) % 3), b = (int)(i / 9216);
    ((bf16_t*)(ws + W_XBCP))[(size_t)(b * 2051 + r) * 3072 + c] = 0; }
}

namespace fa {
constexpr int D = 128, LD = 2048, LDO = 6144;
constexpr float SCALE = 0.08838834764831845f;
constexpr float THR = 8.f;
constexpr int NW = 8, QBLK = 32, KVBLK = 64, QB = NW * QBLK;
constexpr int SHM_V = KVBLK * D * 2, SHM_K = KVBLK * D * 2;
constexpr int TAB_OFF = 2 * SHM_V + 2 * SHM_K + NW * 64 * 4;
constexpr unsigned WBIG = 0x7fffffffu;
constexpr int OSTG_OFF = 77824;
#define KSWZ(row, colB) ((row) * 256 + ((colB) ^ (((row) & 7) << 4)))
#define SBAR() __builtin_amdgcn_sched_barrier(0)
DI int v_st(int k, int c) { const int kk = (k & ~0xC) | ((k & 4) << 1) | ((k & 8) >> 1); return ((kk >> 3) * 4 + (c >> 5)) * 512 + ((kk & 7) * 32 + (c & 31)) * 2; }
DI int v_rd_base(int lane) { return ((lane & 3) << 3) | (((lane >> 2) & 3) << 6) | (((lane >> 4) & 1) << 5) | (((lane >> 5) & 1) << 8); }
constexpr int v_rd_off(int d0, int ks, int half) { return d0 * 512 + ks * 4096 + half * 2048; }
DI int crow(int r, int hi) { return (r & 3) + 8 * (r >> 2) + 4 * hi; }
DI bf16x8 load8(const bf16_t* p) { return *reinterpret_cast<const bf16x8*>(p); }
DI void mask_tile(f32x16& p0, f32x16& p1, int dq, unsigned W) {
  const float NEG = -__builtin_inff();
#pragma unroll
  for (int r = 0; r < 16; ++r) {
    const int c = (r & 3) + 8 * (r >> 2);
    if ((unsigned)(dq - c) >= W) p0[r] = NEG;
    if ((unsigned)(dq - c - 32) >= W) p1[r] = NEG;
  }
}
DI void partialSM(f32x16& p0, f32x16& p1, float& m_reg, float& mn, float& alpha) {
  float pmax = p0[0];
#pragma unroll
  for (int r = 1; r < 16; ++r) pmax = fmaxf(pmax, p0[r]);
#pragma unroll
  for (int r = 0; r < 16; ++r) pmax = fmaxf(pmax, p1[r]);
  { auto rr = __builtin_amdgcn_permlane32_swap(__float_as_uint(pmax), __float_as_uint(pmax), false, false);
    pmax = fmaxf(__uint_as_float(rr[0]), __uint_as_float(rr[1])); }
  constexpr float C2 = 1.4426950408889634f * SCALE;
  if (__builtin_expect(__all((pmax - m_reg) * SCALE <= THR), 1)) { mn = m_reg; alpha = 1.f; }
  else { mn = fmaxf(m_reg, pmax); alpha = __builtin_amdgcn_exp2f((m_reg - mn) * C2); m_reg = mn; }
  const float mnL = -mn * C2;
#pragma unroll
  for (int r = 0; r < 16; ++r) p0[r] = fmaf(p0[r], C2, mnL);
#pragma unroll
  for (int r = 0; r < 16; ++r) p1[r] = fmaf(p1[r], C2, mnL);
#pragma unroll
  for (int r = 0; r < 16; ++r) p0[r] = __builtin_amdgcn_exp2f(p0[r]);
}
DI void finishSM(f32x16& p0, f32x16& p1, float alpha, float& l_reg, bf16x8& pa0, bf16x8& pa1, bf16x8& pa2, bf16x8& pa3) {
#pragma unroll
  for (int r = 0; r < 16; ++r) p1[r] = __builtin_amdgcn_exp2f(p1[r]);
  float ps = 0;
#pragma unroll
  for (int r = 0; r < 16; ++r) ps += p0[r];
#pragma unroll
  for (int r = 0; r < 16; ++r) ps += p1[r];
  { auto rr = __builtin_amdgcn_permlane32_swap(__float_as_uint(ps), __float_as_uint(ps), false, false);
    ps = __uint_as_float(rr[0]) + __uint_as_float(rr[1]); }
  l_reg = l_reg * alpha + ps;
#define PK4(P, B_, OUT) do { unsigned a0 = pk2(P[B_+0], P[B_+1]), a1 = pk2(P[B_+2], P[B_+3]);                          \
        unsigned b0 = pk2(P[B_+4], P[B_+5]), b1 = pk2(P[B_+6], P[B_+7]);                                             \
        auto r0 = __builtin_amdgcn_permlane32_swap(a0, b0, false, false); auto r1 = __builtin_amdgcn_permlane32_swap(a1, b1, false, false); \
        u32x4 w = {r0[0], r1[0], r0[1], r1[1]}; OUT = *reinterpret_cast<bf16x8*>(&w); } while (0)
  PK4(p0, 0, pa0); PK4(p0, 8, pa1); PK4(p1, 0, pa2); PK4(p1, 8, pa3);
#undef PK4
}
template <int KB>
DI void qkt(f32x16& p0, f32x16& p1, const LAS char* K_lds, const LAS float* tabk, int r32, int hi, const bf16x8* qr) {
#pragma unroll
  for (int g = 0; g < 4; ++g) { const f32x4 t0 = *(const LAS f32x4*)(tabk + 8 * g + 4 * hi), t1 = *(const LAS f32x4*)(tabk + 32 + 8 * g + 4 * hi);
#pragma unroll
    for (int e = 0; e < 4; ++e) { p0[4 * g + e] = t0[e]; p1[4 * g + e] = t1[e]; } }
  const LAS char* kb[4];
#pragma unroll
  for (int dd = 0; dd < 4; ++dd) kb[dd] = K_lds + KB * SHM_K + KSWZ(r32, (dd * 16 + hi * 8) * 2);
#pragma unroll
  for (int d0 = 0; d0 < 8; ++d0) { const LAS char* a = kb[d0 & 3] + (d0 >> 2) * 128;
    bf16x8 b0 = *(const LAS bf16x8*)(a);
    bf16x8 b1 = *(const LAS bf16x8*)(a + 32 * 256);
    p0 = __builtin_amdgcn_mfma_f32_32x32x16_bf16(b0, qr[d0], p0, 0, 0, 0);
    p1 = __builtin_amdgcn_mfma_f32_32x32x16_bf16(b1, qr[d0], p1, 0, 0, 0); }
}
template <int VB>
DI void pv_tile(f32x16* o, int vb0, bf16x8 pa0, bf16x8 pa1, bf16x8 pa2, bf16x8 pa3) {
#define TRRD(dst, off) asm volatile("ds_read_b64_tr_b16 %0, %1 offset:%2" : "=&v"(dst) : "v"(vb0), "i"(off) : "memory")
#define PV_D0(d0) do { s16x4 l0, l1, l2, l3, h0, h1, h2, h3; constexpr int b_ = VB * SHM_V + v_rd_off(d0, 0, 0); \
        TRRD(l0, b_); TRRD(h0, b_ + 2048); TRRD(l1, b_ + 4096); TRRD(h1, b_ + 6144); TRRD(l2, b_ + 8192); TRRD(h2, b_ + 10240); TRRD(l3, b_ + 12288); TRRD(h3, b_ + 14336); \
        asm volatile("s_waitcnt lgkmcnt(0)" ::: "memory"); SBAR();   \
        o[d0] = __builtin_amdgcn_mfma_f32_32x32x16_bf16(pa0, (bf16x8){l0[0], l0[1], l0[2], l0[3], h0[0], h0[1], h0[2], h0[3]}, o[d0], 0, 0, 0);   \
        o[d0] = __builtin_amdgcn_mfma_f32_32x32x16_bf16(pa1, (bf16x8){l1[0], l1[1], l1[2], l1[3], h1[0], h1[1], h1[2], h1[3]}, o[d0], 0, 0, 0);   \
        o[d0] = __builtin_amdgcn_mfma_f32_32x32x16_bf16(pa2, (bf16x8){l2[0], l2[1], l2[2], l2[3], h2[0], h2[1], h2[2], h2[3]}, o[d0], 0, 0, 0);   \
        o[d0] = __builtin_amdgcn_mfma_f32_32x32x16_bf16(pa3, (bf16x8){l3[0], l3[1], l3[2], l3[3], h3[0], h3[1], h3[2], h3[3]}, o[d0], 0, 0, 0); } while (0)
  PV_D0(0); PV_D0(1); PV_D0(2); PV_D0(3);
#undef PV_D0
#undef TRRD
}
struct BlockRef { const bf16_t* Q; const bf16_t* K; const bf16_t* V; bf16_t* O; const bf16_t* G; const float* lf; int P0, skv, nvalid, nkeys; };
struct Seam { bf16x8 qr[8]; bf16x8 st_v0, st_v1, st_k0, st_k1; };
constexpr int NFOX = 2048 + 128;
DI BlockRef fox_decode(const Params& P, int L) {
  unsigned char* ws = P.ws; BlockRef r;
  const bf16_t* FQ = (const bf16_t*)(ws + W_FQ); const bf16_t* FG = (const bf16_t*)(ws + W_FG); bf16_t* Y3 = (bf16_t*)(ws + W_Y3);
  if (L < 2048) { const int bh = L >> 3, qb = 7 - (L & 7), b = bh >> 4, h = bh & 15;
    const size_t row = (size_t)b * 2048 + qb * 256;
    r.lf = (const float*)(ws + W_LFT) + (size_t)bh * 2048; r.nkeys = 2048;
    r.Q = FQ + row * 2048 + h * 128; r.K = (const bf16_t*)(ws + W_FK) + (size_t)b * 2048 * 2048 + h * 128; r.V = (const bf16_t*)(ws + W_FV) + (size_t)b * 2048 * 2048 + h * 128;
    r.O = Y3 + row * 6144 + 2048 + h * 128; r.G = FG + row * 2048 + h * 128; r.P0 = qb * 256; r.skv = 2048; r.nvalid = 256;
  } else { const int j = L - 2048, b = j >> 4, h = j & 15;
    r.lf = (const float*)(ws + W_LFS) + (size_t)j * 1088; r.nkeys = 1088;
    const size_t row = (size_t)MP + b * 64;
    r.Q = FQ + row * 2048 + h * 128; r.K = (const bf16_t*)(ws + W_KS) + (size_t)b * 1088 * 2048 + h * 128; r.V = (const bf16_t*)(ws + W_VS) + (size_t)b * 1088 * 2048 + h * 128;
    r.O = Y3 + row * 6144 + 2048 + h * 128; r.G = FG + row * 2048 + h * 128; r.P0 = 1024; r.skv = 1088; r.nvalid = 64; }
  return r;
}

#define ROW(p, k0, rr) ((p) + (size_t)((k0) + 32 * (rr)) * LD + rowoff0)
#define VMW() asm volatile("s_waitcnt vmcnt(0)" ::: "memory")
#define VMWN(n) asm volatile("s_waitcnt vmcnt(%0)" :: "i"(n) : "memory")
#define SLOAD_H(Kp, Vp, k0) do { S.st_v0 = load8(ROW(Vp, k0, 0)); S.st_v1 = load8(ROW(Vp, k0, 1));              \
                         S.st_k0 = load8(ROW(Kp, k0, 0)); S.st_k1 = load8(ROW(Kp, k0, 1)); } while (0)
#define SWRITE_HK(bf) do { *(LAS bf16x8*)(K_lds + (bf) * SHM_K + kws) = S.st_k0; *(LAS bf16x8*)(K_lds + (bf) * SHM_K + kws + 32 * 256) = S.st_k1; } while (0)
#define SWRITE_HV(bf) do { *(LAS bf16x8*)(V_lds + (bf) * SHM_V + vst0) = S.st_v0; *(LAS bf16x8*)(V_lds + (bf) * SHM_V + vst0 + vst1d) = S.st_v1; } while (0)
#define SWRITE_H(bf) do { SWRITE_HV(bf); SWRITE_HK(bf); } while (0)
DI void fox_prime(const BlockRef& cur, LAS char* lds, Seam& S) {
  int tid = threadIdx.x; asm volatile("" : "+v"(tid));
  const int wid = __builtin_amdgcn_readfirstlane(tid >> 6), lane = tid & 63, r32 = lane & 31, hi = lane >> 5;
  const int sr = tid >> 4, sc = (tid & 15) * 8, kws = KSWZ(sr, sc * 2); LAS char* K_lds = lds + 2 * SHM_V;
  const unsigned rowoff0 = (unsigned)(sr * LD + sc);
  const unsigned qoff = (unsigned)((wid * QBLK + r32) * LD + hi * 8);
#pragma unroll
  for (int d0 = 0; d0 < 8; ++d0) S.qr[d0] = load8(cur.Q + qoff + d0 * 16);
  SLOAD_H(cur.K, cur.V, 0); VMW(); SWRITE_HK(0);
  __syncthreads();
}
DI void fox_block(const BlockRef& cur, int Ln, const Params& P, LAS char* lds, Seam& S) {
  int tid = threadIdx.x; asm volatile("" : "+v"(tid));
  const int wid = __builtin_amdgcn_readfirstlane(tid >> 6), lane = tid & 63, r32 = lane & 31, hi = lane >> 5;
  int j_hi = (cur.P0 + QB - 1) / KVBLK + 1; if (j_hi > cur.skv / KVBLK) j_hi = cur.skv / KVBLK;
  const int NT = j_hi;
  const int qlo = cur.P0 + wid * QBLK, qm = qlo + r32 - 4 * hi;
  LAS char* V_lds = lds; LAS char* K_lds = lds + 2 * SHM_V;
  LAS float* ws = (LAS float*)(lds + 2 * SHM_V + 2 * SHM_K) + wid * 64; LAS float* li_l = ws; LAS float* al_l = ws + 32;
  const LAS float* tab = (const LAS float*)(lds + TAB_OFF);
  float m_reg = -1e30f, l_reg = 0; f32x16 o[4] = {};
  const int sr = tid >> 4, sc = (tid & 15) * 8, vst0 = v_st(sr, sc), kws = KSWZ(sr, sc * 2);
  constexpr int vst1d = 8192;
  const unsigned rowoff0 = (unsigned)(sr * LD + sc);
  const int vb0 = (int)(uintptr_t)V_lds + v_rd_base(lane);
  const bf16_t* Kh = cur.K; const bf16_t* Vh = cur.V;
#define RESC(a) do { if (__any((a) < 1.f)) { if (hi == 0) al_l[r32] = (a); asm volatile("s_waitcnt lgkmcnt(0)" ::: "memory");              \
                     for (int d_ = 0; d_ < 4; ++d_) for (int r = 0; r < 16; ++r) o[d_][r] *= al_l[crow(r, hi)]; } } while (0)
#define KBASE(t) ((t) * KVBLK)
#define MASKT(P0_, P1_, t) do { const int kb_ = KBASE(t); if (kb_ + KVBLK - 1 > qlo) mask_tile(P0_, P1_, qm - kb_, WBIG); } while (0)
#define SEAM_K0() do { VMWN(8); SWRITE_HK(0); SBAR(); } while (0)
  f32x16 pA0, pA1, pB0, pB1; float mnA, mnB, alA, alB; bf16x8 pa0, pa1, pa2, pa3;
  SWRITE_HV(0); SBAR();
  if (NT > 1) { SLOAD_H(Kh, Vh, KBASE(1)); }
  SBAR(); qkt<0>(pA0, pA1, K_lds, tab + KBASE(0), r32, hi, S.qr);
  MASKT(pA0, pA1, 0); partialSM(pA0, pA1, m_reg, mnA, alA);
  if (NT > 1) { VMW(); SWRITE_H(1); }
  __syncthreads();
#define HALF_STEP(PX0, PX1, mnX, alX, PY0, PY1, alY, t, KB, VB, SB) do {                                                      \
        SBAR(); qkt<KB>(PX0, PX1, K_lds, tab + KBASE(t), r32, hi, S.qr);                                             \
        finishSM(PY0, PY1, alY, l_reg, pa0, pa1, pa2, pa3); SBAR();                                                           \
        if ((t) + 1 < NT) { SLOAD_H(Kh, Vh, KBASE((t) + 1)); SBAR(); }                                               \
        pv_tile<VB>(o, vb0, pa0, pa1, pa2, pa3); MASKT(PX0, PX1, (t)); partialSM(PX0, PX1, m_reg, mnX, alX);                                        \
        __syncthreads();                                                                                                      \
        if ((t) + 1 < NT) { VMW(); SWRITE_H(SB); }                                                                          \
        RESC(alX); __syncthreads(); } while (0)
  for (int t = 1; t + 1 < NT; t += 2) {
    HALF_STEP(pB0, pB1, mnB, alB, pA0, pA1, alA, t, 1, 0, 0);
    HALF_STEP(pA0, pA1, mnA, alA, pB0, pB1, alB, t + 1, 0, 1, 1);
  }
  const bool even = (NT & 1) == 0;
  if (even) { SBAR(); qkt<1>(pB0, pB1, K_lds, tab + KBASE(NT - 1), r32, hi, S.qr); SBAR(); }
  const BlockRef nxt = (Ln < NFOX) ? fox_decode(P, Ln) : cur;
  SLOAD_H(nxt.K, nxt.V, 0); SBAR();
  unsigned qoff; { int l2 = lane; asm volatile("" : "+v"(l2)); qoff = (unsigned)((wid * QBLK + (l2 & 31)) * LD + (l2 >> 5) * 8); }
#pragma unroll
  for (int d0 = 0; d0 < 8; ++d0) S.qr[d0] = load8(nxt.Q + qoff + d0 * 16);
  SBAR();
  finishSM(pA0, pA1, alA, l_reg, pa0, pa1, pa2, pa3); SBAR();
  pv_tile<0>(o, vb0, pa0, pa1, pa2, pa3);
  if (even) { MASKT(pB0, pB1, NT - 1); partialSM(pB0, pB1, m_reg, mnB, alB); __syncthreads(); RESC(alB);
    finishSM(pB0, pB1, alB, l_reg, pa0, pa1, pa2, pa3); SBAR(); pv_tile<1>(o, vb0, pa0, pa1, pa2, pa3); }
  SBAR(); SEAM_K0();
  if (hi == 0) li_l[r32] = l_reg; asm volatile("s_waitcnt lgkmcnt(0)" ::: "memory");
  { int lane_o = lane; asm volatile("" : "+v"(lane_o));
    LAS char* stg = lds + OSTG_OFF + wid * 8448;
    const int rw = lane_o >> 4, cw = (lane_o & 15) * 8; const int r32 = lane_o & 31, hi = lane_o >> 5;
#pragma unroll
    for (int half = 0; half < 2; ++half) {
#pragma unroll
      for (int rr = 0; rr < 8; ++rr) { const int r = half * 8 + rr; const int orow = crow(r, hi); const float rl = __builtin_amdgcn_rcpf(li_l[orow]);
#pragma unroll
        for (int d0 = 0; d0 < 4; ++d0) *(LAS float*)(stg + (orow - 16 * half) * 528 + (d0 * 32 + r32) * 4) = o[d0][r] * rl; }
      asm volatile("s_waitcnt lgkmcnt(0)" ::: "memory");
#pragma unroll
      for (int i = 0; i < 4; ++i) { const int lr = i * 4 + rw; const int brow = wid * QBLK + half * 16 + lr;
        const f32x4 v0 = *(const LAS f32x4*)(stg + lr * 528 + cw * 4), v1 = *(const LAS f32x4*)(stg + lr * 528 + cw * 4 + 16);
        const u32x4 gw = *(const u32x4*)(cur.G + (unsigned)(brow * LD + cw));
        u32x4 ow; ow[0] = pk2(v0[0] * bflo(gw[0]), v0[1] * bfhi(gw[0])); ow[1] = pk2(v0[2] * bflo(gw[1]), v0[3] * bfhi(gw[1]));
        ow[2] = pk2(v1[0] * bflo(gw[2]), v1[1] * bfhi(gw[2])); ow[3] = pk2(v1[2] * bflo(gw[3]), v1[3] * bfhi(gw[3]));
        if (brow < cur.nvalid) *(u32x4*)(cur.O + (unsigned)(brow * LDO + cw)) = ow; }
      asm volatile("s_waitcnt lgkmcnt(0)" ::: "memory");
    } }
  __syncthreads();
#undef RESC
#undef KBASE
#undef MASKT
#undef SEAM_K0
#undef HALF_STEP
}
#undef ROW
#undef VMW
#undef VMWN
#undef SLOAD_H
#undef SWRITE_HK
#undef SWRITE_HV
#undef SWRITE_H
DI void build_bias(const float* src, int nkeys, LAS char* lds) {
  LAS float* tab = (LAS float*)(lds + TAB_OFF); LAS float* wsum = tab + 2048;
  int tid = threadIdx.x; asm volatile("" : "+v"(tid));
  const int lane = tid & 63, wid = tid >> 6;
  f32x4 v = {0.f, 0.f, 0.f, 0.f}; if (tid * 4 < nkeys) v = *(const f32x4*)(src + tid * 4);
  const float s0 = v[0], s1 = s0 + v[1], s2 = s1 + v[2], s3 = s2 + v[3];
  float incl = s3;
#pragma unroll
  for (int o = 1; o < 64; o <<= 1) { const int sl = lane >= o ? lane - o : lane;
    const float t = __int_as_float(__builtin_amdgcn_ds_bpermute(sl * 4, __float_as_int(incl))); if (lane >= o) incl += t; }
  if (lane == 63) wsum[wid] = incl;
  __syncthreads();
  float off = incl - s3;
  for (int w = 0; w < wid; ++w) off += wsum[w];
  const float kk = -11.313708498984761f;
  f32x4 o = {(off + s0) * kk, (off + s1) * kk, (off + s2) * kk, (off + s3) * kk};
  *(LAS f32x4*)(tab + tid * 4) = o;
  __syncthreads();
}
}

DI int fetch_item(unsigned* ctr, LAS char* lds) {
  volatile LAS int* slot = (volatile LAS int*)(lds + LDS_BYTES - 64);
  __syncthreads();
  if (threadIdx.x == 0) *slot = (int)atomicAdd(ctr, 1u);
  __syncthreads();
  return __builtin_amdgcn_readfirstlane(*slot);
}

DI void ssd_item(const Params& P, LAS unsigned char* lds, int item) {
  unsigned char* ws = P.ws;
  int tid = threadIdx.x; asm volatile("" : "+v"(tid));
  const int wid = __builtin_amdgcn_readfirstlane(tid >> 6), lane = tid & 63, r16 = lane & 15, q = lane >> 4;
  const bool sample = item >= 64; const int i2 = sample ? item - 64 : item; const int b = i2 >> 2, g = i2 & 3;
  const int nch = sample ? 1 : 32;
  const bf16_t* xbc = sample ? (const bf16_t*)(ws + W_XBCS) + (size_t)b * 67 * 3072 : (const bf16_t*)(ws + W_XBCP) + (size_t)b * 2051 * 3072;
  const size_t rowbase = sample ? (size_t)MP + b * 64 : (size_t)b * 2048;
  const int h = g * 8 + wid;
  const float A_h = -__expf(P.in[15][h]), dsk = P.in[16][h];
  const float* DT = (const float*)(ws + W_DT); const bf16_t* ZB = (const bf16_t*)(ws + W_ZB); bf16_t* Y3 = (bf16_t*)(ws + W_Y3); float* SSQP = (float*)(ws + W_SSQP);
  LAS unsigned char* Bs = lds; LAS unsigned char* Cs = lds + 17408; LAS unsigned char* BT = lds + 34816;
  LAS unsigned char* XT = lds + 53248 + wid * 9216;
  LAS float* acum_l = (LAS float*)(lds + 126976 + wid * 768); LAS float* dtv_l = acum_l + 64; LAS float* wend_l = acum_l + 128;
  f32x4 hT[8][4];
#pragma unroll
  for (int nt = 0; nt < 8; ++nt)
#pragma unroll
    for (int pt = 0; pt < 4; ++pt) {
      if (sample) hT[nt][pt] = *(const f32x4*)(P.in[6] + ((size_t)(b * 32 + h) * 64 + pt * 16 + r16) * 128 + nt * 16 + 4 * q);
      else hT[nt][pt] = (f32x4){0.f, 0.f, 0.f, 0.f};
    }
  const float* wconv = P.in[12]; const float* bconv = P.in[13];
  const int chx = h * 64 + lane;
  const float wx0 = wconv[chx], wx1 = wconv[3072 + chx], wx2 = wconv[2 * 3072 + chx], wx3 = wconv[3 * 3072 + chx], bx = bconv[chx];
  const int chn = tid & 255, th = tid >> 8; const bool isB = chn < 128;
  const int ch2 = isB ? 2048 + g * 128 + chn : 2560 + g * 128 + (chn - 128);
  const float wb0 = wconv[ch2], wb1 = wconv[3072 + ch2], wb2 = wconv[2 * 3072 + ch2], wb3 = wconv[3 * 3072 + ch2], bb = bconv[ch2];
  for (int c = 0; c < nch; ++c) {
    const int t0 = c * 64;
    float cdec;
    { const float dtl = DT[(rowbase + t0 + lane) * 32 + h]; float ac = dtl * A_h;
#pragma unroll
      for (int o = 1; o < 64; o <<= 1) { const float t = __shfl_up(ac, o); if (lane >= o) ac += t; }
      const float tot = __shfl(ac, 63);
      acum_l[lane] = ac; dtv_l[lane] = dtl; wend_l[lane] = __expf(tot - ac) * dtl; cdec = __expf(tot); }
    { const bf16_t* xp = xbc + (size_t)t0 * 3072 + chx;
      float r0 = bf2f(xp[0]), r1 = bf2f(xp[3072]), r2 = bf2f(xp[2 * 3072]);
#pragma unroll
      for (int s8 = 0; s8 < 8; ++s8) { float o[8];
#pragma unroll
        for (int i = 0; i < 8; ++i) { const float r3 = bf2f(xp[(size_t)(3 + s8 * 8 + i) * 3072]);
          o[i] = siluf_(bx + wx0 * r0 + wx1 * r1 + wx2 * r2 + wx3 * r3); r0 = r1; r1 = r2; r2 = r3; }
        u32x4 w = {pk2(o[0], o[1]), pk2(o[2], o[3]), pk2(o[4], o[5]), pk2(o[6], o[7])};
        *(LAS u32x4*)(XT + lane * 144 + s8 * 16) = w; } }
    __syncthreads();
    { const bf16_t* bp = xbc + (size_t)(t0 + th * 32) * 3072 + ch2;
      float r0 = bf2f(bp[0]), r1 = bf2f(bp[3072]), r2 = bf2f(bp[2 * 3072]);
#pragma unroll
      for (int s8 = 0; s8 < 4; ++s8) { float o[8];
#pragma unroll
        for (int i = 0; i < 8; ++i) { const float r3 = bf2f(bp[(size_t)(3 + s8 * 8 + i) * 3072]);
          o[i] = siluf_(bb + wb0 * r0 + wb1 * r1 + wb2 * r2 + wb3 * r3); r0 = r1; r1 = r2; r2 = r3; }
        u32x4 w = {pk2(o[0], o[1]), pk2(o[2], o[3]), pk2(o[4], o[5]), pk2(o[6], o[7])};
        const int sb = th * 32 + s8 * 8;
        if (isB) { *(LAS u32x4*)(BT + chn * 144 + sb * 2) = w;
#pragma unroll
          for (int i = 0; i < 8; ++i) *(LAS bf16_t*)(Bs + (sb + i) * 272 + chn * 2) = (bf16_t)((i & 1) ? (w[i >> 1] >> 16) : (w[i >> 1] & 0xffff)); }
        else {
#pragma unroll
          for (int i = 0; i < 8; ++i) *(LAS bf16_t*)(Cs + (sb + i) * 272 + (chn - 128) * 2) = (bf16_t)((i & 1) ? (w[i >> 1] >> 16) : (w[i >> 1] & 0xffff)); }
      } }
    __syncthreads();
    for (int lt = 0; lt < 4; ++lt) {
      const int l = lt * 16 + r16;
      f32x4 y[4];
#pragma unroll
      for (int pt = 0; pt < 4; ++pt) y[pt] = (f32x4){0.f, 0.f, 0.f, 0.f};
#pragma unroll
      for (int np = 0; np < 4; ++np) {
        const u32x2 clo = *(const LAS u32x2*)(Cs + l * 272 + (32 * np + 4 * q) * 2), chi = *(const LAS u32x2*)(Cs + l * 272 + (32 * np + 16 + 4 * q) * 2);
        const bf16x8 bfrag = cat8(clo, chi);
#pragma unroll
        for (int pt = 0; pt < 4; ++pt) y[pt] = MFMA16(pack8(hT[2 * np][pt], hT[2 * np + 1][pt]), bfrag, y[pt]);
      }
      const float al = acum_l[l]; const float el = __expf(al);
#pragma unroll
      for (int pt = 0; pt < 4; ++pt) y[pt] *= el;
      const int nsp = (lt >> 1) + 1;
      for (int sp = 0; sp < nsp; ++sp) {
        f32x4 cb0 = {0.f, 0.f, 0.f, 0.f}, cb1 = {0.f, 0.f, 0.f, 0.f};
#pragma unroll
        for (int ks = 0; ks < 4; ++ks) {
          const bf16x8 cf = *(const LAS bf16x8*)(Cs + l * 272 + (32 * ks + 8 * q) * 2);
          const bf16x8 b0 = *(const LAS bf16x8*)(Bs + (32 * sp + r16) * 272 + (32 * ks + 8 * q) * 2);
          const bf16x8 b1 = *(const LAS bf16x8*)(Bs + (32 * sp + 16 + r16) * 272 + (32 * ks + 8 * q) * 2);
          cb0 = MFMA16(b0, cf, cb0); cb1 = MFMA16(b1, cf, cb1);
        }
        const int s0 = 32 * sp + 4 * q, s1 = s0 + 16;
        const f32x4 as0 = *(const LAS f32x4*)(acum_l + s0), as1 = *(const LAS f32x4*)(acum_l + s1);
        const f32x4 d0 = *(const LAS f32x4*)(dtv_l + s0), d1 = *(const LAS f32x4*)(dtv_l + s1);
        f32x4 m0, m1;
#pragma unroll
        for (int e = 0; e < 4; ++e) {
          m0[e] = (s0 + e <= l) ? cb0[e] * __expf(al - as0[e]) * d0[e] : 0.f;
          m1[e] = (s1 + e <= l) ? cb1[e] * __expf(al - as1[e]) * d1[e] : 0.f;
        }
        const bf16x8 mfrag = pack8(m0, m1);
#pragma unroll
        for (int pt = 0; pt < 4; ++pt) { const int p = pt * 16 + r16;
          const u32x2 xlo = *(const LAS u32x2*)(XT + p * 144 + s0 * 2), xhi = *(const LAS u32x2*)(XT + p * 144 + s1 * 2);
          y[pt] = MFMA16(cat8(xlo, xhi), mfrag, y[pt]); }
      }
      const size_t row = rowbase + t0 + l;
      float ssq = 0.f;
#pragma unroll
      for (int pt = 0; pt < 4; ++pt) { const int p0 = pt * 16 + 4 * q;
        const f32x4 zz = ld_bf4(ZB + row * 2048 + h * 64 + p0);
        f32x4 v;
#pragma unroll
        for (int e = 0; e < 4; ++e) { const float xv = bf2f(*(const LAS bf16_t*)(XT + (p0 + e) * 144 + l * 2));
          v[e] = (y[pt][e] + dsk * xv) * zz[e]; ssq += v[e] * v[e]; }
        st_bf4(Y3 + row * 6144 + h * 64 + p0, v); }
      ssq += __shfl_xor(ssq, 16); ssq += __shfl_xor(ssq, 32);
      if (q == 0) SSQP[row * 32 + h] = ssq;
    }
#pragma unroll
    for (int nt = 0; nt < 8; ++nt)
#pragma unroll
      for (int pt = 0; pt < 4; ++pt) hT[nt][pt] *= cdec;
#pragma unroll
    for (int ks = 0; ks < 2; ++ks) {
      bf16x8 bfr[4];
      const f32x4 w0 = *(const LAS f32x4*)(wend_l + 32 * ks + 8 * q), w1 = *(const LAS f32x4*)(wend_l + 32 * ks + 8 * q + 4);
#pragma unroll
      for (int pt = 0; pt < 4; ++pt) { const int p = pt * 16 + r16;
        const u32x4 xr = *(const LAS u32x4*)(XT + p * 144 + (32 * ks + 8 * q) * 2);
        const f32x4 a = {bflo(xr[0]) * w0[0], bfhi(xr[0]) * w0[1], bflo(xr[1]) * w0[2], bfhi(xr[1]) * w0[3]};
        const f32x4 bq = {bflo(xr[2]) * w1[0], bfhi(xr[2]) * w1[1], bflo(xr[3]) * w1[2], bfhi(xr[3]) * w1[3]};
        bfr[pt] = pack8(a, bq); }
#pragma unroll
      for (int nt = 0; nt < 8; ++nt) { const bf16x8 af = *(const LAS bf16x8*)(BT + (nt * 16 + r16) * 144 + (32 * ks + 8 * q) * 2);
#pragma unroll
        for (int pt = 0; pt < 4; ++pt) hT[nt][pt] = MFMA16(af, bfr[pt], hT[nt][pt]); }
    }
  }
  float* so = P.out + (sample ? O_SSDS : O_SSDP) + (size_t)(b * 32 + h) * 8192;
#pragma unroll
  for (int nt = 0; nt < 8; ++nt)
#pragma unroll
    for (int pt = 0; pt < 4; ++pt) *(f32x4*)(so + (size_t)(pt * 16 + r16) * 128 + nt * 16 + 4 * q) = hT[nt][pt];
  __syncthreads();
}

__global__ __launch_bounds__(512) void mk_forward(Params Parg) {
#if defined(__HIP_DEVICE_COMPILE__)
  extern __shared__ __attribute__((aligned(16))) unsigned char lds_raw[];
  LAS unsigned char* lds = (LAS unsigned char*)lds_raw;
  cg::grid_group grid = cg::this_grid();
  const int G = gridDim.x, cblk = blockIdx.x;
  typedef __attribute__((address_space(4))) const Params* KP;
  const KP kp = (KP)__builtin_amdgcn_kernarg_segment_ptr();
#define PHASE_PARAMS() KP kq_ = kp; asm volatile("" : "+s"(kq_)); const Params P = *kq_; unsigned char* ws = P.ws; (void)ws
#ifndef PH
#define PH 255
#endif
  if (PH & 1) { PHASE_PARAMS(); phase0(P, lds); }
  grid.sync();
  if (PH & 2) { PHASE_PARAMS();
    SchedP1 S; S.c = cblk; S.G = G; S.XB = (const char*)(ws + W_XB); S.WIN = (const char*)(ws + W_WIN); S.MB = (const char*)(ws + W_MB); S.WMEM = (const char*)(ws + W_WMEM);
    EpiIn E; E.P = P; pg8::Gemm g; g.lda = 2048; g.ldb = 2048; g.K = 2048;
    pg8::gemm_phase(lds, g, S, E); }
  grid.sync();
  if (PH & 4) { PHASE_PARAMS();
    SchedS S; S.c = cblk; S.G = G; S.MQ = (const char*)(ws + W_MQ); S.MKP = (const char*)(ws + W_MKP); S.MKS = (const char*)(ws + W_MKS);
    EpiS E; E.P = P; pg8::Gemm g; g.lda = 2048; g.ldb = 2048; g.K = 512;
    pg8::gemm_phase(lds, g, S, E); }
  if (PH & 8) { PHASE_PARAMS(); unsigned* ctl = (unsigned*)(ws + W_CTL);
    for (;;) { const int it = fetch_item(ctl + 0, (LAS char*)lds_raw); if (it >= 96) break; ssd_item(P, lds, it); } }
  if (PH & 16) { PHASE_PARAMS(); unsigned* ctl = (unsigned*)(ws + W_CTL);
    LAS char* l8 = (LAS char*)lds_raw;
    int L = fetch_item(ctl + 16, l8);
    if (L < fa::NFOX) {
      fa::BlockRef cur = fa::fox_decode(P, L);
      fa::Seam S;
      fa::build_bias(cur.lf, cur.nkeys, l8);
      fa::fox_prime(cur, l8, S);
      for (;;) {
        const int Ln = fetch_item(ctl + 16, l8);
        fa::fox_block(cur, Ln, P, l8, S);
        if (Ln >= fa::NFOX) break;
        cur = fa::fox_decode(P, Ln);
        fa::build_bias(cur.lf, cur.nkeys, l8);
      }
    }
  }
  grid.sync();
  if (PH & 32) { PHASE_PARAMS();
    { const float* SSQP = (const float*)(ws + W_SSQP); float* RS = (float*)(ws + W_RS);
      int tid = threadIdx.x; asm volatile("" : "+v"(tid));
      for (int r = cblk * 512 + tid; r < MT; r += G * 512) { float s = 0.f;
#pragma unroll
        for (int j = 0; j < 8; ++j) { const f32x4 v = *(const f32x4*)(SSQP + (size_t)r * 32 + 4 * j); s += (v[0] + v[1]) + (v[2] + v[3]); }
        RS[r] = rsqrtf(s * (1.f / 2048.f) + EPS); } }
    SchedPV S; S.c = cblk; S.G = G; S.PM = (const char*)(ws + W_PM); S.VTP = (const char*)(ws + W_VTP); S.VTS = (const char*)(ws + W_VTS);
    EpiPV E; E.P = P; pg8::Gemm g; g.lda = 1024; g.ldb = 256; g.K = 256;
    pg8::gemm_phase(lds, g, S, E); }
  grid.sync();
  if (PH & 64) { PHASE_PARAMS();
    SchedMerge S; S.c = cblk; S.G = G; S.A = (const char*)(ws + W_Y3); S.B = (const char*)(ws + W_WO);
    EpiMerge E; E.P = P; pg8::Gemm g; g.lda = 6144; g.ldb = 6144; g.K = 2048;
    pg8::gemm_phase(lds, g, S, E); }
  grid.sync();
  if (PH & 128) { PHASE_PARAMS();
    SchedTile S; S.c = cblk; S.G = G; S.nM = 130; S.nN = 8; S.A = (const char*)(ws + W_MRG); S.B = (const char*)(ws + W_WOUT); S.astep = (size_t)256 * 2048 * 2; S.bstep = (size_t)256 * 2048 * 2;
    EpiOut E; E.P = P; pg8::Gemm g; g.lda = 2048; g.ldb = 2048; g.K = 2048;
    pg8::gemm_phase(lds, g, S, E); }
  grid.sync();
  { PHASE_PARAMS();
    const float* PARTO = (const float*)(ws + W_PARTO); const float* gf = P.in[25];
    int tid = threadIdx.x; asm volatile("" : "+v"(tid)); const int wid = tid >> 6, lane = tid & 63;
    for (int r = cblk * 8 + wid; r < MT; r += G * 8) {
      const float pv = lane < 32 ? PARTO[(size_t)r * 32 + lane] : 0.f;
      const float sc = rsqrtf(wave_sum(pv) * (1.f / 2048.f) + EPS);
      f32x4* y = (f32x4*)(P.out + (size_t)r * 2048) + lane; const f32x4* gv = (const f32x4*)gf + lane;
#pragma unroll
      for (int j = 0; j < 8; ++j) { f32x4 v = y[64 * j]; const f32x4 gg = gv[64 * j]; y[64 * j] = v * sc * gg; }
    } }
#endif
}

extern "C" void kernel_launch(void* const* d_in, const int* in_sizes, int n_in,
                              void* d_out, int out_size, void* d_ws, size_t ws_size,
                              hipStream_t stream) {
  static int grid = 0;
  if (grid == 0) {
    int dev = 0, cus = 0, per_cu = 0;
    (void)hipGetDevice(&dev);
    (void)hipDeviceGetAttribute(&cus, hipDeviceAttributeMultiprocessorCount, dev);
    (void)hipFuncSetAttribute((const void*)mk_forward, hipFuncAttributeMaxDynamicSharedMemorySize, LDS_BYTES);
    (void)hipOccupancyMaxActiveBlocksPerMultiprocessor(&per_cu, (const void*)mk_forward, 512, LDS_BYTES);
    if (per_cu < 1) per_cu = 1;
    grid = cus * per_cu;
    if (ws_size < W_END) { fprintf(stderr, "workspace too small: %zu < %zu\n", ws_size, (size_t)W_END); grid = -1; }
  }
  if (grid < 0) return;
  Params p{};
  for (int i = 0; i < 26; ++i) p.in[i] = (const float*)d_in[i];
  p.out = (float*)d_out; p.ws = (unsigned char*)d_ws;
  void* args[] = {&p};
  hipError_t e = hipLaunchCooperativeKernel((const void*)mk_forward, dim3(grid), dim3(512), args, LDS_BYTES, stream);
  if (e != hipSuccess) fprintf(stderr, "cooperative launch failed: %s (grid %d)\n", hipGetErrorString(e), grid);
}
```

```cpp
#include <hip/hip_runtime.h>
#include <hip/hip_cooperative_groups.h>
#include <cstdio>
#include <cstdint>
namespace cg = cooperative_groups;

#define LAS __attribute__((address_space(3)))
#define DI __device__ __forceinline__
typedef unsigned short bf16_t;
typedef short bf16x8 __attribute__((ext_vector_type(8)));
typedef short s16x4 __attribute__((ext_vector_type(4)));
typedef float f32x4 __attribute__((ext_vector_type(4)));
typedef float f32x16 __attribute__((ext_vector_type(16)));
typedef unsigned u32x4 __attribute__((ext_vector_type(4)));
typedef unsigned u32x2 __attribute__((ext_vector_type(2)));

constexpr int DM = 2048;
constexpr int MP = 32768, MS = 512, MT = MP + MS, MPADR = MT + 256;
constexpr int NIN = 23808;
constexpr int LDS_BYTES = 147456;
constexpr float EPS = 1e-6f;

constexpr long O_YP = 0;
constexpr long O_YS = 67108864L;
constexpr long O_FKP = O_YS + 1048576L;
constexpr long O_FVP = O_FKP + 67108864L;
constexpr long O_FLP = O_FVP + 67108864L;
constexpr long O_SSDP = O_FLP + 524288L;
constexpr long O_CONVP = O_SSDP + 4194304L;
constexpr long O_MKP = O_CONVP + 147456L;
constexpr long O_MVP = O_MKP + 8388608L;
constexpr long O_FKS = O_MVP + 8388608L;
constexpr long O_FVS = O_FKS + 1048576L;
constexpr long O_FLS = O_FVS + 1048576L;
constexpr long O_SSDS = O_FLS + 8192L;
constexpr long O_CONVS = O_SSDS + 2097152L;

constexpr size_t al256(size_t x) { return (x + 255) & ~(size_t)255; }
constexpr size_t W_CTL = 0;
constexpr size_t W_R1 = 4096;
constexpr size_t W_RM = al256(W_R1 + (size_t)MT * 4);
constexpr size_t W_RS = al256(W_RM + 4096 * 4);
constexpr size_t W_XB = al256(W_RS + (size_t)MT * 4);
constexpr size_t W_MB = al256(W_XB + (size_t)MT * DM * 2);
constexpr size_t W_WIN = al256(W_MB + (size_t)4096 * DM * 2);
constexpr size_t W_WMEM = al256(W_WIN + (size_t)NIN * DM * 2);
constexpr size_t W_WO = al256(W_WMEM + (size_t)4096 * DM * 2);
constexpr size_t W_WOUT = al256(W_WO + (size_t)2048 * 6144 * 2);
constexpr size_t W_ZB = al256(W_WOUT + (size_t)2048 * 2048 * 2);
constexpr size_t W_XBCP = al256(W_ZB + (size_t)MT * DM * 2);
constexpr size_t W_XBCS = al256(W_XBCP + (size_t)16 * 2051 * 3072 * 2);
constexpr size_t W_DT = al256(W_XBCS + (size_t)8 * 67 * 3072 * 2);
constexpr size_t W_FQ = al256(W_DT + (size_t)MT * 32 * 4);
constexpr size_t W_FK = al256(W_FQ + (size_t)MPADR * DM * 2);
constexpr size_t W_FV = al256(W_FK + (size_t)MP * DM * 2);
constexpr size_t W_KS = al256(W_FV + (size_t)MP * DM * 2);
constexpr size_t W_VS = al256(W_KS + (size_t)8 * 1088 * DM * 2);
constexpr size_t W_FG = al256(W_VS + (size_t)8 * 1088 * DM * 2);
constexpr size_t W_MQ = al256(W_FG + (size_t)MPADR * DM * 2);
constexpr size_t W_MG = al256(W_MQ + (size_t)MPADR * DM * 2);
constexpr size_t W_G3 = al256(W_MG + (size_t)MT * DM * 2);
constexpr size_t W_LFT = al256(W_G3 + (size_t)MT * 6144 * 2);
constexpr size_t W_LFS = al256(W_LFT + (size_t)256 * 2048 * 4);
constexpr size_t W_MKP = al256(W_LFS + (size_t)128 * 1088 * 4);
constexpr size_t W_VTP = al256(W_MKP + (size_t)4096 * DM * 2);
constexpr size_t W_MKS = al256(W_VTP + (size_t)4096 * DM * 2);
constexpr size_t W_VTS = al256(W_MKS + (size_t)2048 * DM * 2);
constexpr size_t W_PM = al256(W_VTS + (size_t)2048 * DM * 2);
constexpr size_t W_PSUM = al256(W_PM + (size_t)MPADR * 1024 * 2);
constexpr size_t W_Y3 = al256(W_PSUM + (size_t)MT * 16 * 4);
constexpr size_t W_SSQP = al256(W_Y3 + (size_t)MT * 6144 * 2);
constexpr size_t W_MRG = al256(W_SSQP + (size_t)MT * 32 * 4);
constexpr size_t W_PARTO = al256(W_MRG + (size_t)MT * DM * 2);
constexpr size_t W_TMP = al256(W_PARTO + (size_t)MT * 32 * 4);
constexpr size_t W_XCT = al256(W_TMP + (size_t)MT * DM * 4);
constexpr size_t W_BCN = al256(W_XCT + (size_t)520 * 32 * 4096 * 2);
constexpr size_t W_BTT = al256(W_BCN + (size_t)MT * 1024 * 2);
constexpr size_t W_END = al256(W_BTT + (size_t)520 * 4 * 8192 * 2);

struct Params { const float* in[26]; float* out; unsigned char* ws; };

DI unsigned pk2(float lo, float hi) { unsigned r; asm volatile("v_cvt_pk_bf16_f32 %0, %1, %2" : "=v"(r) : "v"(lo), "v"(hi)); return r; }
DI float bf2f(unsigned short b) { return __uint_as_float(((unsigned)b) << 16); }
DI float bflo(unsigned w) { return __uint_as_float(w << 16); }
DI float bfhi(unsigned w) { return __uint_as_float(w & 0xffff0000u); }
DI float sigmoidf_(float x) { return 1.f / (1.f + __expf(-x)); }
DI float siluf_(float x) { return x / (1.f + __expf(-x)); }
DI float softplusf_(float x) { return x > 20.f ? x : log1pf(__expf(x)); }
DI float wave_sum(float v) {
#pragma unroll
  for (int o = 1; o < 64; o <<= 1) v += __shfl_xor(v, o);
  return v;
}
DI bf16x8 pack8(f32x4 a, f32x4 b) {
  u32x4 w = {pk2(a[0], a[1]), pk2(a[2], a[3]), pk2(b[0], b[1]), pk2(b[2], b[3])};
  return __builtin_bit_cast(bf16x8, w);
}
DI bf16x8 cat8(u32x2 lo, u32x2 hi) { u32x4 w = {lo[0], lo[1], hi[0], hi[1]}; return __builtin_bit_cast(bf16x8, w); }
#define MFMA16(a, b, c) __builtin_amdgcn_mfma_f32_16x16x32_bf16((a), (b), (c), 0, 0, 0)

namespace pg8 {
constexpr int BM = 256, BK = 64, HALF = 128, HTB = HALF * BK * 2, STAGE_BYTES = 8 * HTB, NXCD = 8, WGM = 8;
DI int lds_byte(int r, int c) { const int st = (r >> 4) * 2 + (c >> 5), rr = r & 15, cc = c & 31, ob = rr * 64 + cc * 2; return st * 1024 + (ob ^ (((ob >> 9) & 1) << 5)); }
DI void stage_rc(int b, int& R, int& C) { const int st = b / 1024, sb = b % 1024, swz = sb ^ (((sb >> 9) & 1) << 5); R = (st >> 1) * 16 + swz / 64; C = (st & 1) * 32 + (swz % 64) / 2; }

struct Unit { const char* A; const char* B; int row0, col0, kind, nvalid, aux; };
struct Gemm { int lda, ldb, K; };

DI void tile_order(int L, int nM, int nN, int& pm, int& pn) {
  const int nwg = nM * nN; int wgid = L;
  { const int q = nwg / NXCD, r = nwg % NXCD, xcd = wgid % NXCD, off = wgid / NXCD; wgid = (xcd < r ? xcd * (q + 1) : r * (q + 1) + (xcd - r) * q) + off; }
  const int nig = WGM * nN, gid = wgid / nig, fm = gid * WGM, gsz = (nM - fm) < WGM ? (nM - fm) : WGM;
  pm = fm + ((wgid % nig) % gsz); pn = (wgid % nig) / gsz;
}

template <class Epi, class Sched>
DI void gemm_phase(LAS unsigned char* lds, const Gemm g, const Sched& S, const Epi& E) {
  int tid = threadIdx.x; asm volatile("" : "+v"(tid));
  const int wid = __builtin_amdgcn_readfirstlane(tid >> 6), lane = tid & 63, wr = wid >> 2, wc = wid & 3, fr = lane & 15, fq = lane >> 4;
  int K = g.K; asm volatile("" : "+s"(K));
  const int nt = K / BK;
  unsigned voffA[2], voffB[2];
#pragma unroll
  for (int i = 0; i < 2; ++i) { int R, C; stage_rc(tid * 16 + i * 8192, R, C);
    voffA[i] = (unsigned)(R * g.lda + C) * 2u; voffB[i] = (unsigned)(R * g.ldb + C) * 2u; }
  const size_t kstep = (size_t)(BK * 2);
  const size_t hstepA = (size_t)HALF * g.lda * 2, hstepB = (size_t)HALF * g.ldb * 2;
  const unsigned ldsw = (unsigned)wid * 1024u;
  const int aoff = lds_byte(wr * 64 + fr, fq * 8), boff = lds_byte(wc * 32 + fr, fq * 8);
#define PG8_SA(b, h) (((b) * 2 + (h)) * HTB)
#define PG8_SB(b, h) ((4 + (b) * 2 + (h)) * HTB)
#define PG8_STAGE(bufoff, gbase, voff) do { _Pragma("unroll") for (int _i = 0; _i < 2; ++_i) \
        __builtin_amdgcn_global_load_lds((const unsigned*)((const char*)(gbase) + (voff)[_i]), (LAS unsigned*)(lds + (bufoff) + ldsw + _i * 8192), 16, 0, 0); } while (0)
#define PG8_LDA(dst, b, h) do { _Pragma("unroll") for (int m = 0; m < 4; ++m) _Pragma("unroll") for (int k = 0; k < 2; ++k) dst[m][k] = *(const LAS bf16x8*)(lds + PG8_SA(b, h) + aoff + m * 2048 + k * 1024); } while (0)
#define PG8_LDB(dst, b, h) do { _Pragma("unroll") for (int n = 0; n < 2; ++n) _Pragma("unroll") for (int k = 0; k < 2; ++k) dst[n][k] = *(const LAS bf16x8*)(lds + PG8_SB(b, h) + boff + n * 2048 + k * 1024); } while (0)
#define PG8_MMA(ai, bj, At, Bt) do { __builtin_amdgcn_s_setprio(1); _Pragma("unroll") for (int m = 0; m < 4; ++m) _Pragma("unroll") for (int n = 0; n < 2; ++n) _Pragma("unroll") for (int k = 0; k < 2; ++k) \
        acc[ai][bj][m][n] = __builtin_amdgcn_mfma_f32_16x16x32_bf16(Bt[n][k], At[m][k], acc[ai][bj][m][n], 0, 0, 0); __builtin_amdgcn_s_setprio(0); } while (0)
#define PG8_WAIT_V(n) asm volatile("s_waitcnt vmcnt(" #n ")" ::: "memory")
#define PG8_WAIT_L(n) asm volatile("s_waitcnt lgkmcnt(" #n ")" ::: "memory")
#define PG8_BAR __builtin_amdgcn_s_barrier()
#define PG8_SCHED __builtin_amdgcn_sched_barrier(0)
  Unit cur, nxt; int ui = 0;
  if (!S.next(0, cur)) return;
  f32x4 acc[2][2][4][2];
#pragma unroll
  for (int a = 0; a < 2; ++a)
#pragma unroll
    for (int b = 0; b < 2; ++b)
#pragma unroll
      for (int m = 0; m < 4; ++m)
#pragma unroll
        for (int n = 0; n < 2; ++n) acc[a][b][m][n] = (f32x4){0.f, 0.f, 0.f, 0.f};
  bf16x8 At[4][2], B0[2][2], B1[2][2];
  const char* cA = cur.A; const char* cB = cur.B;
  PG8_STAGE(PG8_SB(0, 0), cB, voffB); PG8_STAGE(PG8_SA(0, 0), cA, voffA); PG8_STAGE(PG8_SB(0, 1), cB + hstepB, voffB); PG8_STAGE(PG8_SA(0, 1), cA + hstepA, voffA);
  if (wr == 1) PG8_BAR;
  PG8_WAIT_V(4); PG8_BAR;
  PG8_STAGE(PG8_SB(1, 0), cB + kstep, voffB); PG8_STAGE(PG8_SA(1, 0), cA + kstep, voffA); PG8_STAGE(PG8_SB(1, 1), cB + hstepB + kstep, voffB);
  PG8_WAIT_V(6); PG8_BAR;
  for (;;) {
    const bool has_next = S.next(ui + 1, nxt);
    const char* nA = has_next ? nxt.A : cA; const char* nB = has_next ? nxt.B : cB;
    for (int t = 0; t < nt; t += 2) {
      const bool last = (t == nt - 2);
      if constexpr (Epi::HOOK) { if (t == 32 || t == 64) E.rescale(acc, cur, t >> 5, wr, wc, fr, fq); }
      const char* a1 = cA + (size_t)(t + 1) * kstep;
      const char* a2 = last ? nA : cA + (size_t)(t + 2) * kstep; const char* b2 = last ? nB : cB + (size_t)(t + 2) * kstep;
      const char* a3 = a2 + kstep; const char* b3 = b2 + kstep;
      PG8_LDB(B0, 0, 0); PG8_SCHED; PG8_LDA(At, 0, 0); PG8_STAGE(PG8_SA(1, 1), a1 + hstepA, voffA);
      PG8_WAIT_L(8); PG8_BAR; PG8_WAIT_L(0); PG8_MMA(0, 0, At, B0); PG8_BAR; PG8_SCHED;
      PG8_LDB(B1, 0, 1); PG8_STAGE(PG8_SB(0, 0), b2, voffB);
      PG8_BAR; PG8_WAIT_L(0); PG8_MMA(0, 1, At, B1); PG8_BAR;
      PG8_LDA(At, 0, 1); PG8_STAGE(PG8_SA(0, 0), a2, voffA);
      PG8_BAR; PG8_WAIT_L(0); PG8_MMA(1, 0, At, B0); PG8_BAR; PG8_SCHED;
      PG8_STAGE(PG8_SB(0, 1), b2 + hstepB, voffB);
      PG8_WAIT_V(6); PG8_BAR; PG8_MMA(1, 1, At, B1); PG8_BAR;
      PG8_LDB(B0, 1, 0); PG8_SCHED; PG8_LDA(At, 1, 0); PG8_STAGE(PG8_SA(0, 1), a2 + hstepA, voffA);
      PG8_WAIT_L(8); PG8_BAR; PG8_WAIT_L(0); PG8_MMA(0, 0, At, B0); PG8_BAR; PG8_SCHED;
      PG8_LDB(B1, 1, 1); PG8_STAGE(PG8_SB(1, 0), b3, voffB);
      PG8_BAR; PG8_WAIT_L(0); PG8_MMA(0, 1, At, B1); PG8_BAR;
      PG8_LDA(At, 1, 1); PG8_STAGE(PG8_SA(1, 0), a3, voffA);
      PG8_BAR; PG8_WAIT_L(0); PG8_MMA(1, 0, At, B0); PG8_BAR; PG8_SCHED;
      PG8_STAGE(PG8_SB(1, 1), b3 + hstepB, voffB);
      PG8_WAIT_V(6); PG8_BAR; PG8_MMA(1, 1, At, B1); PG8_BAR;
    }
    E(acc, cur, wr, wc, fr, fq);
    if (!has_next) break;
#pragma unroll
    for (int a = 0; a < 2; ++a)
#pragma unroll
      for (int b = 0; b < 2; ++b)
#pragma unroll
        for (int m = 0; m < 4; ++m)
#pragma unroll
          for (int n = 0; n < 2; ++n) acc[a][b][m][n] = (f32x4){0.f, 0.f, 0.f, 0.f};
    cur = nxt; cA = nA; cB = nB; ++ui;
  }
  PG8_WAIT_V(0);
  if (wr == 0) PG8_BAR;
  PG8_BAR;
#undef PG8_SA
#undef PG8_SB
#undef PG8_STAGE
#undef PG8_LDA
#undef PG8_LDB
#undef PG8_MMA
#undef PG8_WAIT_V
#undef PG8_WAIT_L
#undef PG8_BAR
#undef PG8_SCHED
}
}
using pg8::Unit;
typedef const f32x4 (&AccRef)[2][2][4][2];

DI void st_bf4(bf16_t* p, f32x4 v) { u32x2 w = {pk2(v[0], v[1]), pk2(v[2], v[3])}; *(u32x2*)p = w; }
DI f32x4 ld_bf4(const bf16_t* p) { u32x2 w = *(const u32x2*)p; return (f32x4){bflo(w[0]), bfhi(w[0]), bflo(w[1]), bfhi(w[1])}; }

struct EpiIn {
  static constexpr bool HOOK = false;
  Params P;
  DI void rescale(f32x4 (&)[2][2][4][2], const Unit&, int, int, int, int, int) const {}
  DI void operator()(AccRef acc, const Unit& u, int wr, int wc, int fr, int fq) const {
    unsigned char* ws = P.ws; float* out = P.out;
    if (u.kind == 1) {
      const float* RM = (const float*)(ws + W_RM);
      const bool isV = u.col0 >= 2048; const int cb = isV ? u.col0 - 2048 : u.col0;
      float* fo = out + (isV ? O_MVP : O_MKP);
      bf16_t* MKP = (bf16_t*)(ws + W_MKP); bf16_t* VTP = (bf16_t*)(ws + W_VTP);
#pragma unroll
      for (int ai = 0; ai < 2; ++ai)
#pragma unroll
        for (int m = 0; m < 4; ++m) {
          const int row = u.row0 + ai * 128 + wr * 64 + m * 16 + fr; const float r = RM[row];
#pragma unroll
          for (int bj = 0; bj < 2; ++bj)
#pragma unroll
            for (int n = 0; n < 2; ++n) {
              const int c = cb + bj * 128 + wc * 32 + n * 16 + 4 * fq;
              const f32x4 v = acc[ai][bj][m][n] * r;
              *(f32x4*)(fo + (size_t)row * 2048 + c) = v;
              if (!isV) st_bf4(MKP + (size_t)row * 2048 + c, v);
              else { const int b = row >> 8, key = row & 255, h = c >> 9, d = c & 511;
                bf16_t* vt = VTP + ((size_t)((b * 4 + h) * 512 + d)) * 256 + key;
                const unsigned w0 = pk2(v[0], v[1]), w1 = pk2(v[2], v[3]);
                vt[0] = (bf16_t)(w0 & 0xffff); vt[256] = (bf16_t)(w0 >> 16); vt[512] = (bf16_t)(w1 & 0xffff); vt[768] = (bf16_t)(w1 >> 16); }
            }
        }
      return;
    }
    const float* R1 = (const float*)(ws + W_R1);
    const bool sample = u.row0 >= MP;
    const int T = sample ? 64 : 2048;
    const int col0 = u.col0;
    if (col0 >= 23552) {
      if (wc > 1) return;
      const float* dtb = P.in[14]; const float* bfg = P.in[18];
      float* DT = (float*)(ws + W_DT);
      float* LFT = (float*)(ws + W_LFT); float* LFS = (float*)(ws + W_LFS);
#pragma unroll
      for (int ai = 0; ai < 2; ++ai)
#pragma unroll
        for (int m = 0; m < 4; ++m) {
          const int row = u.row0 + ai * 128 + wr * 64 + m * 16 + fr; const float r = R1[row];
          const int rs = row - MP; const int b = sample ? (rs >> 6) : (row >> 11), t = sample ? (rs & 63) : (row & 2047);
#pragma unroll
          for (int n = 0; n < 2; ++n) {
            const int c = wc * 32 + n * 16 + 4 * fq;
            const f32x4 v = acc[ai][0][m][n] * r;
            if (c < 32) { f32x4 o;
#pragma unroll
              for (int e = 0; e < 4; ++e) o[e] = softplusf_(v[e] + dtb[c + e]);
              *(f32x4*)(DT + (size_t)row * 32 + c) = o; }
            else if (c < 48) { const int h0 = c - 32; f32x4 o;
#pragma unroll
              for (int e = 0; e < 4; ++e) o[e] = -softplusf_(-(v[e] + bfg[h0 + e]));
              float* lo = sample ? out + O_FLS + (size_t)rs * 16 + h0 : out + O_FLP + (size_t)row * 16 + h0;
              *(f32x4*)lo = o;
#pragma unroll
              for (int e = 0; e < 4; ++e) { if (sample) LFS[(size_t)(b * 16 + h0 + e) * 1088 + 1024 + t] = o[e]; else LFT[(size_t)(b * 16 + h0 + e) * 2048 + t] = o[e]; }
            }
          }
        }
      return;
    }
    int act = 0, ld = 2048, c0, rowmode = 0; bf16_t* dst; float* fout = nullptr; float* convout = nullptr;
    if (col0 < 2048) { act = 1; dst = (bf16_t*)(ws + W_ZB); c0 = col0; }
    else if (col0 < 5120) { rowmode = 1; ld = 3072; dst = (bf16_t*)(ws + (sample ? W_XBCS : W_XBCP)); c0 = col0 - 2048; convout = out + (sample ? O_CONVS : O_CONVP); }
    else if (col0 < 7168) { dst = (bf16_t*)(ws + W_FQ); c0 = col0 - 5120; }
    else if (col0 < 9216) { rowmode = 2; dst = (bf16_t*)(ws + (sample ? W_KS : W_FK)); c0 = col0 - 7168; fout = out + (sample ? O_FKS : O_FKP); }
    else if (col0 < 11264) { rowmode = 2; dst = (bf16_t*)(ws + (sample ? W_VS : W_FV)); c0 = col0 - 9216; fout = out + (sample ? O_FVS : O_FVP); }
    else if (col0 < 13312) { act = 1; dst = (bf16_t*)(ws + W_FG); c0 = col0 - 11264; }
    else if (col0 < 15360) { dst = (bf16_t*)(ws + W_MQ); c0 = col0 - 13312; }
    else if (col0 < 17408) { act = 1; dst = (bf16_t*)(ws + W_MG); c0 = col0 - 15360; }
    else { act = 2; ld = 6144; dst = (bf16_t*)(ws + W_G3); c0 = col0 - 17408; }
#pragma unroll
    for (int ai = 0; ai < 2; ++ai)
#pragma unroll
      for (int m = 0; m < 4; ++m) {
        const int row = u.row0 + ai * 128 + wr * 64 + m * 16 + fr; const float r = R1[row];
        const int rs = row - MP; const int b = sample ? (rs >> 6) : (row >> 11), t = sample ? (rs & 63) : (row & 2047);
        size_t drow = (size_t)row;
        if (rowmode == 1) drow = sample ? (size_t)(b * 67 + 3 + t) : (size_t)(b * 2051 + 3 + t);
        else if (rowmode == 2) drow = sample ? (size_t)(b * 1088 + 1024 + t) : (size_t)row;
        const size_t frow = sample ? (size_t)rs : (size_t)row;
#pragma unroll
        for (int bj = 0; bj < 2; ++bj)
#pragma unroll
          for (int n = 0; n < 2; ++n) {
            const int c = c0 + bj * 128 + wc * 32 + n * 16 + 4 * fq;
            f32x4 v = acc[ai][bj][m][n] * r;
            if (fout) *(f32x4*)(fout + frow * 2048 + c) = v;
            if (convout && t >= T - 3) *(f32x4*)(convout + (size_t)(b * 3 + t - (T - 3)) * 3072 + c) = v;
            if (act == 1) {
#pragma unroll
              for (int e = 0; e < 4; ++e) v[e] = siluf_(v[e]);
            } else if (act == 2) {
#pragma unroll
              for (int e = 0; e < 4; ++e) v[e] = sigmoidf_(v[e]);
            }
            st_bf4(dst + drow * ld + c, v);
          }
      }
  }
};
struct SchedP1 {
  int c, G; const char* XB; const char* WIN; const char* MB; const char* WMEM;
  DI bool next(int i, Unit& u) const {
    const int L = i * G + c;
    constexpr int N1 = 130 * 93;
    if (L < N1) { int pm, pn; pg8::tile_order(L, 130, 93, pm, pn);
      u.A = XB + (size_t)pm * 256 * 2048 * 2; u.B = WIN + (size_t)pn * 256 * 2048 * 2; u.row0 = pm * 256; u.col0 = pn * 256; u.kind = 0; u.nvalid = 256; u.aux = 0; return true; }
    const int L2 = L - N1; if (L2 >= 256) return false;
    int pm, pn; pg8::tile_order(L2, 16, 16, pm, pn);
    u.A = MB + (size_t)pm * 256 * 2048 * 2; u.B = WMEM + (size_t)pn * 256 * 2048 * 2; u.row0 = pm * 256; u.col0 = pn * 256; u.kind = 1; u.nvalid = 256; u.aux = 0; return true;
  }
};

struct EpiS {
  static constexpr bool HOOK = false;
  Params P;
  DI void rescale(f32x4 (&)[2][2][4][2], const Unit&, int, int, int, int, int) const {}
  DI void operator()(AccRef acc, const Unit& u, int wr, int wc, int fr, int fq) const {
    bf16_t* PM = (bf16_t*)(P.ws + W_PM); float* PSUM = (float*)(P.ws + W_PSUM);
    const float c2 = 0.044194173824159216f * 1.4426950408889634f;
    const int h = u.aux;
#pragma unroll
    for (int ai = 0; ai < 2; ++ai)
#pragma unroll
      for (int m = 0; m < 4; ++m) {
        const int rr = ai * 128 + wr * 64 + m * 16 + fr; const int row = u.row0 + rr; const bool ok = rr < u.nvalid;
        float s = 0.f;
#pragma unroll
        for (int bj = 0; bj < 2; ++bj)
#pragma unroll
          for (int n = 0; n < 2; ++n) {
            const int c = bj * 128 + wc * 32 + n * 16 + 4 * fq;
            f32x4 e;
#pragma unroll
            for (int k = 0; k < 4; ++k) { e[k] = __builtin_amdgcn_exp2f(fminf(acc[ai][bj][m][n][k] * c2, 100.f)); s += e[k]; }
            if (ok) st_bf4(PM + (size_t)row * 1024 + h * 256 + c, e);
          }
        s += __shfl_xor(s, 16); s += __shfl_xor(s, 32);
        if (ok && fq == 0) PSUM[(size_t)row * 16 + h * 4 + wc] = s;
      }
  }
};
struct SchedS {
  int c, G; const char* MQ; const char* MKP; const char* MKS;
  DI bool next(int i, Unit& u) const {
    const int L = i * G + c; if (L >= 544) return false;
    u.col0 = 0; u.kind = 0;
    if (L < 512) { const int b = L >> 5, h = (L >> 3) & 3, mt = L & 7; u.row0 = b * 2048 + mt * 256; u.nvalid = 256; u.aux = h;
      u.A = MQ + ((size_t)u.row0 * 2048 + h * 512) * 2; u.B = MKP + ((size_t)(b * 256) * 2048 + h * 512) * 2; }
    else { const int j = L - 512, b = j >> 2, h = j & 3; u.row0 = MP + b * 64; u.nvalid = 64; u.aux = h;
      u.A = MQ + ((size_t)u.row0 * 2048 + h * 512) * 2; u.B = MKS + ((size_t)(b * 256) * 2048 + h * 512) * 2; }
    return true;
  }
};
struct EpiPV {
  static constexpr bool HOOK = false;
  Params P;
  DI void rescale(f32x4 (&)[2][2][4][2], const Unit&, int, int, int, int, int) const {}
  DI void operator()(AccRef acc, const Unit& u, int wr, int wc, int fr, int fq) const {
    const float* PSUM = (const float*)(P.ws + W_PSUM); const bf16_t* MG = (const bf16_t*)(P.ws + W_MG); bf16_t* Y3 = (bf16_t*)(P.ws + W_Y3);
    const int h = u.aux >> 9;
#pragma unroll
    for (int ai = 0; ai < 2; ++ai)
#pragma unroll
      for (int m = 0; m < 4; ++m) {
        int rr = ai * 128 + wr * 64 + m * 16 + fr; asm volatile("" : "+v"(rr)); const int row = u.row0 + rr;
        __builtin_amdgcn_sched_barrier(0);
        if (rr < u.nvalid) {
          const f32x4 ps = *(const f32x4*)(PSUM + (size_t)row * 16 + h * 4);
          const float inv = 1.f / ((ps[0] + ps[1]) + (ps[2] + ps[3]));
#pragma unroll
          for (int bj = 0; bj < 2; ++bj)
#pragma unroll
            for (int n = 0; n < 2; ++n) {
              const int c = u.aux + bj * 128 + wc * 32 + n * 16 + 4 * fq;
              const f32x4 gte = ld_bf4(MG + (size_t)row * 2048 + c);
              st_bf4(Y3 + (size_t)row * 6144 + 4096 + c, acc[ai][bj][m][n] * gte * inv);
            }
        }
      }
  }
};
struct SchedPV {
  int c, G; const char* PM; const char* VTP; const char* VTS;
  DI bool next(int i, Unit& u) const {
    const int L = i * G + c; if (L >= 1088) return false;
    u.col0 = 0; u.kind = 0;
    if (L < 1024) { const int b = L >> 6, h = (L >> 4) & 3, mt = (L >> 1) & 7, n2 = L & 1; u.row0 = b * 2048 + mt * 256; u.nvalid = 256; u.aux = h * 512 + n2 * 256;
      u.A = PM + ((size_t)u.row0 * 1024 + h * 256) * 2; u.B = VTP + ((size_t)((b * 4 + h) * 512 + n2 * 256) * 256) * 2; }
    else { const int j = L - 1024, b = j >> 3, h = (j >> 1) & 3, n2 = j & 1; u.row0 = MP + b * 64; u.nvalid = 64; u.aux = h * 512 + n2 * 256;
      u.A = PM + ((size_t)u.row0 * 1024 + h * 256) * 2; u.B = VTS + ((size_t)((b * 4 + h) * 512 + n2 * 256) * 256) * 2; }
    return true;
  }
};

struct EpiMerge {
  static constexpr bool HOOK = false;
  Params P;
  DI void rescale(f32x4 (&)[2][2][4][2], const Unit&, int, int, int, int, int) const {}
  DI void operator()(AccRef acc, const Unit& u, int wr, int wc, int fr, int fq) const {
    const bf16_t* G3 = (const bf16_t*)(P.ws + W_G3); bf16_t* MRG = (bf16_t*)(P.ws + W_MRG); float* TMP = (float*)(P.ws + W_TMP);
    const float* RS = (const float*)(P.ws + W_RS);
    const int seg = u.kind;
#pragma unroll
    for (int ai = 0; ai < 2; ++ai)
#pragma unroll
      for (int m = 0; m < 4; ++m) {
        int row = u.row0 + ai * 128 + wr * 64 + m * 16 + fr; asm volatile("" : "+v"(row));
        const float rs = (seg == 0) ? RS[row] : 1.f;
#pragma unroll
        for (int bj = 0; bj < 2; ++bj)
#pragma unroll
          for (int n = 0; n < 2; ++n) {
            const int c = u.col0 + bj * 128 + wc * 32 + n * 16 + 4 * fq;
            const f32x4 gte = ld_bf4(G3 + (size_t)row * 6144 + seg * 2048 + c);
            f32x4 v = acc[ai][bj][m][n] * gte * rs;
            float* tp = TMP + (size_t)row * 2048 + c;
            if (seg > 0) v += *(const f32x4*)tp;
            if (seg < 2) *(f32x4*)tp = v; else st_bf4(MRG + (size_t)row * 2048 + c, v);
          }
        __builtin_amdgcn_sched_barrier(0);
      }
  }
};
struct SchedMerge {
  int c, G; const char* A; const char* B;
  DI bool next(int i, Unit& u) const {
    const int ti = i / 3, seg = i - ti * 3; const int L = ti * G + c; if (L >= 130 * 8) return false;
    int pm, pn; pg8::tile_order(L, 130, 8, pm, pn);
    u.A = A + ((size_t)pm * 256 * 6144 + seg * 2048) * 2; u.B = B + ((size_t)pn * 256 * 6144 + seg * 2048) * 2; u.row0 = pm * 256; u.col0 = pn * 256; u.kind = seg; u.nvalid = 256; u.aux = pn; return true;
  }
};
struct SchedTile {
  int c, G, nM, nN; const char* A; const char* B; size_t astep, bstep;
  DI bool next(int i, Unit& u) const {
    const int L = i * G + c; if (L >= nM * nN) return false;
    int pm, pn; pg8::tile_order(L, nM, nN, pm, pn);
    u.A = A + (size_t)pm * astep; u.B = B + (size_t)pn * bstep; u.row0 = pm * 256; u.col0 = pn * 256; u.kind = 0; u.nvalid = 256; u.aux = pn; return true;
  }
};
struct EpiOut {
  static constexpr bool HOOK = false;
  Params P;
  DI void rescale(f32x4 (&)[2][2][4][2], const Unit&, int, int, int, int, int) const {}
  DI void operator()(AccRef acc, const Unit& u, int wr, int wc, int fr, int fq) const {
    float* out = P.out; float* PARTO = (float*)(P.ws + W_PARTO);
    const bool sample = u.row0 >= MP;
    const float* xin = sample ? P.in[1] - (size_t)MP * 2048 : P.in[0];
#pragma unroll
    for (int ai = 0; ai < 2; ++ai)
#pragma unroll
      for (int m = 0; m < 4; ++m) {
        const int row = u.row0 + ai * 128 + wr * 64 + m * 16 + fr;
        float s = 0.f;
#pragma unroll
        for (int bj = 0; bj < 2; ++bj)
#pragma unroll
          for (int n = 0; n < 2; ++n) {
            const int c = u.col0 + bj * 128 + wc * 32 + n * 16 + 4 * fq;
            const f32x4 xo = acc[ai][bj][m][n] + *(const f32x4*)(xin + (size_t)row * 2048 + c);
            *(f32x4*)(out + (size_t)row * 2048 + c) = xo;
            s += xo[0] * xo[0] + xo[1] * xo[1] + xo[2] * xo[2] + xo[3] * xo[3];
          }
        s += __shfl_xor(s, 16); s += __shfl_xor(s, 32);
        if (fq == 0) PARTO[(size_t)row * 32 + u.aux * 4 + wc] = s;
      }
  }
};

DI void row_to_bf16(const float* src, bf16_t* dst, float* rs, int lane) {
  const f32x4* s = (const f32x4*)src + lane; f32x4 v[8]; float ss = 0.f;
#pragma unroll
  for (int j = 0; j < 8; ++j) { v[j] = s[64 * j]; ss += (v[j][0] * v[j][0] + v[j][1] * v[j][1]) + (v[j][2] * v[j][2] + v[j][3] * v[j][3]); }
  if (rs) { ss = wave_sum(ss); if (lane == 0) *rs = rsqrtf(ss * (1.f / 2048.f) + EPS); }
  u32x2* d = (u32x2*)dst + lane;
#pragma unroll
  for (int j = 0; j < 8; ++j) { u32x2 w = {pk2(v[j][0], v[j][1]), pk2(v[j][2], v[j][3])}; d[64 * j] = w; }
}
DI void transpose_item(const float* W, int ldw, int scol0, int nvalid, const float* scale, bf16_t* WT, int ldd, int drow0, int dcol0, int kb, LAS float* scr, int lane) {
  const int k0 = 64 * kb;
#pragma unroll 8
  for (int i = 0; i < 32; ++i) { const int kk = 2 * i + (lane >> 5), n = lane & 31;
    float v = 0.f; if (n < nvalid) { v = W[(size_t)(k0 + kk) * ldw + scol0 + n]; if (scale) v *= scale[k0 + kk]; }
    scr[kk * 33 + n] = v; }
  asm volatile("s_waitcnt lgkmcnt(0)" ::: "memory");
  const int c = lane & 7;
#pragma unroll
  for (int j = 0; j < 4; ++j) { const int n = (lane >> 3) + 8 * j; const LAS float* s = scr + (8 * c) * 33 + n;
    u32x4 o; o[0] = pk2(s[0 * 33], s[1 * 33]); o[1] = pk2(s[2 * 33], s[3 * 33]); o[2] = pk2(s[4 * 33], s[5 * 33]); o[3] = pk2(s[6 * 33], s[7 * 33]);
    *(u32x4*)(WT + (size_t)(drow0 + n) * ldd + dcol0 + k0 + 8 * c) = o; }
  asm volatile("s_waitcnt lgkmcnt(0)" ::: "memory");
}
DI void phase0(const Params& P, LAS unsigned char* lds) {
  unsigned char* ws = P.ws;
  int tid = threadIdx.x; asm volatile("" : "+v"(tid));
  const int wid = tid >> 6, lane = tid & 63;
  const int gw = blockIdx.x * 8 + wid, NGW = gridDim.x * 8;
  if (blockIdx.x == 0 && tid < 64) ((unsigned*)(ws + W_CTL))[tid] = 0u;
  constexpr int NR = MT + 4096 + 8192 + 8192 + 2048;
  for (int r = gw; r < NR; r += NGW) {
    if (r < MP) row_to_bf16(P.in[0] + (size_t)r * 2048, (bf16_t*)(ws + W_XB) + (size_t)r * 2048, (float*)(ws + W_R1) + r, lane);
    else if (r < MT) row_to_bf16(P.in[1] + (size_t)(r - MP) * 2048, (bf16_t*)(ws + W_XB) + (size_t)r * 2048, (float*)(ws + W_R1) + r, lane);
    else if (r < MT + 4096) { const int q = r - MT; row_to_bf16(P.in[2] + (size_t)q * 2048, (bf16_t*)(ws + W_MB) + (size_t)q * 2048, (float*)(ws + W_RM) + q, lane); }
    else if (r < MT + 4096 + 8192) { const int q = r - MT - 4096, b = q >> 10, j = q & 1023; row_to_bf16(P.in[3] + (size_t)q * 2048, (bf16_t*)(ws + W_KS) + (size_t)(b * 1088 + j) * 2048, nullptr, lane); }
    else if (r < MT + 4096 + 16384) { const int q = r - MT - 4096 - 8192, b = q >> 10, j = q & 1023; row_to_bf16(P.in[4] + (size_t)q * 2048, (bf16_t*)(ws + W_VS) + (size_t)(b * 1088 + j) * 2048, nullptr, lane); }
    else { const int q = r - MT - 4096 - 16384; row_to_bf16(P.in[8] + (size_t)q * 2048, (bf16_t*)(ws + W_MKS) + (size_t)q * 2048, nullptr, lane); }
  }
  LAS float* scr = (LAS float*)(lds + wid * 8448);
  constexpr int I_IN = 744 * 32, I_MEM = 128 * 32, I_O = 64 * 32;
  constexpr int NITEMS = I_IN + I_MEM + 4 * I_O;
  for (int it = gw; it < NITEMS; it += NGW) {
    int r = it;
    if (r < I_IN) { const int nb = r >> 5, kb = r & 31, d = nb * 32; int src, nv = 32;
      if (d < 5120) src = d; else if (d < 13312) src = d + 32; else if (d < 23552) src = d + 48;
      else if (d == 23552) src = 5120; else if (d == 23584) { src = 13344; nv = 16; } else { src = 0; nv = 0; }
      transpose_item(P.in[11], 23600, src, nv, P.in[10], (bf16_t*)(ws + W_WIN), 2048, d, 0, kb, scr, lane); continue; }
    r -= I_IN;
    if (r < I_MEM) { const int nb = r >> 5, kb = r & 31; transpose_item(P.in[20], 4096, nb * 32, 32, P.in[19], (bf16_t*)(ws + W_WMEM), 2048, nb * 32, 0, kb, scr, lane); continue; }
    r -= I_MEM;
    if (r < I_O) { const int nb = r >> 5, kb = r & 31; transpose_item(P.in[21], 2048, nb * 32, 32, P.in[17], (bf16_t*)(ws + W_WO), 6144, nb * 32, 0, kb, scr, lane); continue; }
    r -= I_O;
    if (r < I_O) { const int nb = r >> 5, kb = r & 31; transpose_item(P.in[22], 2048, nb * 32, 32, nullptr, (bf16_t*)(ws + W_WO), 6144, nb * 32, 2048, kb, scr, lane); continue; }
    r -= I_O;
    if (r < I_O) { const int nb = r >> 5, kb = r & 31; transpose_item(P.in[23], 2048, nb * 32, 32, nullptr, (bf16_t*)(ws + W_WO), 6144, nb * 32, 4096, kb, scr, lane); continue; }
    r -= I_O;
    { const int nb = r >> 5, kb = r & 31; transpose_item(P.in[24], 2048, nb * 32, 32, nullptr, (bf16_t*)(ws + W_WOUT), 2048, nb * 32, 0, kb, scr, lane); }
  }
  const long gt = (long)blockIdx.x * 512 + tid, NT = (long)gridDim.x * 512;
  for (long i = gt; i < 8L * 32 * 2048; i += NT) {
    const int hd = (int)(i & 2047), kg = (int)((i >> 11) & 31), b = (int)(i >> 16);
    const float* s = P.in[9] + ((size_t)(b * 256 + kg * 8) * 2048 + hd);
    u32x4 o; o[0] = pk2(s[0], s[2048]); o[1] = pk2(s[2 * 2048], s[3 * 2048]); o[2] = pk2(s[4 * 2048], s[5 * 2048]); o[3] = pk2(s[6 * 2048], s[7 * 2048]);
    *(u32x4*)((bf16_t*)(ws + W_VTS) + ((size_t)(b * 2048 + hd)) * 256 + kg * 8) = o;
  }
  for (long i = gt; i < 8L * 1024 * 16; i += NT) { const int h = (int)(i & 15), j = (int)((i >> 4) & 1023), b = (int)(i >> 14);
    ((float*)(ws + W_LFS))[(size_t)(b * 16 + h) * 1088 + j] = P.in[5][i]; }
  for (long i = gt; i < 8L * 3 * 3072; i += NT) { const int c = (int)(i % 3072), r = (int)((i / 3072) % 3), b = (int)(i / 9216);
    ((bf16_t*)(ws + W_XBCS))[(size_t)(b * 67 + r) * 3072 + c] = (bf16_t)(pk2(P.in[7][i], 0.f) & 0xffff); }
  for (long i = gt; i < 16L * 3 * 3072; i += NT) { const int c = (int)(i % 3072), r = (int)((i / 3072) % 3), b = (int)(i / 9216);
    ((bf16_t*)(ws + W_XBCP))[(size_t)(b * 2051 + r) * 3072 + c] = 0; }
}

namespace fa {
constexpr int D = 128, LD = 2048, LDO = 6144;
constexpr float SCALE = 0.08838834764831845f;
constexpr float THR = 8.f;
constexpr int NW = 8, QBLK = 32, KVBLK = 64, QB = NW * QBLK;
constexpr int SHM_V = KVBLK * D * 2, SHM_K = KVBLK * D * 2;
constexpr int TAB_OFF = 2 * SHM_V + 2 * SHM_K + NW * 64 * 4;
constexpr unsigned WBIG = 0x7fffffffu;
constexpr int OSTG_OFF = 77824;
#define KSWZ(row, colB) ((row) * 256 + ((colB) ^ (((row) & 7) << 4)))
#define SBAR() __builtin_amdgcn_sched_barrier(0)
DI int v_st(int k, int c) { const int kk = (k & ~0xC) | ((k & 4) << 1) | ((k & 8) >> 1); return ((kk >> 3) * 4 + (c >> 5)) * 512 + ((kk & 7) * 32 + (c & 31)) * 2; }
DI int v_rd_base(int lane) { return ((lane & 3) << 3) | (((lane >> 2) & 3) << 6) | (((lane >> 4) & 1) << 5) | (((lane >> 5) & 1) << 8); }
constexpr int v_rd_off(int d0, int ks, int half) { return d0 * 512 + ks * 4096 + half * 2048; }
DI int crow(int r, int hi) { return (r & 3) + 8 * (r >> 2) + 4 * hi; }
DI bf16x8 load8(const bf16_t* p) { return *reinterpret_cast<const bf16x8*>(p); }
DI void mask_tile(f32x16& p0, f32x16& p1, int dq, unsigned W) {
  const float NEG = -__builtin_inff();
#pragma unroll
  for (int r = 0; r < 16; ++r) {
    const int c = (r & 3) + 8 * (r >> 2);
    if ((unsigned)(dq - c) >= W) p0[r] = NEG;
    if ((unsigned)(dq - c - 32) >= W) p1[r] = NEG;
  }
}
DI void partialSM(f32x16& p0, f32x16& p1, float& m_reg, float& mn, float& alpha) {
  float pmax = p0[0];
#pragma unroll
  for (int r = 1; r < 16; ++r) pmax = fmaxf(pmax, p0[r]);
#pragma unroll
  for (int r = 0; r < 16; ++r) pmax = fmaxf(pmax, p1[r]);
  { auto rr = __builtin_amdgcn_permlane32_swap(__float_as_uint(pmax), __float_as_uint(pmax), false, false);
    pmax = fmaxf(__uint_as_float(rr[0]), __uint_as_float(rr[1])); }
  constexpr float C2 = 1.4426950408889634f * SCALE;
  if (__builtin_expect(__all((pmax - m_reg) * SCALE <= THR), 1)) { mn = m_reg; alpha = 1.f; }
  else { mn = fmaxf(m_reg, pmax); alpha = __builtin_amdgcn_exp2f((m_reg - mn) * C2); m_reg = mn; }
  const float mnL = -mn * C2;
#pragma unroll
  for (int r = 0; r < 16; ++r) p0[r] = fmaf(p0[r], C2, mnL);
#pragma unroll
  for (int r = 0; r < 16; ++r) p1[r] = fmaf(p1[r], C2, mnL);
#pragma unroll
  for (int r = 0; r < 16; ++r) p0[r] = __builtin_amdgcn_exp2f(p0[r]);
}
DI void finishSM(f32x16& p0, f32x16& p1, float alpha, float& l_reg, bf16x8& pa0, bf16x8& pa1, bf16x8& pa2, bf16x8& pa3) {
#pragma unroll
  for (int r = 0; r < 16; ++r) p1[r] = __builtin_amdgcn_exp2f(p1[r]);
  float ps = 0;
#pragma unroll
  for (int r = 0; r < 16; ++r) ps += p0[r];
#pragma unroll
  for (int r = 0; r < 16; ++r) ps += p1[r];
  { auto rr = __builtin_amdgcn_permlane32_swap(__float_as_uint(ps), __float_as_uint(ps), false, false);
    ps = __uint_as_float(rr[0]) + __uint_as_float(rr[1]); }
  l_reg = l_reg * alpha + ps;
#define PK4(P, B_, OUT) do { unsigned a0 = pk2(P[B_+0], P[B_+1]), a1 = pk2(P[B_+2], P[B_+3]);                          \
        unsigned b0 = pk2(P[B_+4], P[B_+5]), b1 = pk2(P[B_+6], P[B_+7]);                                             \
        auto r0 = __builtin_amdgcn_permlane32_swap(a0, b0, false, false); auto r1 = __builtin_amdgcn_permlane32_swap(a1, b1, false, false); \
        u32x4 w = {r0[0], r1[0], r0[1], r1[1]}; OUT = *reinterpret_cast<bf16x8*>(&w); } while (0)
  PK4(p0, 0, pa0); PK4(p0, 8, pa1); PK4(p1, 0, pa2); PK4(p1, 8, pa3);
#undef PK4
}
template <int KB>
DI void qkt(f32x16& p0, f32x16& p1, const LAS char* K_lds, const LAS float* tabk, int r32, int hi, const bf16x8* qr) {
#pragma unroll
  for (int g = 0; g < 4; ++g) { const f32x4 t0 = *(const LAS f32x4*)(tabk + 8 * g + 4 * hi), t1 = *(const LAS f32x4*)(tabk + 32 + 8 * g + 4 * hi);
#pragma unroll
    for (int e = 0; e < 4; ++e) { p0[4 * g + e] = t0[e]; p1[4 * g + e] = t1[e]; } }
  const LAS char* kb[4];
#pragma unroll
  for (int dd = 0; dd < 4; ++dd) kb[dd] = K_lds + KB * SHM_K + KSWZ(r32, (dd * 16 + hi * 8) * 2);
#pragma unroll
  for (int d0 = 0; d0 < 8; ++d0) { const LAS char* a = kb[d0 & 3] + (d0 >> 2) * 128;
    bf16x8 b0 = *(const LAS bf16x8*)(a);
    bf16x8 b1 = *(const LAS bf16x8*)(a + 32 * 256);
    p0 = __builtin_amdgcn_mfma_f32_32x32x16_bf16(b0, qr[d0], p0, 0, 0, 0);
    p1 = __builtin_amdgcn_mfma_f32_32x32x16_bf16(b1, qr[d0], p1, 0, 0, 0); }
}
template <int VB>
DI void pv_tile(f32x16* o, int vb0, bf16x8 pa0, bf16x8 pa1, bf16x8 pa2, bf16x8 pa3) {
#define TRRD(dst, off) asm volatile("ds_read_b64_tr_b16 %0, %1 offset:%2" : "=&v"(dst) : "v"(vb0), "i"(off) : "memory")
#define PV_D0(d0) do { s16x4 l0, l1, l2, l3, h0, h1, h2, h3; constexpr int b_ = VB * SHM_V + v_rd_off(d0, 0, 0); \
        TRRD(l0, b_); TRRD(h0, b_ + 2048); TRRD(l1, b_ + 4096); TRRD(h1, b_ + 6144); TRRD(l2, b_ + 8192); TRRD(h2, b_ + 10240); TRRD(l3, b_ + 12288); TRRD(h3, b_ + 14336); \
        asm volatile("s_waitcnt lgkmcnt(0)" ::: "memory"); SBAR();   \
        o[d0] = __builtin_amdgcn_mfma_f32_32x32x16_bf16(pa0, (bf16x8){l0[0], l0[1], l0[2], l0[3], h0[0], h0[1], h0[2], h0[3]}, o[d0], 0, 0, 0);   \
        o[d0] = __builtin_amdgcn_mfma_f32_32x32x16_bf16(pa1, (bf16x8){l1[0], l1[1], l1[2], l1[3], h1[0], h1[1], h1[2], h1[3]}, o[d0], 0, 0, 0);   \
        o[d0] = __builtin_amdgcn_mfma_f32_32x32x16_bf16(pa2, (bf16x8){l2[0], l2[1], l2[2], l2[3], h2[0], h2[1], h2[2], h2[3]}, o[d0], 0, 0, 0);   \
        o[d0] = __builtin_amdgcn_mfma_f32_32x32x16_bf16(pa3, (bf16x8){l3[0], l3[1], l3[2], l3[3], h3[0], h3[1], h3[2], h3[3]}, o[d0], 0, 0, 0); } while (0)
  PV_D0(0); PV_D0(1); PV_D0(2); PV_D0(3);
#undef PV_D0
#undef TRRD
}
struct BlockRef { const bf16_t* Q; const bf16_t* K; const bf16_t* V; bf16_t* O; const bf16_t* G; const float* lf; int P0, skv, nvalid, nkeys; };
struct Seam { bf16x8 qr[8]; bf16x8 st_v0, st_v1, st_k0, st_k1; };
constexpr int NFOX = 2048 + 128;
DI BlockRef fox_decode(const Params& P, int L) {
  unsigned char* ws = P.ws; BlockRef r;
  const bf16_t* FQ = (const bf16_t*)(ws + W_FQ); const bf16_t* FG = (const bf16_t*)(ws + W_FG); bf16_t* Y3 = (bf16_t*)(ws + W_Y3);
  if (L < 2048) { const int bh = L >> 3, qb = 7 - (L & 7), b = bh >> 4, h = bh & 15;
    const size_t row = (size_t)b * 2048 + qb * 256;
    r.lf = (const float*)(ws + W_LFT) + (size_t)bh * 2048; r.nkeys = 2048;
    r.Q = FQ + row * 2048 + h * 128; r.K = (const bf16_t*)(ws + W_FK) + (size_t)b * 2048 * 2048 + h * 128; r.V = (const bf16_t*)(ws + W_FV) + (size_t)b * 2048 * 2048 + h * 128;
    r.O = Y3 + row * 6144 + 2048 + h * 128; r.G = FG + row * 2048 + h * 128; r.P0 = qb * 256; r.skv = 2048; r.nvalid = 256;
  } else { const int j = L - 2048, b = j >> 4, h = j & 15;
    r.lf = (const float*)(ws + W_LFS) + (size_t)j * 1088; r.nkeys = 1088;
    const size_t row = (size_t)MP + b * 64;
    r.Q = FQ + row * 2048 + h * 128; r.K = (const bf16_t*)(ws + W_KS) + (size_t)b * 1088 * 2048 + h * 128; r.V = (const bf16_t*)(ws + W_VS) + (size_t)b * 1088 * 2048 + h * 128;
    r.O = Y3 + row * 6144 + 2048 + h * 128; r.G = FG + row * 2048 + h * 128; r.P0 = 1024; r.skv = 1088; r.nvalid = 64; }
  return r;
}

#define ROW(p, k0, rr) ((p) + (size_t)((k0) + 32 * (rr)) * LD + rowoff0)
#define VMW() asm volatile("s_waitcnt vmcnt(0)" ::: "memory")
#define VMWN(n) asm volatile("s_waitcnt vmcnt(%0)" :: "i"(n) : "memory")
#define SLOAD_H(Kp, Vp, k0) do { S.st_v0 = load8(ROW(Vp, k0, 0)); S.st_v1 = load8(ROW(Vp, k0, 1));              \
                         S.st_k0 = load8(ROW(Kp, k0, 0)); S.st_k1 = load8(ROW(Kp, k0, 1)); } while (0)
#define SWRITE_HK(bf) do { *(LAS bf16x8*)(K_lds + (bf) * SHM_K + kws) = S.st_k0; *(LAS bf16x8*)(K_lds + (bf) * SHM_K + kws + 32 * 256) = S.st_k1; } while (0)
#define SWRITE_HV(bf) do { *(LAS bf16x8*)(V_lds + (bf) * SHM_V + vst0) = S.st_v0; *(LAS bf16x8*)(V_lds + (bf) * SHM_V + vst0 + vst1d) = S.st_v1; } while (0)
#define SWRITE_H(bf) do { SWRITE_HV(bf); SWRITE_HK(bf); } while (0)
DI void fox_prime(const BlockRef& cur, LAS char* lds, Seam& S) {
  int tid = threadIdx.x; asm volatile("" : "+v"(tid));
  const int wid = __builtin_amdgcn_readfirstlane(tid >> 6), lane = tid & 63, r32 = lane & 31, hi = lane >> 5;
  const int sr = tid >> 4, sc = (tid & 15) * 8, kws = KSWZ(sr, sc * 2); LAS char* K_lds = lds + 2 * SHM_V;
  const unsigned rowoff0 = (unsigned)(sr * LD + sc);
  const unsigned qoff = (unsigned)((wid * QBLK + r32) * LD + hi * 8);
#pragma unroll
  for (int d0 = 0; d0 < 8; ++d0) S.qr[d0] = load8(cur.Q + qoff + d0 * 16);
  SLOAD_H(cur.K, cur.V, 0); VMW(); SWRITE_HK(0);
  __syncthreads();
}
DI void fox_block(const BlockRef& cur, int Ln, const Params& P, LAS char* lds, Seam& S) {
  int tid = threadIdx.x; asm volatile("" : "+v"(tid));
  const int wid = __builtin_amdgcn_readfirstlane(tid >> 6), lane = tid & 63, r32 = lane & 31, hi = lane >> 5;
  int j_hi = (cur.P0 + QB - 1) / KVBLK + 1; if (j_hi > cur.skv / KVBLK) j_hi = cur.skv / KVBLK;
  const int NT = j_hi;
  const int qlo = cur.P0 + wid * QBLK, qm = qlo + r32 - 4 * hi;
  LAS char* V_lds = lds; LAS char* K_lds = lds + 2 * SHM_V;
  LAS float* ws = (LAS float*)(lds + 2 * SHM_V + 2 * SHM_K) + wid * 64; LAS float* li_l = ws; LAS float* al_l = ws + 32;
  const LAS float* tab = (const LAS float*)(lds + TAB_OFF);
  float m_reg = -1e30f, l_reg = 0; f32x16 o[4] = {};
  const int sr = tid >> 4, sc = (tid & 15) * 8, vst0 = v_st(sr, sc), kws = KSWZ(sr, sc * 2);
  constexpr int vst1d = 8192;
  const unsigned rowoff0 = (unsigned)(sr * LD + sc);
  const int vb0 = (int)(uintptr_t)V_lds + v_rd_base(lane);
  const bf16_t* Kh = cur.K; const bf16_t* Vh = cur.V;
#define RESC(a) do { if (__any((a) < 1.f)) { if (hi == 0) al_l[r32] = (a); asm volatile("s_waitcnt lgkmcnt(0)" ::: "memory");              \
                     for (int d_ = 0; d_ < 4; ++d_) for (int r = 0; r < 16; ++r) o[d_][r] *= al_l[crow(r, hi)]; } } while (0)
#define KBASE(t) ((t) * KVBLK)
#define MASKT(P0_, P1_, t) do { const int kb_ = KBASE(t); if (kb_ + KVBLK - 1 > qlo) mask_tile(P0_, P1_, qm - kb_, WBIG); } while (0)
#define SEAM_K0() do { VMWN(8); SWRITE_HK(0); SBAR(); } while (0)
  f32x16 pA0, pA1, pB0, pB1; float mnA, mnB, alA, alB; bf16x8 pa0, pa1, pa2, pa3;
  SWRITE_HV(0); SBAR();
  if (NT > 1) { SLOAD_H(Kh, Vh, KBASE(1)); }
  SBAR(); qkt<0>(pA0, pA1, K_lds, tab + KBASE(0), r32, hi, S.qr);
  MASKT(pA0, pA1, 0); partialSM(pA0, pA1, m_reg, mnA, alA);
  if (NT > 1) { VMW(); SWRITE_H(1); }
  __syncthreads();
#define HALF_STEP(PX0, PX1, mnX, alX, PY0, PY1, alY, t, KB, VB, SB) do {                                                      \
        SBAR(); qkt<KB>(PX0, PX1, K_lds, tab + KBASE(t), r32, hi, S.qr);                                             \
        finishSM(PY0, PY1, alY, l_reg, pa0, pa1, pa2, pa3); SBAR();                                                           \
        if ((t) + 1 < NT) { SLOAD_H(Kh, Vh, KBASE((t) + 1)); SBAR(); }                                               \
        pv_tile<VB>(o, vb0, pa0, pa1, pa2, pa3); MASKT(PX0, PX1, (t)); partialSM(PX0, PX1, m_reg, mnX, alX);                                        \
        __syncthreads();                                                                                                      \
        if ((t) + 1 < NT) { VMW(); SWRITE_H(SB); }                                                                          \
        RESC(alX); __syncthreads(); } while (0)
  for (int t = 1; t + 1 < NT; t += 2) {
    HALF_STEP(pB0, pB1, mnB, alB, pA0, pA1, alA, t, 1, 0, 0);
    HALF_STEP(pA0, pA1, mnA, alA, pB0, pB1, alB, t + 1, 0, 1, 1);
  }
  const bool even = (NT & 1) == 0;
  if (even) { SBAR(); qkt<1>(pB0, pB1, K_lds, tab + KBASE(NT - 1), r32, hi, S.qr); SBAR(); }
  const BlockRef nxt = (Ln < NFOX) ? fox_decode(P, Ln) : cur;
  SLOAD_H(nxt.K, nxt.V, 0); SBAR();
  unsigned qoff; { int l2 = lane; asm volatile("" : "+v"(l2)); qoff = (unsigned)((wid * QBLK + (l2 & 31)) * LD + (l2 >> 5) * 8); }
#pragma unroll
  for (int d0 = 0; d0 < 8; ++d0) S.qr[d0] = load8(nxt.Q + qoff + d0 * 16);
  SBAR();
  finishSM(pA0, pA1, alA, l_reg, pa0, pa1, pa2, pa3); SBAR();
  pv_tile<0>(o, vb0, pa0, pa1, pa2, pa3);
  if (even) { MASKT(pB0, pB1, NT - 1); partialSM(pB0, pB1, m_reg, mnB, alB); __syncthreads(); RESC(alB);
    finishSM(pB0, pB1, alB, l_reg, pa0, pa1, pa2, pa3); SBAR(); pv_tile<1>(o, vb0, pa0, pa1, pa2, pa3); }
  SBAR(); SEAM_K0();
  if (hi == 0) li_l[r32] = l_reg; asm volatile("s_waitcnt lgkmcnt(0)" ::: "memory");
  { int lane_o = lane; asm volatile("" : "+v"(lane_o));
    LAS char* stg = lds + OSTG_OFF + wid * 8448;
    const int rw = lane_o >> 4, cw = (lane_o & 15) * 8; const int r32 = lane_o & 31, hi = lane_o >> 5;
#pragma unroll
    for (int half = 0; half < 2; ++half) {
#pragma unroll
      for (int rr = 0; rr < 8; ++rr) { const int r = half * 8 + rr; const int orow = crow(r, hi); const float rl = __builtin_amdgcn_rcpf(li_l[orow]);
#pragma unroll
        for (int d0 = 0; d0 < 4; ++d0) *(LAS float*)(stg + (orow - 16 * half) * 528 + (d0 * 32 + r32) * 4) = o[d0][r] * rl; }
      asm volatile("s_waitcnt lgkmcnt(0)" ::: "memory");
#pragma unroll
      for (int i = 0; i < 4; ++i) { const int lr = i * 4 + rw; const int brow = wid * QBLK + half * 16 + lr;
        const f32x4 v0 = *(const LAS f32x4*)(stg + lr * 528 + cw * 4), v1 = *(const LAS f32x4*)(stg + lr * 528 + cw * 4 + 16);
        const u32x4 gw = *(const u32x4*)(cur.G + (unsigned)(brow * LD + cw));
        u32x4 ow; ow[0] = pk2(v0[0] * bflo(gw[0]), v0[1] * bfhi(gw[0])); ow[1] = pk2(v0[2] * bflo(gw[1]), v0[3] * bfhi(gw[1]));
        ow[2] = pk2(v1[0] * bflo(gw[2]), v1[1] * bfhi(gw[2])); ow[3] = pk2(v1[2] * bflo(gw[3]), v1[3] * bfhi(gw[3]));
        if (brow < cur.nvalid) *(u32x4*)(cur.O + (unsigned)(brow * LDO + cw)) = ow; }
      asm volatile("s_waitcnt lgkmcnt(0)" ::: "memory");
    } }
  __syncthreads();
#undef RESC
#undef KBASE
#undef MASKT
#undef SEAM_K0
#undef HALF_STEP
}
#undef ROW
#undef VMW
#undef VMWN
#undef SLOAD_H
#undef SWRITE_HK
#undef SWRITE_HV
#undef SWRITE_H
DI void build_bias(const float* src, int nkeys, LAS char* lds) {
  LAS float* tab = (LAS float*)(lds + TAB_OFF); LAS float* wsum = tab + 2048;
  int tid = threadIdx.x; asm volatile("" : "+v"(tid));
  const int lane = tid & 63, wid = tid >> 6;
  f32x4 v = {0.f, 0.f, 0.f, 0.f}; if (tid * 4 < nkeys) v = *(const f32x4*)(src + tid * 4);
  const float s0 = v[0], s1 = s0 + v[1], s2 = s1 + v[2], s3 = s2 + v[3];
  float incl = s3;
#pragma unroll
  for (int o = 1; o < 64; o <<= 1) { const int sl = lane >= o ? lane - o : lane;
    const float t = __int_as_float(__builtin_amdgcn_ds_bpermute(sl * 4, __float_as_int(incl))); if (lane >= o) incl += t; }
  if (lane == 63) wsum[wid] = incl;
  __syncthreads();
  float off = incl - s3;
  for (int w = 0; w < wid; ++w) off += wsum[w];
  const float kk = -11.313708498984761f;
  f32x4 o = {(off + s0) * kk, (off + s1) * kk, (off + s2) * kk, (off + s3) * kk};
  *(LAS f32x4*)(tab + tid * 4) = o;
  __syncthreads();
}
}

DI int fetch_item(unsigned* ctr, LAS char* lds) {
  volatile LAS int* slot = (volatile LAS int*)(lds + LDS_BYTES - 64);
  __syncthreads();
  if (threadIdx.x == 0) *slot = (int)atomicAdd(ctr, 1u);
  __syncthreads();
  return __builtin_amdgcn_readfirstlane(*slot);
}


DI void conv_pass(const Params& P) {
  unsigned char* ws = P.ws;
  int tid = threadIdx.x; asm volatile("" : "+v"(tid));
  const float* wconv = P.in[12]; const float* bconv = P.in[13];
  bf16_t* XCT = (bf16_t*)(ws + W_XCT); bf16_t* BCN = (bf16_t*)(ws + W_BCN); bf16_t* BTT = (bf16_t*)(ws + W_BTT);
  const int lane = tid & 63, wv = blockIdx.x * 8 + (tid >> 6), NWV = gridDim.x * 8;
  const int tg = lane & 7, ccl = lane >> 3;
  for (int it = wv; it < 520 * 48; it += NWV) {
    const int cidx = it / 48, ccg = it - cidx * 48; const int cc = ccg * 8 + ccl; const int ch = cc * 8;
    const bool sample = cidx >= 512; const int b = sample ? cidx - 512 : cidx >> 5, c = sample ? 0 : cidx & 31;
    const bf16_t* xbc = sample ? (const bf16_t*)(ws + W_XBCS) + (size_t)b * 67 * 3072 : (const bf16_t*)(ws + W_XBCP) + (size_t)b * 2051 * 3072;
    const size_t rowbase = sample ? (size_t)MP + b * 64 : (size_t)b * 2048;
    const int t0 = c * 64 + tg * 8;
    u32x4 raw[11];
#pragma unroll
    for (int j = 0; j < 11; ++j) raw[j] = *(const u32x4*)(xbc + (size_t)(t0 + j) * 3072 + ch);
    f32x4 wv4[4][2], bv[2];
#pragma unroll
    for (int i = 0; i < 4; ++i) { wv4[i][0] = *(const f32x4*)(wconv + i * 3072 + ch); wv4[i][1] = *(const f32x4*)(wconv + i * 3072 + ch + 4); }
    bv[0] = *(const f32x4*)(bconv + ch); bv[1] = *(const f32x4*)(bconv + ch + 4);
    unsigned op[8][4];
    u32x4 on[8];
    float prev[8];
#pragma unroll
    for (int j = 0; j < 8; ++j) {
      float o[8];
#pragma unroll
      for (int e = 0; e < 8; ++e) { float a = bv[e >> 2][e & 3];
#pragma unroll
        for (int i = 0; i < 4; ++i) { const unsigned w = raw[j + i][e >> 1]; const float xv = (e & 1) ? bfhi(w) : bflo(w); a += wv4[i][e >> 2][e & 3] * xv; }
        o[e] = siluf_(a); }
      on[j][0] = pk2(o[0], o[1]); on[j][1] = pk2(o[2], o[3]); on[j][2] = pk2(o[4], o[5]); on[j][3] = pk2(o[6], o[7]);
      if (j & 1) {
#pragma unroll
        for (int e = 0; e < 8; ++e) op[e][j >> 1] = pk2(prev[e], o[e]);
      } else {
#pragma unroll
        for (int e = 0; e < 8; ++e) prev[e] = o[e];
      }
    }
    if (ch < 2048) { const int h = ch >> 6, p0 = ch & 63;
      bf16_t* dst = XCT + ((size_t)(cidx * 32 + h) * 64 + p0) * 64 + tg * 8;
#pragma unroll
      for (int e = 0; e < 8; ++e) { u32x4 w = {op[e][0], op[e][1], op[e][2], op[e][3]}; *(u32x4*)(dst + e * 64) = w; }
    } else {
      const int cb = ch - 2048;
      bf16_t* dn = BCN + (rowbase + t0) * 1024 + cb;
#pragma unroll
      for (int j = 0; j < 8; ++j) *(u32x4*)(dn + (size_t)j * 1024) = on[j];
      if (cb < 512) { const int g = cb >> 7, n0 = cb & 127;
        bf16_t* dt_ = BTT + ((size_t)(cidx * 4 + g) * 128 + n0) * 64 + tg * 8;
#pragma unroll
        for (int e = 0; e < 8; ++e) { u32x4 w = {op[e][0], op[e][1], op[e][2], op[e][3]}; *(u32x4*)(dt_ + e * 64) = w; }
      }
    }
  }
}

DI void ssd_item(const Params& P, LAS unsigned char* lds, int item) {
  unsigned char* ws = P.ws;
  int tid = threadIdx.x; asm volatile("" : "+v"(tid));
  const int wid = __builtin_amdgcn_readfirstlane(tid >> 6), lane = tid & 63, r16 = lane & 15, q = lane >> 4;
  const bool sample = item >= 64; const int i2 = sample ? item - 64 : item; const int b = i2 >> 2, g = i2 & 3;
  const int nch = sample ? 1 : 32;
  const bf16_t* xbc = sample ? (const bf16_t*)(ws + W_XBCS) + (size_t)b * 67 * 3072 : (const bf16_t*)(ws + W_XBCP) + (size_t)b * 2051 * 3072;
  const size_t rowbase = sample ? (size_t)MP + b * 64 : (size_t)b * 2048;
  const int h = g * 8 + wid;
  const float A_h = -__expf(P.in[15][h]), dsk = P.in[16][h];
  const float* DT = (const float*)(ws + W_DT); const bf16_t* ZB = (const bf16_t*)(ws + W_ZB); bf16_t* Y3 = (bf16_t*)(ws + W_Y3); float* SSQP = (float*)(ws + W_SSQP);
  LAS unsigned char* Bs = lds; LAS unsigned char* Cs = lds + 17408; LAS unsigned char* BT = lds + 34816;
  LAS unsigned char* XT = lds + 53248 + wid * 9216;
  LAS float* acum_l = (LAS float*)(lds + 126976 + wid * 768); LAS float* dtv_l = acum_l + 64; LAS float* wend_l = acum_l + 128;
  f32x4 hT[8][4];
#pragma unroll
  for (int nt = 0; nt < 8; ++nt)
#pragma unroll
    for (int pt = 0; pt < 4; ++pt) {
      if (sample) hT[nt][pt] = *(const f32x4*)(P.in[6] + ((size_t)(b * 32 + h) * 64 + pt * 16 + r16) * 128 + nt * 16 + 4 * q);
      else hT[nt][pt] = (f32x4){0.f, 0.f, 0.f, 0.f};
    }
  const bf16_t* XCT = (const bf16_t*)(ws + W_XCT); const bf16_t* BCN = (const bf16_t*)(ws + W_BCN); const bf16_t* BTT = (const bf16_t*)(ws + W_BTT);
  for (int c = 0; c < nch; ++c) {
    const int t0 = c * 64;
    const int cidx = sample ? 512 + b : b * 32 + c;
    const float dtl = DT[(rowbase + t0 + lane) * 32 + h];
    u32x4 rx[8], rb[2], rc[2], rt[2];
    { const bf16_t* xs = XCT + (size_t)(cidx * 32 + h) * 4096;
#pragma unroll
      for (int j = 0; j < 8; ++j) rx[j] = *(const u32x4*)(xs + (j * 64 + lane) * 8);
      const bf16_t* bts = BTT + (size_t)(cidx * 4 + g) * 8192;
#pragma unroll
      for (int j = 0; j < 2; ++j) { const int id = tid + 512 * j; const int s = id >> 4, k = id & 15;
        rb[j] = *(const u32x4*)(BCN + (rowbase + t0 + s) * 1024 + g * 128 + k * 8);
        rc[j] = *(const u32x4*)(BCN + (rowbase + t0 + s) * 1024 + 512 + g * 128 + k * 8);
        rt[j] = *(const u32x4*)(bts + id * 8); } }
    float cdec;
    { float ac = dtl * A_h;
#pragma unroll
      for (int o = 1; o < 64; o <<= 1) { const float t = __shfl_up(ac, o); if (lane >= o) ac += t; }
      const float tot = __shfl(ac, 63);
      acum_l[lane] = ac; dtv_l[lane] = dtl; wend_l[lane] = __expf(tot - ac) * dtl; cdec = __expf(tot); }
#pragma unroll
    for (int j = 0; j < 8; ++j) { const int e8 = j * 64 + lane; *(LAS u32x4*)(XT + (e8 >> 3) * 144 + (e8 & 7) * 16) = rx[j]; }
    __syncthreads();
#pragma unroll
    for (int j = 0; j < 2; ++j) { const int id = tid + 512 * j;
      *(LAS u32x4*)(Bs + (id >> 4) * 272 + (id & 15) * 16) = rb[j];
      *(LAS u32x4*)(Cs + (id >> 4) * 272 + (id & 15) * 16) = rc[j];
      *(LAS u32x4*)(BT + (id >> 3) * 144 + (id & 7) * 16) = rt[j]; }
    __syncthreads();
    for (int lt = 0; lt < 4; ++lt) {
      const int l = lt * 16 + r16;
      const size_t row = rowbase + t0 + l;
      u32x2 zraw[4];
#pragma unroll
      for (int pt = 0; pt < 4; ++pt) zraw[pt] = *(const u32x2*)(ZB + row * 2048 + h * 64 + pt * 16 + 4 * q);
      f32x4 y[4];
#pragma unroll
      for (int pt = 0; pt < 4; ++pt) y[pt] = (f32x4){0.f, 0.f, 0.f, 0.f};
#pragma unroll
      for (int np = 0; np < 4; ++np) {
        const u32x2 clo = *(const LAS u32x2*)(Cs + l * 272 + (32 * np + 4 * q) * 2), chi = *(const LAS u32x2*)(Cs + l * 272 + (32 * np + 16 + 4 * q) * 2);
        const bf16x8 bfrag = cat8(clo, chi);
#pragma unroll
        for (int pt = 0; pt < 4; ++pt) y[pt] = MFMA16(pack8(hT[2 * np][pt], hT[2 * np + 1][pt]), bfrag, y[pt]);
      }
      const float al = acum_l[l]; const float el = __expf(al);
#pragma unroll
      for (int pt = 0; pt < 4; ++pt) y[pt] *= el;
      const int nsp = (lt >> 1) + 1;
      for (int sp = 0; sp < nsp; ++sp) {
        f32x4 cb0 = {0.f, 0.f, 0.f, 0.f}, cb1 = {0.f, 0.f, 0.f, 0.f};
#pragma unroll
        for (int ks = 0; ks < 4; ++ks) {
          const bf16x8 cf = *(const LAS bf16x8*)(Cs + l * 272 + (32 * ks + 8 * q) * 2);
          const bf16x8 b0 = *(const LAS bf16x8*)(Bs + (32 * sp + r16) * 272 + (32 * ks + 8 * q) * 2);
          const bf16x8 b1 = *(const LAS bf16x8*)(Bs + (32 * sp + 16 + r16) * 272 + (32 * ks + 8 * q) * 2);
          cb0 = MFMA16(b0, cf, cb0); cb1 = MFMA16(b1, cf, cb1);
        }
        const int s0 = 32 * sp + 4 * q, s1 = s0 + 16;
        const f32x4 as0 = *(const LAS f32x4*)(acum_l + s0), as1 = *(const LAS f32x4*)(acum_l + s1);
        const f32x4 d0 = *(const LAS f32x4*)(dtv_l + s0), d1 = *(const LAS f32x4*)(dtv_l + s1);
        f32x4 m0, m1;
#pragma unroll
        for (int e = 0; e < 4; ++e) {
          m0[e] = (s0 + e <= l) ? cb0[e] * __expf(al - as0[e]) * d0[e] : 0.f;
          m1[e] = (s1 + e <= l) ? cb1[e] * __expf(al - as1[e]) * d1[e] : 0.f;
        }
        const bf16x8 mfrag = pack8(m0, m1);
#pragma unroll
        for (int pt = 0; pt < 4; ++pt) { const int p = pt * 16 + r16;
          const u32x2 xlo = *(const LAS u32x2*)(XT + p * 144 + s0 * 2), xhi = *(const LAS u32x2*)(XT + p * 144 + s1 * 2);
          y[pt] = MFMA16(cat8(xlo, xhi), mfrag, y[pt]); }
      }
      float ssq = 0.f;
#pragma unroll
      for (int pt = 0; pt < 4; ++pt) { const int p0 = pt * 16 + 4 * q;
        const f32x4 zz = {bflo(zraw[pt][0]), bfhi(zraw[pt][0]), bflo(zraw[pt][1]), bfhi(zraw[pt][1])};
        f32x4 v;
#pragma unroll
        for (int e = 0; e < 4; ++e) { const float xv = bf2f(*(const LAS bf16_t*)(XT + (p0 + e) * 144 + l * 2));
          v[e] = (y[pt][e] + dsk * xv) * zz[e]; ssq += v[e] * v[e]; }
        st_bf4(Y3 + row * 6144 + h * 64 + p0, v); }
      ssq += __shfl_xor(ssq, 16); ssq += __shfl_xor(ssq, 32);
      if (q == 0) SSQP[row * 32 + h] = ssq;
    }
#pragma unroll
    for (int nt = 0; nt < 8; ++nt)
#pragma unroll
      for (int pt = 0; pt < 4; ++pt) hT[nt][pt] *= cdec;
#pragma unroll
    for (int ks = 0; ks < 2; ++ks) {
      bf16x8 bfr[4];
      const f32x4 w0 = *(const LAS f32x4*)(wend_l + 32 * ks + 8 * q), w1 = *(const LAS f32x4*)(wend_l + 32 * ks + 8 * q + 4);
#pragma unroll
      for (int pt = 0; pt < 4; ++pt) { const int p = pt * 16 + r16;
        const u32x4 xr = *(const LAS u32x4*)(XT + p * 144 + (32 * ks + 8 * q) * 2);
        const f32x4 a = {bflo(xr[0]) * w0[0], bfhi(xr[0]) * w0[1], bflo(xr[1]) * w0[2], bfhi(xr[1]) * w0[3]};
        const f32x4 bq = {bflo(xr[2]) * w1[0], bfhi(xr[2]) * w1[1], bflo(xr[3]) * w1[2], bfhi(xr[3]) * w1[3]};
        bfr[pt] = pack8(a, bq); }
#pragma unroll
      for (int nt = 0; nt < 8; ++nt) { const bf16x8 af = *(const LAS bf16x8*)(BT + (nt * 16 + r16) * 144 + (32 * ks + 8 * q) * 2);
#pragma unroll
        for (int pt = 0; pt < 4; ++pt) hT[nt][pt] = MFMA16(af, bfr[pt], hT[nt][pt]); }
    }
  }
  float* so = P.out + (sample ? O_SSDS : O_SSDP) + (size_t)(b * 32 + h) * 8192;
#pragma unroll
  for (int nt = 0; nt < 8; ++nt)
#pragma unroll
    for (int pt = 0; pt < 4; ++pt) *(f32x4*)(so + (size_t)(pt * 16 + r16) * 128 + nt * 16 + 4 * q) = hT[nt][pt];
  __syncthreads();
}

__global__ __launch_bounds__(512) void mk_forward(Params Parg) {
#if defined(__HIP_DEVICE_COMPILE__)
  extern __shared__ __attribute__((aligned(16))) unsigned char lds_raw[];
  LAS unsigned char* lds = (LAS unsigned char*)lds_raw;
  cg::grid_group grid = cg::this_grid();
  const int G = gridDim.x, cblk = blockIdx.x;
  typedef __attribute__((address_space(4))) const Params* KP;
  const KP kp = (KP)__builtin_amdgcn_kernarg_segment_ptr();
#define PHASE_PARAMS() KP kq_ = kp; asm volatile("" : "+s"(kq_)); const Params P = *kq_; unsigned char* ws = P.ws; (void)ws
#ifndef PH
#define PH 255
#endif
#ifndef DUPMASK
#define DUPMASK 0
#endif
  for (int rep0_ = 0; rep0_ < ((DUPMASK & 1) ? 2 : 1); ++rep0_)
  if (PH & 1) { PHASE_PARAMS(); phase0(P, lds); }
  grid.sync();
  for (int rep_ = 0; rep_ < ((DUPMASK & 2) ? 2 : 1); ++rep_)
  if (PH & 2) { PHASE_PARAMS();
    SchedP1 S; S.c = cblk; S.G = G; S.XB = (const char*)(ws + W_XB); S.WIN = (const char*)(ws + W_WIN); S.MB = (const char*)(ws + W_MB); S.WMEM = (const char*)(ws + W_WMEM);
    EpiIn E; E.P = P; pg8::Gemm g; g.lda = 2048; g.ldb = 2048; g.K = 2048;
    pg8::gemm_phase(lds, g, S, E); }
  grid.sync();
  { PHASE_PARAMS(); conv_pass(P); }
  for (int rep_ = 0; rep_ < ((DUPMASK & 4) ? 2 : 1); ++rep_) {
  if (rep_) grid.sync();
  if (PH & 4) { PHASE_PARAMS();
    SchedS S; S.c = cblk; S.G = G; S.MQ = (const char*)(ws + W_MQ); S.MKP = (const char*)(ws + W_MKP); S.MKS = (const char*)(ws + W_MKS);
    EpiS E; E.P = P; pg8::Gemm g; g.lda = 2048; g.ldb = 2048; g.K = 512;
    pg8::gemm_phase(lds, g, S, E); }
  if (!rep_) grid.sync();
  if (PH & 8) { PHASE_PARAMS(); unsigned* ctl = (unsigned*)(ws + W_CTL) + rep_ * 32;
    for (;;) { const int it = fetch_item(ctl + 0, (LAS char*)lds_raw); if (it >= 96) break; ssd_item(P, lds, it); } }
  if (PH & 16) { PHASE_PARAMS(); unsigned* ctl = (unsigned*)(ws + W_CTL) + rep_ * 32;
    LAS char* l8 = (LAS char*)lds_raw;
    int L = fetch_item(ctl + 16, l8);
    if (L < fa::NFOX) {
      fa::BlockRef cur = fa::fox_decode(P, L);
      fa::Seam S;
      fa::build_bias(cur.lf, cur.nkeys, l8);
      fa::fox_prime(cur, l8, S);
      for (;;) {
        const int Ln = fetch_item(ctl + 16, l8);
        fa::fox_block(cur, Ln, P, l8, S);
        if (Ln >= fa::NFOX) break;
        cur = fa::fox_decode(P, Ln);
        fa::build_bias(cur.lf, cur.nkeys, l8);
      }
    }
  }
  }
  grid.sync();
  for (int rep3_ = 0; rep3_ < ((DUPMASK & 32) ? 2 : 1); ++rep3_)
  if (PH & 32) { PHASE_PARAMS();
    { const float* SSQP = (const float*)(ws + W_SSQP); float* RS = (float*)(ws + W_RS);
      int tid = threadIdx.x; asm volatile("" : "+v"(tid));
      for (int r = cblk * 512 + tid; r < MT; r += G * 512) { float s = 0.f;
#pragma unroll
        for (int j = 0; j < 8; ++j) { const f32x4 v = *(const f32x4*)(SSQP + (size_t)r * 32 + 4 * j); s += (v[0] + v[1]) + (v[2] + v[3]); }
        RS[r] = rsqrtf(s * (1.f / 2048.f) + EPS); } }
    SchedPV S; S.c = cblk; S.G = G; S.PM = (const char*)(ws + W_PM); S.VTP = (const char*)(ws + W_VTP); S.VTS = (const char*)(ws + W_VTS);
    EpiPV E; E.P = P; pg8::Gemm g; g.lda = 1024; g.ldb = 256; g.K = 256;
    pg8::gemm_phase(lds, g, S, E); }
  grid.sync();
  for (int rep4_ = 0; rep4_ < ((DUPMASK & 64) ? 2 : 1); ++rep4_)
  if (PH & 64) { PHASE_PARAMS();
    SchedMerge S; S.c = cblk; S.G = G; S.A = (const char*)(ws + W_Y3); S.B = (const char*)(ws + W_WO);
    EpiMerge E; E.P = P; pg8::Gemm g; g.lda = 6144; g.ldb = 6144; g.K = 2048;
    pg8::gemm_phase(lds, g, S, E); }
  grid.sync();
  for (int rep5_ = 0; rep5_ < ((DUPMASK & 128) ? 2 : 1); ++rep5_)
  if (PH & 128) { PHASE_PARAMS();
    SchedTile S; S.c = cblk; S.G = G; S.nM = 130; S.nN = 8; S.A = (const char*)(ws + W_MRG); S.B = (const char*)(ws + W_WOUT); S.astep = (size_t)256 * 2048 * 2; S.bstep = (size_t)256 * 2048 * 2;
    EpiOut E; E.P = P; pg8::Gemm g; g.lda = 2048; g.ldb = 2048; g.K = 2048;
    pg8::gemm_phase(lds, g, S, E); }
  grid.sync();
  { PHASE_PARAMS();
    const float* PARTO = (const float*)(ws + W_PARTO); const float* gf = P.in[25];
    int tid = threadIdx.x; asm volatile("" : "+v"(tid)); const int wid = tid >> 6, lane = tid & 63;
    for (int r = cblk * 8 + wid; r < MT; r += G * 8) {
      const float pv = lane < 32 ? PARTO[(size_t)r * 32 + lane] : 0.f;
      const float sc = rsqrtf(wave_sum(pv) * (1.f / 2048.f) + EPS);
      f32x4* y = (f32x4*)(P.out + (size_t)r * 2048) + lane; const f32x4* gv = (const f32x4*)gf + lane;
#pragma unroll
      for (int j = 0; j < 8; ++j) { f32x4 v = y[64 * j]; const f32x4 gg = gv[64 * j]; y[64 * j] = v * sc * gg; }
    } }
#endif
}

extern "C" void kernel_launch(void* const* d_in, const int* in_sizes, int n_in,
                              void* d_out, int out_size, void* d_ws, size_t ws_size,
                              hipStream_t stream) {
  static int grid = 0;
  if (grid == 0) {
    int dev = 0, cus = 0, per_cu = 0;
    (void)hipGetDevice(&dev);
    (void)hipDeviceGetAttribute(&cus, hipDeviceAttributeMultiprocessorCount, dev);
    (void)hipFuncSetAttribute((const void*)mk_forward, hipFuncAttributeMaxDynamicSharedMemorySize, LDS_BYTES);
    (void)hipOccupancyMaxActiveBlocksPerMultiprocessor(&per_cu, (const void*)mk_forward, 512, LDS_BYTES);
    if (per_cu < 1) per_cu = 1;
    grid = cus * per_cu;
    if (ws_size < W_END) { fprintf(stderr, "workspace too small: %zu < %zu\n", ws_size, (size_t)W_END); grid = -1; }
  }
  if (grid < 0) return;
  Params p{};
  for (int i = 0; i < 26; ++i) p.in[i] = (const float*)d_in[i];
  p.out = (float*)d_out; p.ws = (unsigned char*)d_ws;
  void* args[] = {&p};
  hipError_t e = hipLaunchCooperativeKernel((const void*)mk_forward, dim3(grid), dim3(512), args, LDS_BYTES, stream);
  if (e != hipSuccess) fprintf(stderr, "cooperative launch failed: %s (grid %d)\n", hipGetErrorString(e), grid);
}
```

```cpp
#include <hip/hip_runtime.h>
#include <hip/hip_cooperative_groups.h>
#include <cstdio>
#include <cstdint>
namespace cg = cooperative_groups;

#define LAS __attribute__((address_space(3)))
#define DI __device__ __forceinline__
typedef unsigned short bf16_t;
typedef short bf16x8 __attribute__((ext_vector_type(8)));
typedef short s16x4 __attribute__((ext_vector_type(4)));
typedef float f32x4 __attribute__((ext_vector_type(4)));
typedef float f32x16 __attribute__((ext_vector_type(16)));
typedef unsigned u32x4 __attribute__((ext_vector_type(4)));
typedef unsigned u32x2 __attribute__((ext_vector_type(2)));

constexpr int DM = 2048;
constexpr int MP = 32768, MS = 512, MT = MP + MS, MPADR = MT + 256;
constexpr int NIN = 23808;
constexpr int LDS_BYTES = 147456;
constexpr float EPS = 1e-6f;

constexpr long O_YP = 0;
constexpr long O_YS = 67108864L;
constexpr long O_FKP = O_YS + 1048576L;
constexpr long O_FVP = O_FKP + 67108864L;
constexpr long O_FLP = O_FVP + 67108864L;
constexpr long O_SSDP = O_FLP + 524288L;
constexpr long O_CONVP = O_SSDP + 4194304L;
constexpr long O_MKP = O_CONVP + 147456L;
constexpr long O_MVP = O_MKP + 8388608L;
constexpr long O_FKS = O_MVP + 8388608L;
constexpr long O_FVS = O_FKS + 1048576L;
constexpr long O_FLS = O_FVS + 1048576L;
constexpr long O_SSDS = O_FLS + 8192L;
constexpr long O_CONVS = O_SSDS + 2097152L;

constexpr size_t al256(size_t x) { return (x + 255) & ~(size_t)255; }
constexpr size_t W_CTL = 0;
constexpr size_t W_R1 = 4096;
constexpr size_t W_RM = al256(W_R1 + (size_t)MT * 4);
constexpr size_t W_RS = al256(W_RM + 4096 * 4);
constexpr size_t W_XB = al256(W_RS + (size_t)MT * 4);
constexpr size_t W_MB = al256(W_XB + (size_t)MT * DM * 2);
constexpr size_t W_WIN = al256(W_MB + (size_t)4096 * DM * 2);
constexpr size_t W_WMEM = al256(W_WIN + (size_t)NIN * DM * 2);
constexpr size_t W_WO = al256(W_WMEM + (size_t)4096 * DM * 2);
constexpr size_t W_WOUT = al256(W_WO + (size_t)2048 * 6144 * 2);
constexpr size_t W_ZB = al256(W_WOUT + (size_t)2048 * 2048 * 2);
constexpr size_t W_XBCP = al256(W_ZB + (size_t)MT * DM * 2);
constexpr size_t W_XBCS = al256(W_XBCP + (size_t)16 * 2051 * 3072 * 2);
constexpr size_t W_DT = al256(W_XBCS + (size_t)8 * 67 * 3072 * 2);
constexpr size_t W_FQ = al256(W_DT + (size_t)MT * 32 * 4);
constexpr size_t W_FK = al256(W_FQ + (size_t)MPADR * DM * 2);
constexpr size_t W_FV = al256(W_FK + (size_t)MP * DM * 2);
constexpr size_t W_KS = al256(W_FV + (size_t)MP * DM * 2);
constexpr size_t W_VS = al256(W_KS + (size_t)8 * 1088 * DM * 2);
constexpr size_t W_FG = al256(W_VS + (size_t)8 * 1088 * DM * 2);
constexpr size_t W_MQ = al256(W_FG + (size_t)MPADR * DM * 2);
constexpr size_t W_MG = al256(W_MQ + (size_t)MPADR * DM * 2);
constexpr size_t W_G3 = al256(W_MG + (size_t)MT * DM * 2);
constexpr size_t W_LFT = al256(W_G3 + (size_t)MT * 6144 * 2);
constexpr size_t W_LFS = al256(W_LFT + (size_t)256 * 2048 * 4);
constexpr size_t W_MKP = al256(W_LFS + (size_t)128 * 1088 * 4);
constexpr size_t W_VTP = al256(W_MKP + (size_t)4096 * DM * 2);
constexpr size_t W_MKS = al256(W_VTP + (size_t)4096 * DM * 2);
constexpr size_t W_VTS = al256(W_MKS + (size_t)2048 * DM * 2);
constexpr size_t W_PM = al256(W_VTS + (size_t)2048 * DM * 2);
constexpr size_t W_PSUM = al256(W_PM + (size_t)MPADR * 1024 * 2);
constexpr size_t W_Y3 = al256(W_PSUM + (size_t)MT * 16 * 4);
constexpr size_t W_SSQP = al256(W_Y3 + (size_t)MT * 6144 * 2);
constexpr size_t W_MRG = al256(W_SSQP + (size_t)MT * 64 * 4);
constexpr size_t W_PARTO = al256(W_MRG + (size_t)MT * DM * 2);
constexpr size_t W_TMP = al256(W_PARTO + (size_t)MT * 32 * 4);
constexpr size_t W_PARTM = al256(W_TMP + (size_t)MT * DM * 4);
constexpr size_t W_PART5 = al256(W_PARTM + (size_t)3 * MS * DM * 4);
constexpr size_t W_XCT = al256(W_PART5 + (size_t)4 * MS * DM * 4);
constexpr size_t W_BCN = al256(W_XCT + (size_t)520 * 32 * 4096 * 2);
constexpr size_t W_BTT = al256(W_BCN + (size_t)MT * 1024 * 2);
constexpr size_t W_END = al256(W_BTT + (size_t)520 * 4 * 8192 * 2);

struct Params { const float* in[26]; float* out; unsigned char* ws; };

typedef __bf16 bf16x2_t __attribute__((ext_vector_type(2)));
typedef float f32x2_t __attribute__((ext_vector_type(2)));
DI unsigned pk2a(float lo, float hi) { unsigned r; asm volatile("v_cvt_pk_bf16_f32 %0, %1, %2" : "=v"(r) : "v"(lo), "v"(hi)); return r; }
DI unsigned pk2(float lo, float hi) { f32x2_t f = {lo, hi}; bf16x2_t v = __builtin_convertvector(f, bf16x2_t); return __builtin_bit_cast(unsigned, v); }
DI float bf2f(unsigned short b) { return __uint_as_float(((unsigned)b) << 16); }
DI float bflo(unsigned w) { return __uint_as_float(w << 16); }
DI float bfhi(unsigned w) { return __uint_as_float(w & 0xffff0000u); }
DI float sigmoidf_(float x) { return __builtin_amdgcn_rcpf(1.f + __builtin_amdgcn_exp2f(-1.4426950408889634f * x)); }
DI float siluf_(float x) { return x * __builtin_amdgcn_rcpf(1.f + __builtin_amdgcn_exp2f(-1.4426950408889634f * x)); }
DI float softplusf_(float x) { return x > 20.f ? x : log1pf(__expf(x)); }
DI float wave_sum(float v) {
#pragma unroll
  for (int o = 1; o < 64; o <<= 1) v += __shfl_xor(v, o);
  return v;
}
DI bf16x8 pack8(f32x4 a, f32x4 b) {
  u32x4 w = {pk2(a[0], a[1]), pk2(a[2], a[3]), pk2(b[0], b[1]), pk2(b[2], b[3])};
  return __builtin_bit_cast(bf16x8, w);
}
DI bf16x8 pack8a(f32x4 a, f32x4 b) {
  u32x4 w = {pk2a(a[0], a[1]), pk2a(a[2], a[3]), pk2a(b[0], b[1]), pk2a(b[2], b[3])};
  return __builtin_bit_cast(bf16x8, w);
}
DI bf16x8 cat8(u32x2 lo, u32x2 hi) { u32x4 w = {lo[0], lo[1], hi[0], hi[1]}; return __builtin_bit_cast(bf16x8, w); }
#define MFMA16(a, b, c) __builtin_amdgcn_mfma_f32_16x16x32_bf16((a), (b), (c), 0, 0, 0)

namespace pg8 {
constexpr int BM = 256, BK = 64, HALF = 128, HTB = HALF * BK * 2, STAGE_BYTES = 8 * HTB, NXCD = 8, WGM = 8;
DI int lds_byte(int r, int c) { const int st = (r >> 4) * 2 + (c >> 5), rr = r & 15, cc = c & 31, ob = rr * 64 + cc * 2; return st * 1024 + (ob ^ (((ob >> 9) & 1) << 5)); }
DI void stage_rc(int b, int& R, int& C) { const int st = b / 1024, sb = b % 1024, swz = sb ^ (((sb >> 9) & 1) << 5); R = (st >> 1) * 16 + swz / 64; C = (st & 1) * 32 + (swz % 64) / 2; }

struct Unit { const char* A; const char* B; int row0, col0, kind, nvalid, aux; };
struct Gemm { int lda, ldb, K; int delay; };

DI void tile_order(int L, int nM, int nN, int& pm, int& pn) {
  const int nwg = nM * nN; int wgid = L;
  { const int q = nwg / NXCD, r = nwg % NXCD, xcd = wgid % NXCD, off = wgid / NXCD; wgid = (xcd < r ? xcd * (q + 1) : r * (q + 1) + (xcd - r) * q) + off; }
  const int nig = WGM * nN, gid = wgid / nig, fm = gid * WGM, gsz = (nM - fm) < WGM ? (nM - fm) : WGM;
  pm = fm + ((wgid % nig) % gsz); pn = (wgid % nig) / gsz;
}

template <class Epi, class Sched>
DI void gemm_phase(LAS unsigned char* lds, const Gemm g, const Sched& S, const Epi& E) {
  int tid = threadIdx.x; asm volatile("" : "+v"(tid));
  const int wid = __builtin_amdgcn_readfirstlane(tid >> 6), lane = tid & 63, wr = wid >> 2, wc = wid & 3, fr = lane & 15, fq = lane >> 4;
  int K = g.K; asm volatile("" : "+s"(K));
  const int nt = K / BK;
  unsigned voffA[2], voffB[2];
#pragma unroll
  for (int i = 0; i < 2; ++i) { int R, C; stage_rc(tid * 16 + i * 8192, R, C);
    voffA[i] = (unsigned)(R * g.lda + C) * 2u; voffB[i] = (unsigned)(R * g.ldb + C) * 2u; }
  const size_t kstep = (size_t)(BK * 2);
  const size_t hstepA = (size_t)HALF * g.lda * 2, hstepB = (size_t)HALF * g.ldb * 2;
  const unsigned ldsw = (unsigned)wid * 1024u;
  const int aoff = lds_byte(wr * 64 + fr, fq * 8), boff = lds_byte(wc * 32 + fr, fq * 8);
#define PG8_SA(b, h) (((b) * 2 + (h)) * HTB)
#define PG8_SB(b, h) ((4 + (b) * 2 + (h)) * HTB)
#define PG8_STAGE(bufoff, gbase, voff) do { _Pragma("unroll") for (int _i = 0; _i < 2; ++_i) \
        __builtin_amdgcn_global_load_lds((const unsigned*)((const char*)(gbase) + (voff)[_i]), (LAS unsigned*)(lds + (bufoff) + ldsw + _i * 8192), 16, 0, 0); } while (0)
#define PG8_LDA(dst, b, h) do { _Pragma("unroll") for (int m = 0; m < 4; ++m) _Pragma("unroll") for (int k = 0; k < 2; ++k) dst[m][k] = *(const LAS bf16x8*)(lds + PG8_SA(b, h) + aoff + m * 2048 + k * 1024); } while (0)
#define PG8_LDB(dst, b, h) do { _Pragma("unroll") for (int n = 0; n < 2; ++n) _Pragma("unroll") for (int k = 0; k < 2; ++k) dst[n][k] = *(const LAS bf16x8*)(lds + PG8_SB(b, h) + boff + n * 2048 + k * 1024); } while (0)
#define PG8_MMA(ai, bj, At, Bt) do { __builtin_amdgcn_s_setprio(1); _Pragma("unroll") for (int m = 0; m < 4; ++m) _Pragma("unroll") for (int n = 0; n < 2; ++n) _Pragma("unroll") for (int k = 0; k < 2; ++k) \
        acc[ai][bj][m][n] = __builtin_amdgcn_mfma_f32_16x16x32_bf16(Bt[n][k], At[m][k], acc[ai][bj][m][n], 0, 0, 0); __builtin_amdgcn_s_setprio(0); } while (0)
#define PG8_WAIT_V(n) asm volatile("s_waitcnt vmcnt(" #n ")" ::: "memory")
#define PG8_WAIT_L(n) asm volatile("s_waitcnt lgkmcnt(" #n ")" ::: "memory")
#define PG8_BAR __builtin_amdgcn_s_barrier()
#define PG8_SCHED __builtin_amdgcn_sched_barrier(0)
  Unit cur, nxt; int ui = 0;
  if (!S.next(0, cur)) return;
  if (g.delay > 0) { const unsigned long long t0_ = __builtin_amdgcn_s_memrealtime(); while ((long long)(__builtin_amdgcn_s_memrealtime() - t0_) < (long long)g.delay) __builtin_amdgcn_s_sleep(16); }
  f32x4 acc[2][2][4][2];
#pragma unroll
  for (int a = 0; a < 2; ++a)
#pragma unroll
    for (int b = 0; b < 2; ++b)
#pragma unroll
      for (int m = 0; m < 4; ++m)
#pragma unroll
        for (int n = 0; n < 2; ++n) acc[a][b][m][n] = (f32x4){0.f, 0.f, 0.f, 0.f};
  bf16x8 At[4][2], B0[2][2], B1[2][2];
  const char* cA = cur.A; const char* cB = cur.B;
  PG8_STAGE(PG8_SB(0, 0), cB, voffB); PG8_STAGE(PG8_SA(0, 0), cA, voffA); PG8_STAGE(PG8_SB(0, 1), cB + hstepB, voffB); PG8_STAGE(PG8_SA(0, 1), cA + hstepA, voffA);
  if (wr == 1) PG8_BAR;
  PG8_WAIT_V(4); PG8_BAR;
  PG8_STAGE(PG8_SB(1, 0), cB + kstep, voffB); PG8_STAGE(PG8_SA(1, 0), cA + kstep, voffA); PG8_STAGE(PG8_SB(1, 1), cB + hstepB + kstep, voffB);
  PG8_WAIT_V(6); PG8_BAR;
  for (;;) {
    const bool has_next = S.next(ui + 1, nxt);
    const char* nA = has_next ? nxt.A : cA; const char* nB = has_next ? nxt.B : cB;
    for (int t = 0; t < nt; t += 2) {
      const bool last = (t == nt - 2);
      if constexpr (Epi::HOOK) { if (t == 32 || t == 64) E.rescale(acc, cur, t >> 5, wr, wc, fr, fq); }
      const char* a1 = cA + (size_t)(t + 1) * kstep;
      const char* a2 = last ? nA : cA + (size_t)(t + 2) * kstep; const char* b2 = last ? nB : cB + (size_t)(t + 2) * kstep;
      const char* a3 = a2 + kstep; const char* b3 = b2 + kstep;
      PG8_LDB(B0, 0, 0); PG8_SCHED; PG8_LDA(At, 0, 0); PG8_STAGE(PG8_SA(1, 1), a1 + hstepA, voffA);
      PG8_WAIT_L(8); PG8_BAR; PG8_WAIT_L(0); PG8_MMA(0, 0, At, B0); PG8_BAR; PG8_SCHED;
      PG8_LDB(B1, 0, 1); PG8_STAGE(PG8_SB(0, 0), b2, voffB);
      PG8_BAR; PG8_WAIT_L(0); PG8_MMA(0, 1, At, B1); PG8_BAR;
      PG8_LDA(At, 0, 1); PG8_STAGE(PG8_SA(0, 0), a2, voffA);
      PG8_BAR; PG8_WAIT_L(0); PG8_MMA(1, 0, At, B0); PG8_BAR; PG8_SCHED;
      PG8_STAGE(PG8_SB(0, 1), b2 + hstepB, voffB);
      PG8_WAIT_V(6); PG8_BAR; PG8_MMA(1, 1, At, B1); PG8_BAR;
      PG8_LDB(B0, 1, 0); PG8_SCHED; PG8_LDA(At, 1, 0); PG8_STAGE(PG8_SA(0, 1), a2 + hstepA, voffA);
      PG8_WAIT_L(8); PG8_BAR; PG8_WAIT_L(0); PG8_MMA(0, 0, At, B0); PG8_BAR; PG8_SCHED;
      PG8_LDB(B1, 1, 1); PG8_STAGE(PG8_SB(1, 0), b3, voffB);
      PG8_BAR; PG8_WAIT_L(0); PG8_MMA(0, 1, At, B1); PG8_BAR;
      PG8_LDA(At, 1, 1); PG8_STAGE(PG8_SA(1, 0), a3, voffA);
      PG8_BAR; PG8_WAIT_L(0); PG8_MMA(1, 0, At, B0); PG8_BAR; PG8_SCHED;
      PG8_STAGE(PG8_SB(1, 1), b3 + hstepB, voffB);
      PG8_WAIT_V(6); PG8_BAR; PG8_MMA(1, 1, At, B1); PG8_BAR;
    }
    E(acc, cur, wr, wc, fr, fq);
    if (!has_next) break;
#pragma unroll
    for (int a = 0; a < 2; ++a)
#pragma unroll
      for (int b = 0; b < 2; ++b)
#pragma unroll
        for (int m = 0; m < 4; ++m)
#pragma unroll
          for (int n = 0; n < 2; ++n) acc[a][b][m][n] = (f32x4){0.f, 0.f, 0.f, 0.f};
    cur = nxt; cA = nA; cB = nB; ++ui;
  }
  PG8_WAIT_V(0);
  if (wr == 0) PG8_BAR;
  PG8_BAR;
#undef PG8_SA
#undef PG8_SB
#undef PG8_STAGE
#undef PG8_LDA
#undef PG8_LDB
#undef PG8_MMA
#undef PG8_WAIT_V
#undef PG8_WAIT_L
#undef PG8_BAR
#undef PG8_SCHED
}
}
using pg8::Unit;
typedef const f32x4 (&AccRef)[2][2][4][2];

DI void st_bf4(bf16_t* p, f32x4 v) { u32x2 w = {pk2(v[0], v[1]), pk2(v[2], v[3])}; *(u32x2*)p = w; }
DI void st_bf4a(bf16_t* p, f32x4 v) { u32x2 w = {pk2a(v[0], v[1]), pk2a(v[2], v[3])}; *(u32x2*)p = w; }
DI f32x4 ld_bf4(const bf16_t* p) { u32x2 w = *(const u32x2*)p; return (f32x4){bflo(w[0]), bfhi(w[0]), bflo(w[1]), bfhi(w[1])}; }

struct EpiIn {
  static constexpr bool HOOK = false;
  Params P; LAS unsigned char* ldsb;
  DI void rescale(f32x4 (&)[2][2][4][2], const Unit&, int, int, int, int, int) const {}
  DI void operator()(AccRef acc, const Unit& u, int wr, int wc, int fr, int fq) const {
    unsigned char* ws = P.ws; float* out = P.out;
    if (u.kind == 1) {
      const bool isV = u.col0 >= 2048; const int cb = isV ? u.col0 - 2048 : u.col0;
      float* fo = out + (isV ? O_MVP : O_MKP);
      bf16_t* MKP = (bf16_t*)(ws + W_MKP); bf16_t* VTP = (bf16_t*)(ws + W_VTP);
#pragma unroll
      for (int ai = 0; ai < 2; ++ai)
#pragma unroll
        for (int m = 0; m < 4; ++m) {
          const int row = u.row0 + ai * 128 + wr * 64 + m * 16 + fr;
#pragma unroll
          for (int bj = 0; bj < 2; ++bj)
#pragma unroll
            for (int n = 0; n < 2; ++n) {
              const int c = cb + bj * 128 + wc * 32 + n * 16 + 4 * fq;
              const f32x4 v = acc[ai][bj][m][n];
              *(f32x4*)(fo + (size_t)row * 2048 + c) = v;
              if (!isV) st_bf4(MKP + (size_t)row * 2048 + c, v);
              else { const int b = row >> 8, key = row & 255, h = c >> 9, d = c & 511;
                bf16_t* vt = VTP + ((size_t)((b * 4 + h) * 512 + d)) * 256 + key;
                const unsigned w0 = pk2(v[0], v[1]), w1 = pk2(v[2], v[3]);
                vt[0] = (bf16_t)(w0 & 0xffff); vt[256] = (bf16_t)(w0 >> 16); vt[512] = (bf16_t)(w1 & 0xffff); vt[768] = (bf16_t)(w1 >> 16); }
            }
        }
      return;
    }
    const bool sample = u.row0 >= MP;
    const int T = sample ? 64 : 2048;
    const int col0 = u.col0;
    if (col0 >= 23552) {
      if (wc > 1) return;
      const float* dtb = P.in[14]; const float* bfg = P.in[18];
      float* DT = (float*)(ws + W_DT);
      float* LFT = (float*)(ws + W_LFT); float* LFS = (float*)(ws + W_LFS);
#pragma unroll
      for (int ai = 0; ai < 2; ++ai)
#pragma unroll
        for (int m = 0; m < 4; ++m) {
          const int row = u.row0 + ai * 128 + wr * 64 + m * 16 + fr;
          const int rs = row - MP; const int b = sample ? (rs >> 6) : (row >> 11), t = sample ? (rs & 63) : (row & 2047);
#pragma unroll
          for (int n = 0; n < 2; ++n) {
            const int c = wc * 32 + n * 16 + 4 * fq;
            const f32x4 v = acc[ai][0][m][n];
            if (c < 32) { f32x4 o;
#pragma unroll
              for (int e = 0; e < 4; ++e) o[e] = softplusf_(v[e] + dtb[c + e]);
              *(f32x4*)(DT + (size_t)row * 32 + c) = o; }
            else if (c < 48) { const int h0 = c - 32; f32x4 o;
#pragma unroll
              for (int e = 0; e < 4; ++e) o[e] = -softplusf_(-(v[e] + bfg[h0 + e]));
              float* lo = sample ? out + O_FLS + (size_t)rs * 16 + h0 : out + O_FLP + (size_t)row * 16 + h0;
              *(f32x4*)lo = o;
#pragma unroll
              for (int e = 0; e < 4; ++e) { if (sample) LFS[(size_t)(b * 16 + h0 + e) * 1088 + 1024 + t] = o[e]; else LFT[(size_t)(b * 16 + h0 + e) * 2048 + t] = o[e]; }
            }
          }
        }
      return;
    }
    const bool smp = sample;
    if (col0 < 2048) seg_store<1, 0, false, false>(acc, u, wr, wc, fr, fq, (bf16_t*)(ws + W_ZB), 2048, col0, nullptr, nullptr, smp);
    else if (col0 < 5120) seg_store<0, 1, false, true>(acc, u, wr, wc, fr, fq, (bf16_t*)(ws + (smp ? W_XBCS : W_XBCP)), 3072, col0 - 2048, nullptr, out + (smp ? O_CONVS : O_CONVP), smp);
    else if (col0 < 7168) seg_store<0, 0, false, false>(acc, u, wr, wc, fr, fq, (bf16_t*)(ws + W_FQ), 2048, col0 - 5120, nullptr, nullptr, smp);
    else if (col0 < 9216) seg_store<0, 2, true, false>(acc, u, wr, wc, fr, fq, (bf16_t*)(ws + (smp ? W_KS : W_FK)), 2048, col0 - 7168, out + (smp ? O_FKS : O_FKP), nullptr, smp);
    else if (col0 < 11264) seg_store<0, 2, true, false>(acc, u, wr, wc, fr, fq, (bf16_t*)(ws + (smp ? W_VS : W_FV)), 2048, col0 - 9216, out + (smp ? O_FVS : O_FVP), nullptr, smp);
    else if (col0 < 13312) seg_store<1, 0, false, false>(acc, u, wr, wc, fr, fq, (bf16_t*)(ws + W_FG), 2048, col0 - 11264, nullptr, nullptr, smp);
    else if (col0 < 15360) seg_store<0, 0, false, false>(acc, u, wr, wc, fr, fq, (bf16_t*)(ws + W_MQ), 2048, col0 - 13312, nullptr, nullptr, smp);
    else if (col0 < 17408) seg_store<1, 0, false, false>(acc, u, wr, wc, fr, fq, (bf16_t*)(ws + W_MG), 2048, col0 - 15360, nullptr, nullptr, smp);
    else seg_store<2, 0, false, false>(acc, u, wr, wc, fr, fq, (bf16_t*)(ws + W_G3), 6144, col0 - 17408, nullptr, nullptr, smp);
  }
  template <int ACT, int ROWMODE, bool HASF, bool HASCONV>
  DI void seg_store(AccRef acc, const Unit& u, int wr, int wc, int fr, int fq, bf16_t* dst, int ld, int c0, float* fout, float* convout, bool sample) const {
    const int T = sample ? 64 : 2048;
    const int cl = c0 + wc * 32 + 4 * fq;
    const int lane = fr + 16 * fq, wid = wr * 4 + wc;
    LAS unsigned char* stg = ldsb + 131072 + wid * 1280;
    const int rS = lane >> 2, cS = (lane & 3) * 8;
#pragma unroll
    for (int ai = 0; ai < 2; ++ai)
#pragma unroll
      for (int m = 0; m < 4; ++m) {
        const int row = u.row0 + ai * 128 + wr * 64 + m * 16 + fr;
        const int rs = row - MP; const int b = sample ? (rs >> 6) : (row >> 11), t = sample ? (rs & 63) : (row & 2047);
        float* fp = HASF ? fout + (sample ? (size_t)rs : (size_t)row) * 2048 + cl : nullptr;
        const bool ctail = HASCONV && t >= T - 3;
        float* cp = HASCONV ? convout + (size_t)(b * 3 + t - (T - 3)) * 3072 + cl : nullptr;
        const int rowS = u.row0 + ai * 128 + wr * 64 + m * 16 + rS;
        size_t drow = (size_t)rowS;
        if (ROWMODE != 0) { const int rsS = rowS - MP; const int bS = sample ? (rsS >> 6) : (rowS >> 11), tS = sample ? (rsS & 63) : (rowS & 2047);
          if (ROWMODE == 1) drow = sample ? (size_t)(bS * 67 + 3 + tS) : (size_t)(bS * 2051 + 3 + tS);
          else drow = sample ? (size_t)(bS * 1088 + 1024 + tS) : (size_t)rowS; }
        bf16_t* dp = dst + drow * ld + c0 + wc * 32 + cS;
#pragma unroll
        for (int bj = 0; bj < 2; ++bj) {
#pragma unroll
          for (int n = 0; n < 2; ++n) {
            const int co = bj * 128 + n * 16;
            f32x4 v = acc[ai][bj][m][n];
            if (HASF) *(f32x4*)(fp + co) = v;
            if (HASCONV) { if (ctail) *(f32x4*)(cp + co) = v; }
            if (ACT == 1) {
#pragma unroll
              for (int e = 0; e < 4; ++e) v[e] = siluf_(v[e]);
            } else if (ACT == 2) {
#pragma unroll
              for (int e = 0; e < 4; ++e) v[e] = sigmoidf_(v[e]);
            }
            u32x2 w = {pk2(v[0], v[1]), pk2(v[2], v[3])};
            *(LAS u32x2*)(stg + fr * 80 + n * 32 + fq * 8) = w;
          }
          const u32x4 o = *(const LAS u32x4*)(stg + rS * 80 + cS * 2);
          *(u32x4*)(dp + bj * 128) = o;
        }
      }
  }
};
struct SchedP1 {
  int c, G; const char* XB; const char* WIN; const char* MB; const char* WMEM;
  DI bool next(int i, Unit& u) const {
    const int L = i * G + c;
    constexpr int N1 = 130 * 93;
    if (L < N1) { int pm, pn; pg8::tile_order(L, 130, 93, pm, pn);
      u.A = XB + (size_t)pm * 256 * 2048 * 2; u.B = WIN + (size_t)pn * 256 * 2048 * 2; u.row0 = pm * 256; u.col0 = pn * 256; u.kind = 0; u.nvalid = 256; u.aux = 0; return true; }
    const int L2 = L - N1; if (L2 >= 256) return false;
    int pm, pn; pg8::tile_order(L2, 16, 16, pm, pn);
    u.A = MB + (size_t)pm * 256 * 2048 * 2; u.B = WMEM + (size_t)pn * 256 * 2048 * 2; u.row0 = pm * 256; u.col0 = pn * 256; u.kind = 1; u.nvalid = 256; u.aux = 0; return true;
  }
};

struct EpiS {
  static constexpr bool HOOK = false;
  Params P;
  DI void rescale(f32x4 (&)[2][2][4][2], const Unit&, int, int, int, int, int) const {}
  DI void operator()(AccRef acc, const Unit& u, int wr, int wc, int fr, int fq) const {
    bf16_t* PM = (bf16_t*)(P.ws + W_PM); float* PSUM = (float*)(P.ws + W_PSUM);
    const float c2 = 0.044194173824159216f * 1.4426950408889634f;
    const int h = u.aux;
#pragma unroll
    for (int ai = 0; ai < 2; ++ai)
#pragma unroll
      for (int m = 0; m < 4; ++m) {
        const int rr = ai * 128 + wr * 64 + m * 16 + fr; const int row = u.row0 + rr; const bool ok = rr < u.nvalid;
        float s = 0.f;
#pragma unroll
        for (int bj = 0; bj < 2; ++bj)
#pragma unroll
          for (int n = 0; n < 2; ++n) {
            const int c = bj * 128 + wc * 32 + n * 16 + 4 * fq;
            f32x4 e;
#pragma unroll
            for (int k = 0; k < 4; ++k) { e[k] = __builtin_amdgcn_exp2f(fminf(acc[ai][bj][m][n][k] * c2, 100.f)); s += e[k]; }
            if (ok) st_bf4(PM + (size_t)row * 1024 + h * 256 + c, e);
          }
        s += __shfl_xor(s, 16); s += __shfl_xor(s, 32);
        if (ok && fq == 0) PSUM[(size_t)row * 16 + h * 4 + wc] = s;
      }
  }
};
struct SchedS {
  int c, G; const char* MQ; const char* MKP; const char* MKS;
  DI bool next(int i, Unit& u) const {
    const int L = i * G + c; if (L >= 544) return false;
    u.col0 = 0; u.kind = 0;
    if (L < 512) { const int b = L >> 5, h = (L >> 3) & 3, mt = L & 7; u.row0 = b * 2048 + mt * 256; u.nvalid = 256; u.aux = h;
      u.A = MQ + ((size_t)u.row0 * 2048 + h * 512) * 2; u.B = MKP + ((size_t)(b * 256) * 2048 + h * 512) * 2; }
    else { const int j = L - 512, b = j >> 2, h = j & 3; u.row0 = MP + b * 64; u.nvalid = 64; u.aux = h;
      u.A = MQ + ((size_t)u.row0 * 2048 + h * 512) * 2; u.B = MKS + ((size_t)(b * 256) * 2048 + h * 512) * 2; }
    return true;
  }
};
struct EpiPV {
  static constexpr bool HOOK = false;
  Params P;
  DI void rescale(f32x4 (&)[2][2][4][2], const Unit&, int, int, int, int, int) const {}
  DI void operator()(AccRef acc, const Unit& u, int wr, int wc, int fr, int fq) const {
    const float* PSUM = (const float*)(P.ws + W_PSUM); const bf16_t* MG = (const bf16_t*)(P.ws + W_MG); bf16_t* Y3 = (bf16_t*)(P.ws + W_Y3);
    const int h = u.aux >> 9;
#pragma unroll
    for (int ai = 0; ai < 2; ++ai)
#pragma unroll
      for (int m = 0; m < 4; ++m) {
        int rr = ai * 128 + wr * 64 + m * 16 + fr; asm volatile("" : "+v"(rr)); const int row = u.row0 + rr;
        if (!(m & 1)) __builtin_amdgcn_sched_barrier(0);
        if (rr < u.nvalid) {
          const f32x4 ps = *(const f32x4*)(PSUM + (size_t)row * 16 + h * 4);
          const float inv = 1.f / ((ps[0] + ps[1]) + (ps[2] + ps[3]));
#pragma unroll
          for (int bj = 0; bj < 2; ++bj)
#pragma unroll
            for (int n = 0; n < 2; ++n) {
              const int c = u.aux + bj * 128 + wc * 32 + n * 16 + 4 * fq;
              const f32x4 gte = ld_bf4(MG + (size_t)row * 2048 + c);
              st_bf4(Y3 + (size_t)row * 6144 + 4096 + c, acc[ai][bj][m][n] * gte * inv);
            }
        }
      }
  }
};
struct SchedPV {
  int c, G; const char* PM; const char* VTP; const char* VTS;
  DI bool next(int i, Unit& u) const {
    const int L = i * G + c; if (L >= 1088) return false;
    u.col0 = 0; u.kind = 0;
    if (L < 1024) { const int b = L >> 6, h = (L >> 4) & 3, mt = (L >> 1) & 7, n2 = L & 1; u.row0 = b * 2048 + mt * 256; u.nvalid = 256; u.aux = h * 512 + n2 * 256;
      u.A = PM + ((size_t)u.row0 * 1024 + h * 256) * 2; u.B = VTP + ((size_t)((b * 4 + h) * 512 + n2 * 256) * 256) * 2; }
    else { const int j = L - 1024, b = j >> 3, h = (j >> 1) & 3, n2 = j & 1; u.row0 = MP + b * 64; u.nvalid = 64; u.aux = h * 512 + n2 * 256;
      u.A = PM + ((size_t)u.row0 * 1024 + h * 256) * 2; u.B = VTS + ((size_t)((b * 4 + h) * 512 + n2 * 256) * 256) * 2; }
    return true;
  }
};

struct EpiMerge {
  static constexpr bool HOOK = false;
  Params P;
  DI void rescale(f32x4 (&)[2][2][4][2], const Unit&, int, int, int, int, int) const {}
  DI void operator()(AccRef acc, const Unit& u, int wr, int wc, int fr, int fq) const {
    const bf16_t* G3 = (const bf16_t*)(P.ws + W_G3); bf16_t* MRG = (bf16_t*)(P.ws + W_MRG); bf16_t* TMP = (bf16_t*)(P.ws + W_TMP);
    float* PARTM = (float*)(P.ws + W_PARTM);
    const float* RS = (const float*)(P.ws + W_RS);
    const int seg = u.kind >= 3 ? u.kind - 3 : u.kind; const bool part = u.kind >= 3;
#pragma unroll
    for (int ai = 0; ai < 2; ++ai)
#pragma unroll
      for (int m = 0; m < 4; ++m) {
        int row = u.row0 + ai * 128 + wr * 64 + m * 16 + fr; asm volatile("" : "+v"(row));
        const float rs = (seg == 0) ? RS[row] : 1.f;
#pragma unroll
        for (int bj = 0; bj < 2; ++bj)
#pragma unroll
          for (int n = 0; n < 2; ++n) {
            const int c = u.col0 + bj * 128 + wc * 32 + n * 16 + 4 * fq;
            const f32x4 gte = ld_bf4(G3 + (size_t)row * 6144 + seg * 2048 + c);
            f32x4 v = acc[ai][bj][m][n] * gte * rs;
            const size_t to = (size_t)row * 2048 + c;
            if (part) { *(f32x4*)(PARTM + ((size_t)seg * MS + (row - MP)) * 2048 + c) = v; }
            else {
              if (seg > 0) v += ld_bf4(TMP + to);
              if (seg < 2) st_bf4(TMP + to, v); else st_bf4(MRG + to, v);
            }
          }
        if (m & 1) __builtin_amdgcn_sched_barrier(0);
      }
  }
};
struct SchedMerge {
  int c, G; const char* A; const char* B;
  DI bool next(int i, Unit& u) const {
    int pm, pn, seg, kind;
    if (i < 12) { const int ti = i / 3; seg = i - ti * 3; const int L = ti * 256 + c; pm = (L >> 6) * 8 + (L & 7); pn = (L >> 3) & 7; kind = seg; }
    else if (i == 12 && c < 48) { const int e = c / 3; seg = c - e * 3; pm = 128 + (e >> 3); pn = e & 7; kind = 3 + seg; }
    else return false;
    u.A = A + ((size_t)pm * 256 * 6144 + seg * 2048) * 2; u.B = B + ((size_t)pn * 256 * 6144 + seg * 2048) * 2; u.row0 = pm * 256; u.col0 = pn * 256; u.kind = kind; u.nvalid = 256; u.aux = pn; return true;
  }
};
struct SchedOutP {
  int c; const char* A; const char* B;
  DI bool next(int i, Unit& u) const {
    if (i >= 4) return false;
    const int L = i * 256 + c; const int pm = (L >> 6) * 8 + (L & 7), pn = (L >> 3) & 7;
    u.A = A + (size_t)pm * 256 * 2048 * 2; u.B = B + (size_t)pn * 256 * 2048 * 2; u.row0 = pm * 256; u.col0 = pn * 256; u.kind = 0; u.nvalid = 256; u.aux = pn; return true;
  }
};
struct SchedOutS {
  int c; const char* A; const char* B;
  DI bool next(int i, Unit& u) const {
    if (i >= 1 || c >= 64) return false;
    const int e = c >> 2, kq = c & 3; const int pm = 128 + (e >> 3), pn = e & 7;
    u.A = A + ((size_t)pm * 256 * 2048 + kq * 512) * 2; u.B = B + ((size_t)pn * 256 * 2048 + kq * 512) * 2; u.row0 = pm * 256; u.col0 = pn * 256; u.kind = 1; u.nvalid = kq; u.aux = pn; return true;
  }
};
struct SchedTile {
  int c, G, nM, nN; const char* A; const char* B; size_t astep, bstep;
  DI bool next(int i, Unit& u) const {
    const int L = i * G + c; if (L >= nM * nN) return false;
    int pm, pn; pg8::tile_order(L, nM, nN, pm, pn);
    u.A = A + (size_t)pm * astep; u.B = B + (size_t)pn * bstep; u.row0 = pm * 256; u.col0 = pn * 256; u.kind = 0; u.nvalid = 256; u.aux = pn; return true;
  }
};
struct EpiOut {
  static constexpr bool HOOK = false;
  Params P;
  DI void rescale(f32x4 (&)[2][2][4][2], const Unit&, int, int, int, int, int) const {}
  DI void operator()(AccRef acc, const Unit& u, int wr, int wc, int fr, int fq) const {
    float* out = P.out; float* PARTO = (float*)(P.ws + W_PARTO);
    if (u.kind == 1) {
      float* PART5 = (float*)(P.ws + W_PART5) + (size_t)u.nvalid * MS * 2048;
#pragma unroll
      for (int ai = 0; ai < 2; ++ai)
#pragma unroll
        for (int m = 0; m < 4; ++m) {
          const int row = u.row0 + ai * 128 + wr * 64 + m * 16 + fr - MP;
#pragma unroll
          for (int bj = 0; bj < 2; ++bj)
#pragma unroll
            for (int n = 0; n < 2; ++n) *(f32x4*)(PART5 + (size_t)row * 2048 + u.col0 + bj * 128 + wc * 32 + n * 16 + 4 * fq) = acc[ai][bj][m][n];
        }
      return;
    }
    const float* xin = P.in[0];
#pragma unroll
    for (int ai = 0; ai < 2; ++ai)
#pragma unroll
      for (int m = 0; m < 4; ++m) {
        const int row = u.row0 + ai * 128 + wr * 64 + m * 16 + fr;
        float s = 0.f;
#pragma unroll
        for (int bj = 0; bj < 2; ++bj)
#pragma unroll
          for (int n = 0; n < 2; ++n) {
            const int c = u.col0 + bj * 128 + wc * 32 + n * 16 + 4 * fq;
            const f32x4 xo = acc[ai][bj][m][n] + *(const f32x4*)(xin + (size_t)row * 2048 + c);
            *(f32x4*)(out + (size_t)row * 2048 + c) = xo;
            s += xo[0] * xo[0] + xo[1] * xo[1] + xo[2] * xo[2] + xo[3] * xo[3];
          }
        s += __shfl_xor(s, 16); s += __shfl_xor(s, 32);
        if (fq == 0) PARTO[(size_t)row * 32 + u.aux * 4 + wc] = s;
      }
  }
};

DI void row_to_bf16(const float* src, bf16_t* dst, float* rs, int lane) {
  const f32x4* s = (const f32x4*)src + lane; f32x4 v[8]; float ss = 0.f;
#pragma unroll
  for (int j = 0; j < 8; ++j) { v[j] = s[64 * j]; ss += (v[j][0] * v[j][0] + v[j][1] * v[j][1]) + (v[j][2] * v[j][2] + v[j][3] * v[j][3]); }
  float sc = 1.f;
  if (rs) { ss = wave_sum(ss); sc = rsqrtf(ss * (1.f / 2048.f) + EPS); }
  u32x2* d = (u32x2*)dst + lane;
#pragma unroll
  for (int j = 0; j < 8; ++j) { u32x2 w = {pk2(v[j][0] * sc, v[j][1] * sc), pk2(v[j][2] * sc, v[j][3] * sc)}; d[64 * j] = w; }
}
DI void transpose_item(const float* W, int ldw, int scol0, int nvalid, const float* scale, bf16_t* WT, int ldd, int drow0, int dcol0, int kb, LAS float* scr, int lane) {
  const int k0 = 64 * kb;
  float tv[32];
  const bool ok_ = (lane & 31) < nvalid;
#pragma unroll
  for (int i = 0; i < 32; ++i) { const int kk = 2 * i + (lane >> 5); tv[i] = ok_ ? W[(size_t)(k0 + kk) * ldw + scol0 + (lane & 31)] : 0.f; }
#pragma unroll
  for (int i = 0; i < 32; ++i) { const int kk = 2 * i + (lane >> 5), n = lane & 31;
    float v = tv[i]; if (scale) v *= scale[k0 + kk];
    scr[kk * 33 + n] = v; }
  asm volatile("s_waitcnt lgkmcnt(0)" ::: "memory");
  const int c = lane & 7;
#pragma unroll
  for (int j = 0; j < 4; ++j) { const int n = (lane >> 3) + 8 * j; const LAS float* s = scr + (8 * c) * 33 + n;
    u32x4 o; o[0] = pk2(s[0 * 33], s[1 * 33]); o[1] = pk2(s[2 * 33], s[3 * 33]); o[2] = pk2(s[4 * 33], s[5 * 33]); o[3] = pk2(s[6 * 33], s[7 * 33]);
    *(u32x4*)(WT + (size_t)(drow0 + n) * ldd + dcol0 + k0 + 8 * c) = o; }
  asm volatile("s_waitcnt lgkmcnt(0)" ::: "memory");
}
DI void phase0(const Params& P, LAS unsigned char* lds) {
  unsigned char* ws = P.ws;
  int tid = threadIdx.x; asm volatile("" : "+v"(tid));
  const int wid = tid >> 6, lane = tid & 63;
  const int gw = blockIdx.x * 8 + wid, NGW = gridDim.x * 8;
  if (blockIdx.x == 0 && tid < 64) ((unsigned*)(ws + W_CTL))[tid] = 0u;
  constexpr int NR = MT + 4096 + 8192;
  for (int r = gw; r < NR; r += NGW) {
    if (r < MP) row_to_bf16(P.in[0] + (size_t)r * 2048, (bf16_t*)(ws + W_XB) + (size_t)r * 2048, (float*)(ws + W_R1), lane);
    else if (r < MT) row_to_bf16(P.in[1] + (size_t)(r - MP) * 2048, (bf16_t*)(ws + W_XB) + (size_t)r * 2048, (float*)(ws + W_R1), lane);
    else if (r < MT + 4096) { const int q = r - MT; row_to_bf16(P.in[2] + (size_t)q * 2048, (bf16_t*)(ws + W_MB) + (size_t)q * 2048, (float*)(ws + W_RM), lane); }
    else if (r < MT + 4096 + 8192) { const int q = r - MT - 4096, b = q >> 10, j = q & 1023; row_to_bf16(P.in[3] + (size_t)q * 2048, (bf16_t*)(ws + W_KS) + (size_t)(b * 1088 + j) * 2048, nullptr, lane); }
    else if (r < MT + 4096 + 16384) { continue; }
    else { continue; }
  }
  LAS float* scr = (LAS float*)(lds + wid * 8448);
  constexpr int I_IN = 744 * 32, I_MEM = 128 * 32, I_O = 64 * 32;
  constexpr int NITEMS = I_IN + I_MEM + 4 * I_O;
  for (int it = gw; it < NITEMS; it += NGW) {
    int r = it;
    if (r < I_IN) { const int nb = r >> 5, kb = r & 31, d = nb * 32; int src, nv = 32;
      if (d < 5120) src = d; else if (d < 13312) src = d + 32; else if (d < 23552) src = d + 48;
      else if (d == 23552) src = 5120; else if (d == 23584) { src = 13344; nv = 16; } else { src = 0; nv = 0; }
      transpose_item(P.in[11], 23600, src, nv, P.in[10], (bf16_t*)(ws + W_WIN), 2048, d, 0, kb, scr, lane); continue; }
    r -= I_IN;
    if (r < I_MEM) { const int nb = r >> 5, kb = r & 31; transpose_item(P.in[20], 4096, nb * 32, 32, P.in[19], (bf16_t*)(ws + W_WMEM), 2048, nb * 32, 0, kb, scr, lane); continue; }
    r -= I_MEM;
    if (r < I_O) { const int nb = r >> 5, kb = r & 31; transpose_item(P.in[21], 2048, nb * 32, 32, P.in[17], (bf16_t*)(ws + W_WO), 6144, nb * 32, 0, kb, scr, lane); continue; }
    r -= I_O;
    if (r < I_O) { const int nb = r >> 5, kb = r & 31; transpose_item(P.in[22], 2048, nb * 32, 32, nullptr, (bf16_t*)(ws + W_WO), 6144, nb * 32, 2048, kb, scr, lane); continue; }
    r -= I_O;
    if (r < I_O) { const int nb = r >> 5, kb = r & 31; transpose_item(P.in[23], 2048, nb * 32, 32, nullptr, (bf16_t*)(ws + W_WO), 6144, nb * 32, 4096, kb, scr, lane); continue; }
    r -= I_O;
    { const int nb = r >> 5, kb = r & 31; transpose_item(P.in[24], 2048, nb * 32, 32, nullptr, (bf16_t*)(ws + W_WOUT), 2048, nb * 32, 0, kb, scr, lane); }
  }
  const long gt = (long)blockIdx.x * 512 + tid, NT = (long)gridDim.x * 512;
  for (long i = gt; i < 8L * 1024 * 16; i += NT) { const int h = (int)(i & 15), j = (int)((i >> 4) & 1023), b = (int)(i >> 14);
    ((float*)(ws + W_LFS))[(size_t)(b * 16 + h) * 1088 + j] = P.in[5][i]; }
  for (long i = gt; i < 8L * 3 * 3072; i += NT) { const int c = (int)(i % 3072), r = (int)((i / 3072) % 3), b = (int)(i / 9216);
    ((bf16_t*)(ws + W_XBCS))[(size_t)(b * 67 + r) * 3072 + c] = (bf16_t)(pk2(P.in[7][i], 0.f) & 0xffff); }
  for (long i = gt; i < 16L * 3 * 3072; i += NT) { const int c = (int)(i % 3072), r = (int)((i / 3072) % 3), b = (int)(i / 9216);
    ((bf16_t*)(ws + W_XBCP))[(size_t)(b * 2051 + r) * 3072 + c] = 0; }
}

DI void p1_tail_convert(const Params& P, int part, int nparts) {
  unsigned char* ws = P.ws;
  int tid = threadIdx.x; asm volatile("" : "+v"(tid));
  const int wid = tid >> 6, lane = tid & 63;
  for (int q = part * 8 + wid; q < 8192; q += nparts * 8) { const int b = q >> 10, j = q & 1023;
    row_to_bf16(P.in[4] + (size_t)q * 2048, (bf16_t*)(ws + W_VS) + (size_t)(b * 1088 + j) * 2048, nullptr, lane); }
  for (int q = part * 8 + wid; q < 2048; q += nparts * 8) row_to_bf16(P.in[8] + (size_t)q * 2048, (bf16_t*)(ws + W_MKS) + (size_t)q * 2048, nullptr, lane);
  const long gt = (long)part * 512 + tid, NT = (long)nparts * 512;
  for (long i = gt; i < 8L * 32 * 2048; i += NT) {
    const int hd = (int)(i & 2047), kg = (int)((i >> 11) & 31), b = (int)(i >> 16);
    const float* s = P.in[9] + ((size_t)(b * 256 + kg * 8) * 2048 + hd);
    u32x4 o; o[0] = pk2(s[0], s[2048]); o[1] = pk2(s[2 * 2048], s[3 * 2048]); o[2] = pk2(s[4 * 2048], s[5 * 2048]); o[3] = pk2(s[6 * 2048], s[7 * 2048]);
    *(u32x4*)((bf16_t*)(ws + W_VTS) + ((size_t)(b * 2048 + hd)) * 256 + kg * 8) = o;
  }
}

namespace fa {
constexpr int D = 128, LD = 2048, LDO = 6144;
constexpr float SCALE = 0.08838834764831845f;
constexpr float THR = 8.f;
constexpr int NW = 8, QBLK = 32, KVBLK = 64, QB = NW * QBLK;
constexpr int SHM_V = KVBLK * D * 2, SHM_K = KVBLK * D * 2;
constexpr int TAB_OFF = 2 * SHM_V + 2 * SHM_K + NW * 64 * 4;
constexpr unsigned WBIG = 0x7fffffffu;
constexpr int OSTG_OFF = 77824;
#define KSWZ(row, colB) ((row) * 256 + ((colB) ^ (((row) & 7) << 4)))
#define SBAR() __builtin_amdgcn_sched_barrier(0)
DI int v_st(int k, int c) { const int kk = (k & ~0xC) | ((k & 4) << 1) | ((k & 8) >> 1); return ((kk >> 3) * 4 + (c >> 5)) * 512 + ((kk & 7) * 32 + (c & 31)) * 2; }
DI int v_rd_base(int lane) { return ((lane & 3) << 3) | (((lane >> 2) & 3) << 6) | (((lane >> 4) & 1) << 5) | (((lane >> 5) & 1) << 8); }
constexpr int v_rd_off(int d0, int ks, int half) { return d0 * 512 + ks * 4096 + half * 2048; }
DI int crow(int r, int hi) { return (r & 3) + 8 * (r >> 2) + 4 * hi; }
DI bf16x8 load8(const bf16_t* p) { return *reinterpret_cast<const bf16x8*>(p); }
DI void mask_tile(f32x16& p0, f32x16& p1, int dq, unsigned W) {
  const float NEG = -__builtin_inff();
#pragma unroll
  for (int r = 0; r < 16; ++r) {
    const int c = (r & 3) + 8 * (r >> 2);
    if ((unsigned)(dq - c) >= W) p0[r] = NEG;
    if ((unsigned)(dq - c - 32) >= W) p1[r] = NEG;
  }
}
DI void partialSM(f32x16& p0, f32x16& p1, float& m_reg, float& mn, float& alpha) {
  float pmax = p0[0];
#pragma unroll
  for (int r = 1; r < 16; ++r) pmax = fmaxf(pmax, p0[r]);
#pragma unroll
  for (int r = 0; r < 16; ++r) pmax = fmaxf(pmax, p1[r]);
  { auto rr = __builtin_amdgcn_permlane32_swap(__float_as_uint(pmax), __float_as_uint(pmax), false, false);
    pmax = fmaxf(__uint_as_float(rr[0]), __uint_as_float(rr[1])); }
  constexpr float C2 = 1.4426950408889634f * SCALE;
  if (__builtin_expect(__all((pmax - m_reg) * SCALE <= THR), 1)) { mn = m_reg; alpha = 1.f; }
  else { mn = fmaxf(m_reg, pmax); alpha = __builtin_amdgcn_exp2f((m_reg - mn) * C2); m_reg = mn; }
  const float mnL = -mn * C2;
#pragma unroll
  for (int r = 0; r < 16; ++r) p0[r] = fmaf(p0[r], C2, mnL);
#pragma unroll
  for (int r = 0; r < 16; ++r) p1[r] = fmaf(p1[r], C2, mnL);
#pragma unroll
  for (int r = 0; r < 16; ++r) p0[r] = __builtin_amdgcn_exp2f(p0[r]);
}
DI void finishSM(f32x16& p0, f32x16& p1, float alpha, float& l_reg, bf16x8& pa0, bf16x8& pa1, bf16x8& pa2, bf16x8& pa3) {
#pragma unroll
  for (int r = 0; r < 16; ++r) p1[r] = __builtin_amdgcn_exp2f(p1[r]);
  float ps = 0;
#pragma unroll
  for (int r = 0; r < 16; ++r) ps += p0[r];
#pragma unroll
  for (int r = 0; r < 16; ++r) ps += p1[r];
  { auto rr = __builtin_amdgcn_permlane32_swap(__float_as_uint(ps), __float_as_uint(ps), false, false);
    ps = __uint_as_float(rr[0]) + __uint_as_float(rr[1]); }
  l_reg = l_reg * alpha + ps;
#define PK4(P, B_, OUT) do { unsigned a0 = pk2a(P[B_+0], P[B_+1]), a1 = pk2a(P[B_+2], P[B_+3]);                          \
        unsigned b0 = pk2a(P[B_+4], P[B_+5]), b1 = pk2a(P[B_+6], P[B_+7]);                                             \
        auto r0 = __builtin_amdgcn_permlane32_swap(a0, b0, false, false); auto r1 = __builtin_amdgcn_permlane32_swap(a1, b1, false, false); \
        u32x4 w = {r0[0], r1[0], r0[1], r1[1]}; OUT = *reinterpret_cast<bf16x8*>(&w); } while (0)
  PK4(p0, 0, pa0); PK4(p0, 8, pa1); PK4(p1, 0, pa2); PK4(p1, 8, pa3);
#undef PK4
}
template <int KB>
DI void qkt(f32x16& p0, f32x16& p1, const LAS char* K_lds, const LAS float* tabk, int r32, int hi, const bf16x8* qr) {
#pragma unroll
  for (int g = 0; g < 4; ++g) { const f32x4 t0 = *(const LAS f32x4*)(tabk + 8 * g + 4 * hi), t1 = *(const LAS f32x4*)(tabk + 32 + 8 * g + 4 * hi);
#pragma unroll
    for (int e = 0; e < 4; ++e) { p0[4 * g + e] = t0[e]; p1[4 * g + e] = t1[e]; } }
  const LAS char* kb[4];
#pragma unroll
  for (int dd = 0; dd < 4; ++dd) kb[dd] = K_lds + KB * SHM_K + KSWZ(r32, (dd * 16 + hi * 8) * 2);
#pragma unroll
  for (int d0 = 0; d0 < 8; ++d0) { const LAS char* a = kb[d0 & 3] + (d0 >> 2) * 128;
    bf16x8 b0 = *(const LAS bf16x8*)(a);
    bf16x8 b1 = *(const LAS bf16x8*)(a + 32 * 256);
    p0 = __builtin_amdgcn_mfma_f32_32x32x16_bf16(b0, qr[d0], p0, 0, 0, 0);
    p1 = __builtin_amdgcn_mfma_f32_32x32x16_bf16(b1, qr[d0], p1, 0, 0, 0); }
}
template <int VB>
DI void pv_tile(f32x16* o, int vb0, bf16x8 pa0, bf16x8 pa1, bf16x8 pa2, bf16x8 pa3) {
#define TRRD(dst, off) asm volatile("ds_read_b64_tr_b16 %0, %1 offset:%2" : "=&v"(dst) : "v"(vb0), "i"(off) : "memory")
#define PV_D0(d0) do { s16x4 l0, l1, l2, l3, h0, h1, h2, h3; constexpr int b_ = VB * SHM_V + v_rd_off(d0, 0, 0); \
        TRRD(l0, b_); TRRD(h0, b_ + 2048); TRRD(l1, b_ + 4096); TRRD(h1, b_ + 6144); TRRD(l2, b_ + 8192); TRRD(h2, b_ + 10240); TRRD(l3, b_ + 12288); TRRD(h3, b_ + 14336); \
        asm volatile("s_waitcnt lgkmcnt(0)" ::: "memory"); SBAR();   \
        o[d0] = __builtin_amdgcn_mfma_f32_32x32x16_bf16(pa0, (bf16x8){l0[0], l0[1], l0[2], l0[3], h0[0], h0[1], h0[2], h0[3]}, o[d0], 0, 0, 0);   \
        o[d0] = __builtin_amdgcn_mfma_f32_32x32x16_bf16(pa1, (bf16x8){l1[0], l1[1], l1[2], l1[3], h1[0], h1[1], h1[2], h1[3]}, o[d0], 0, 0, 0);   \
        o[d0] = __builtin_amdgcn_mfma_f32_32x32x16_bf16(pa2, (bf16x8){l2[0], l2[1], l2[2], l2[3], h2[0], h2[1], h2[2], h2[3]}, o[d0], 0, 0, 0);   \
        o[d0] = __builtin_amdgcn_mfma_f32_32x32x16_bf16(pa3, (bf16x8){l3[0], l3[1], l3[2], l3[3], h3[0], h3[1], h3[2], h3[3]}, o[d0], 0, 0, 0); } while (0)
  PV_D0(0); PV_D0(1); PV_D0(2); PV_D0(3);
#undef PV_D0
#undef TRRD
}
struct BlockRef { const bf16_t* Q; const bf16_t* K; const bf16_t* V; bf16_t* O; const bf16_t* G; const float* lf; int P0, skv, nvalid, nkeys; };
struct Seam { bf16x8 qr[8]; bf16x8 st_v0, st_v1, st_k0, st_k1; };
constexpr int NFOX = 2048 + 128;
DI BlockRef fox_decode(const Params& P, int L) {
  unsigned char* ws = P.ws; BlockRef r;
  const bf16_t* FQ = (const bf16_t*)(ws + W_FQ); const bf16_t* FG = (const bf16_t*)(ws + W_FG); bf16_t* Y3 = (bf16_t*)(ws + W_Y3);
  if (L < 2048) { const int bh = L >> 3, qb = 7 - (L & 7), b = bh >> 4, h = bh & 15;
    const size_t row = (size_t)b * 2048 + qb * 256;
    r.lf = (const float*)(ws + W_LFT) + (size_t)bh * 2048; r.nkeys = 2048;
    r.Q = FQ + row * 2048 + h * 128; r.K = (const bf16_t*)(ws + W_FK) + (size_t)b * 2048 * 2048 + h * 128; r.V = (const bf16_t*)(ws + W_FV) + (size_t)b * 2048 * 2048 + h * 128;
    r.O = Y3 + row * 6144 + 2048 + h * 128; r.G = FG + row * 2048 + h * 128; r.P0 = qb * 256; r.skv = 2048; r.nvalid = 256;
  } else { const int j = L - 2048, b = j >> 4, h = j & 15;
    r.lf = (const float*)(ws + W_LFS) + (size_t)j * 1088; r.nkeys = 1088;
    const size_t row = (size_t)MP + b * 64;
    r.Q = FQ + row * 2048 + h * 128; r.K = (const bf16_t*)(ws + W_KS) + (size_t)b * 1088 * 2048 + h * 128; r.V = (const bf16_t*)(ws + W_VS) + (size_t)b * 1088 * 2048 + h * 128;
    r.O = Y3 + row * 6144 + 2048 + h * 128; r.G = FG + row * 2048 + h * 128; r.P0 = 1024; r.skv = 1088; r.nvalid = 64; }
  return r;
}

#define ROW(p, k0, rr) ((p) + (size_t)((k0) + 32 * (rr)) * LD + rowoff0)
#define VMW() asm volatile("s_waitcnt vmcnt(0)" ::: "memory")
#define VMWN(n) asm volatile("s_waitcnt vmcnt(%0)" :: "i"(n) : "memory")
#define SLOAD_H(Kp, Vp, k0) do { S.st_v0 = load8(ROW(Vp, k0, 0)); S.st_v1 = load8(ROW(Vp, k0, 1));              \
                         S.st_k0 = load8(ROW(Kp, k0, 0)); S.st_k1 = load8(ROW(Kp, k0, 1)); } while (0)
#define SWRITE_HK(bf) do { *(LAS bf16x8*)(K_lds + (bf) * SHM_K + kws) = S.st_k0; *(LAS bf16x8*)(K_lds + (bf) * SHM_K + kws + 32 * 256) = S.st_k1; } while (0)
#define SWRITE_HV(bf) do { *(LAS bf16x8*)(V_lds + (bf) * SHM_V + vst0) = S.st_v0; *(LAS bf16x8*)(V_lds + (bf) * SHM_V + vst0 + vst1d) = S.st_v1; } while (0)
#define SWRITE_H(bf) do { SWRITE_HV(bf); SWRITE_HK(bf); } while (0)
DI void fox_prime(const BlockRef& cur, LAS char* lds, Seam& S) {
  int tid = threadIdx.x; asm volatile("" : "+v"(tid));
  const int wid = __builtin_amdgcn_readfirstlane(tid >> 6), lane = tid & 63, r32 = lane & 31, hi = lane >> 5;
  const int sr = tid >> 4, sc = (tid & 15) * 8, kws = KSWZ(sr, sc * 2); LAS char* K_lds = lds + 2 * SHM_V;
  const unsigned rowoff0 = (unsigned)(sr * LD + sc);
  const unsigned qoff = (unsigned)((wid * QBLK + r32) * LD + hi * 8);
#pragma unroll
  for (int d0 = 0; d0 < 8; ++d0) S.qr[d0] = load8(cur.Q + qoff + d0 * 16);
  SLOAD_H(cur.K, cur.V, 0); VMW(); SWRITE_HK(0);
  __syncthreads();
}
DI void fox_block(const BlockRef& cur, int Ln, const Params& P, LAS char* lds, Seam& S) {
  int tid = threadIdx.x; asm volatile("" : "+v"(tid));
  const int wid = __builtin_amdgcn_readfirstlane(tid >> 6), lane = tid & 63, r32 = lane & 31, hi = lane >> 5;
  int j_hi = (cur.P0 + QB - 1) / KVBLK + 1; if (j_hi > cur.skv / KVBLK) j_hi = cur.skv / KVBLK;
  const int NT = j_hi;
  const int qlo = cur.P0 + wid * QBLK, qm = qlo + r32 - 4 * hi;
  LAS char* V_lds = lds; LAS char* K_lds = lds + 2 * SHM_V;
  LAS float* ws = (LAS float*)(lds + 2 * SHM_V + 2 * SHM_K) + wid * 64; LAS float* li_l = ws; LAS float* al_l = ws + 32;
  const LAS float* tab = (const LAS float*)(lds + TAB_OFF);
  float m_reg = -1e30f, l_reg = 0; f32x16 o[4] = {};
  const int sr = tid >> 4, sc = (tid & 15) * 8, vst0 = v_st(sr, sc), kws = KSWZ(sr, sc * 2);
  constexpr int vst1d = 8192;
  const unsigned rowoff0 = (unsigned)(sr * LD + sc);
  const int vb0 = (int)(uintptr_t)V_lds + v_rd_base(lane);
  const bf16_t* Kh = cur.K; const bf16_t* Vh = cur.V;
#define RESC(a) do { if (__any((a) < 1.f)) { if (hi == 0) al_l[r32] = (a); asm volatile("s_waitcnt lgkmcnt(0)" ::: "memory");              \
                     for (int d_ = 0; d_ < 4; ++d_) for (int r = 0; r < 16; ++r) o[d_][r] *= al_l[crow(r, hi)]; } } while (0)
#define KBASE(t) ((t) * KVBLK)
#define MASKT(P0_, P1_, t) do { const int kb_ = KBASE(t); if (kb_ + KVBLK - 1 > qlo) mask_tile(P0_, P1_, qm - kb_, WBIG); } while (0)
#define SEAM_K0() do { VMWN(8); SWRITE_HK(0); SBAR(); } while (0)
  f32x16 pA0, pA1, pB0, pB1; float mnA, mnB, alA, alB; bf16x8 pa0, pa1, pa2, pa3;
  SWRITE_HV(0); SBAR();
  if (NT > 1) { SLOAD_H(Kh, Vh, KBASE(1)); }
  SBAR(); qkt<0>(pA0, pA1, K_lds, tab + KBASE(0), r32, hi, S.qr);
  MASKT(pA0, pA1, 0); partialSM(pA0, pA1, m_reg, mnA, alA);
  if (NT > 1) { VMW(); SWRITE_H(1); }
  __syncthreads();
#define HALF_STEP(PX0, PX1, mnX, alX, PY0, PY1, alY, t, KB, VB, SB) do {                                                      \
        SBAR(); qkt<KB>(PX0, PX1, K_lds, tab + KBASE(t), r32, hi, S.qr);                                             \
        finishSM(PY0, PY1, alY, l_reg, pa0, pa1, pa2, pa3); SBAR();                                                           \
        if ((t) + 1 < NT) { SLOAD_H(Kh, Vh, KBASE((t) + 1)); SBAR(); }                                               \
        pv_tile<VB>(o, vb0, pa0, pa1, pa2, pa3); MASKT(PX0, PX1, (t)); partialSM(PX0, PX1, m_reg, mnX, alX);                                        \
        __syncthreads();                                                                                                      \
        if ((t) + 1 < NT) { VMW(); SWRITE_H(SB); }                                                                          \
        RESC(alX); __syncthreads(); } while (0)
  for (int t = 1; t + 1 < NT; t += 2) {
    HALF_STEP(pB0, pB1, mnB, alB, pA0, pA1, alA, t, 1, 0, 0);
    HALF_STEP(pA0, pA1, mnA, alA, pB0, pB1, alB, t + 1, 0, 1, 1);
  }
  const bool even = (NT & 1) == 0;
  if (even) { SBAR(); qkt<1>(pB0, pB1, K_lds, tab + KBASE(NT - 1), r32, hi, S.qr); SBAR(); }
  const BlockRef nxt = (Ln < NFOX) ? fox_decode(P, Ln) : cur;
  SLOAD_H(nxt.K, nxt.V, 0); SBAR();
  unsigned qoff; { int l2 = lane; asm volatile("" : "+v"(l2)); qoff = (unsigned)((wid * QBLK + (l2 & 31)) * LD + (l2 >> 5) * 8); }
#pragma unroll
  for (int d0 = 0; d0 < 8; ++d0) S.qr[d0] = load8(nxt.Q + qoff + d0 * 16);
  SBAR();
  finishSM(pA0, pA1, alA, l_reg, pa0, pa1, pa2, pa3); SBAR();
  pv_tile<0>(o, vb0, pa0, pa1, pa2, pa3);
  if (even) { MASKT(pB0, pB1, NT - 1); partialSM(pB0, pB1, m_reg, mnB, alB); __syncthreads(); RESC(alB);
    finishSM(pB0, pB1, alB, l_reg, pa0, pa1, pa2, pa3); SBAR(); pv_tile<1>(o, vb0, pa0, pa1, pa2, pa3); }
  SBAR(); SEAM_K0();
  if (hi == 0) li_l[r32] = l_reg; asm volatile("s_waitcnt lgkmcnt(0)" ::: "memory");
  { int lane_o = lane; asm volatile("" : "+v"(lane_o));
    LAS char* stg = lds + OSTG_OFF + wid * 8448;
    const int rw = lane_o >> 4, cw = (lane_o & 15) * 8; const int r32 = lane_o & 31, hi = lane_o >> 5;
#pragma unroll
    for (int half = 0; half < 2; ++half) {
#pragma unroll
      for (int rr = 0; rr < 8; ++rr) { const int r = half * 8 + rr; const int orow = crow(r, hi); const float rl = __builtin_amdgcn_rcpf(li_l[orow]);
#pragma unroll
        for (int d0 = 0; d0 < 4; ++d0) *(LAS float*)(stg + (orow - 16 * half) * 528 + (d0 * 32 + r32) * 4) = o[d0][r] * rl; }
      asm volatile("s_waitcnt lgkmcnt(0)" ::: "memory");
#pragma unroll
      for (int i = 0; i < 4; ++i) { const int lr = i * 4 + rw; const int brow = wid * QBLK + half * 16 + lr;
        const f32x4 v0 = *(const LAS f32x4*)(stg + lr * 528 + cw * 4), v1 = *(const LAS f32x4*)(stg + lr * 528 + cw * 4 + 16);
        const u32x4 gw = *(const u32x4*)(cur.G + (unsigned)(brow * LD + cw));
        u32x4 ow; ow[0] = pk2a(v0[0] * bflo(gw[0]), v0[1] * bfhi(gw[0])); ow[1] = pk2a(v0[2] * bflo(gw[1]), v0[3] * bfhi(gw[1]));
        ow[2] = pk2a(v1[0] * bflo(gw[2]), v1[1] * bfhi(gw[2])); ow[3] = pk2a(v1[2] * bflo(gw[3]), v1[3] * bfhi(gw[3]));
        if (brow < cur.nvalid) *(u32x4*)(cur.O + (unsigned)(brow * LDO + cw)) = ow; }
      asm volatile("s_waitcnt lgkmcnt(0)" ::: "memory");
    } }
  __syncthreads();
#undef RESC
#undef KBASE
#undef MASKT
#undef SEAM_K0
#undef HALF_STEP
}
#undef ROW
#undef VMW
#undef VMWN
#undef SLOAD_H
#undef SWRITE_HK
#undef SWRITE_HV
#undef SWRITE_H
DI void build_bias(const float* src, int nkeys, LAS char* lds) {
  LAS float* tab = (LAS float*)(lds + TAB_OFF); LAS float* wsum = tab + 2048;
  int tid = threadIdx.x; asm volatile("" : "+v"(tid));
  const int lane = tid & 63, wid = tid >> 6;
  f32x4 v = {0.f, 0.f, 0.f, 0.f}; if (tid * 4 < nkeys) v = *(const f32x4*)(src + tid * 4);
  const float s0 = v[0], s1 = s0 + v[1], s2 = s1 + v[2], s3 = s2 + v[3];
  float incl = s3;
#pragma unroll
  for (int o = 1; o < 64; o <<= 1) { const int sl = lane >= o ? lane - o : lane;
    const float t = __int_as_float(__builtin_amdgcn_ds_bpermute(sl * 4, __float_as_int(incl))); if (lane >= o) incl += t; }
  if (lane == 63) wsum[wid] = incl;
  __syncthreads();
  float off = incl - s3;
  for (int w = 0; w < wid; ++w) off += wsum[w];
  const float kk = -11.313708498984761f;
  f32x4 o = {(off + s0) * kk, (off + s1) * kk, (off + s2) * kk, (off + s3) * kk};
  *(LAS f32x4*)(tab + tid * 4) = o;
  __syncthreads();
}
}

DI int fetch_item(unsigned* ctr, LAS char* lds) {
  volatile LAS int* slot = (volatile LAS int*)(lds + LDS_BYTES - 64);
  __syncthreads();
  if (threadIdx.x == 0) *slot = (int)atomicAdd(ctr, 1u);
  __syncthreads();
  return __builtin_amdgcn_readfirstlane(*slot);
}


DI void conv_pass(const Params& P) {
  unsigned char* ws = P.ws;
  int tid = threadIdx.x; asm volatile("" : "+v"(tid));
  const float* wconv = P.in[12]; const float* bconv = P.in[13];
  bf16_t* XCT = (bf16_t*)(ws + W_XCT); bf16_t* BCN = (bf16_t*)(ws + W_BCN); bf16_t* BTT = (bf16_t*)(ws + W_BTT);
  const int lane = tid & 63, wv = blockIdx.x * 8 + (tid >> 6), NWV = gridDim.x * 8;
  const int tg = lane & 7, ccl = lane >> 3;
  u32x4 nraw[11];
#define CONV_SRC(it_, dstv) do { const int cidx_ = (it_) / 48, ccg_ = (it_) - cidx_ * 48; const int ch_ = (ccg_ * 8 + ccl) * 8;                    \
    const bool smp_ = cidx_ >= 512; const int b_ = smp_ ? cidx_ - 512 : cidx_ >> 5, c_ = smp_ ? 0 : cidx_ & 31;                               \
    const bf16_t* xbc_ = smp_ ? (const bf16_t*)(ws + W_XBCS) + (size_t)b_ * 67 * 3072 : (const bf16_t*)(ws + W_XBCP) + (size_t)b_ * 2051 * 3072; \
    const int t0_ = c_ * 64 + tg * 8;                                                                                                           \
    _Pragma("unroll") for (int j = 0; j < 11; ++j) dstv[j] = *(const u32x4*)(xbc_ + (size_t)(t0_ + j) * 3072 + ch_); } while (0)
  if (wv < 520 * 48) CONV_SRC(wv, nraw);
  for (int it = wv; it < 520 * 48; it += NWV) {
    const int cidx = it / 48, ccg = it - cidx * 48; const int cc = ccg * 8 + ccl; const int ch = cc * 8;
    const bool sample = cidx >= 512; const int b = sample ? cidx - 512 : cidx >> 5, c = sample ? 0 : cidx & 31;
    const size_t rowbase = sample ? (size_t)MP + b * 64 : (size_t)b * 2048;
    const int t0 = c * 64 + tg * 8;
    u32x4 raw[11];
#pragma unroll
    for (int j = 0; j < 11; ++j) raw[j] = nraw[j];
    if (it + NWV < 520 * 48) CONV_SRC(it + NWV, nraw);
    f32x4 wv4[4][2], bv[2];
#pragma unroll
    for (int i = 0; i < 4; ++i) { wv4[i][0] = *(const f32x4*)(wconv + i * 3072 + ch); wv4[i][1] = *(const f32x4*)(wconv + i * 3072 + ch + 4); }
    bv[0] = *(const f32x4*)(bconv + ch); bv[1] = *(const f32x4*)(bconv + ch + 4);
    unsigned op[8][4];
    u32x4 on[8];
    float prev[8];
#pragma unroll
    for (int j = 0; j < 8; ++j) {
      float o[8];
#pragma unroll
      for (int e = 0; e < 8; ++e) { float a = bv[e >> 2][e & 3];
#pragma unroll
        for (int i = 0; i < 4; ++i) { const unsigned w = raw[j + i][e >> 1]; const float xv = (e & 1) ? bfhi(w) : bflo(w); a += wv4[i][e >> 2][e & 3] * xv; }
        o[e] = siluf_(a); }
      on[j][0] = pk2(o[0], o[1]); on[j][1] = pk2(o[2], o[3]); on[j][2] = pk2(o[4], o[5]); on[j][3] = pk2(o[6], o[7]);
      if (j & 1) {
#pragma unroll
        for (int e = 0; e < 8; ++e) op[e][j >> 1] = pk2(prev[e], o[e]);
      } else {
#pragma unroll
        for (int e = 0; e < 8; ++e) prev[e] = o[e];
      }
    }
    if (ch < 2048) { const int h = ch >> 6, p0 = ch & 63;
      bf16_t* dst = XCT + ((size_t)(cidx * 32 + h) * 64 + p0) * 64 + tg * 8;
#pragma unroll
      for (int e = 0; e < 8; ++e) { u32x4 w = {op[e][0], op[e][1], op[e][2], op[e][3]}; *(u32x4*)(dst + e * 64) = w; }
    } else {
      const int cb = ch - 2048;
      bf16_t* dn = BCN + (rowbase + t0) * 1024 + cb;
#pragma unroll
      for (int j = 0; j < 8; ++j) *(u32x4*)(dn + (size_t)j * 1024) = on[j];
      if (cb < 512) { const int g = cb >> 7, n0 = cb & 127;
        bf16_t* dt_ = BTT + ((size_t)(cidx * 4 + g) * 128 + n0) * 64 + tg * 8;
#pragma unroll
        for (int e = 0; e < 8; ++e) { u32x4 w = {op[e][0], op[e][1], op[e][2], op[e][3]}; *(u32x4*)(dt_ + e * 64) = w; }
      }
    }
  }
}

DI void ssd_item(const Params& P, LAS unsigned char* lds, int item) {
  unsigned char* ws = P.ws;
  int tid = threadIdx.x; asm volatile("" : "+v"(tid));
  const int wid = __builtin_amdgcn_readfirstlane(tid >> 6), lane = tid & 63, r16 = lane & 15, q = lane >> 4;
  const bool sample = item >= 128; const int i2 = sample ? item - 128 : item; const int b = i2 >> 3, g = (i2 >> 1) & 3, hh = i2 & 1;
  const int nch = sample ? 1 : 32;
  const size_t rowbase = sample ? (size_t)MP + b * 64 : (size_t)b * 2048;
  const int h = g * 8 + hh * 4 + (wid >> 1), ph = wid & 1, pb = ph * 32;
  const float A_h = -__expf(P.in[15][h]), dsk = P.in[16][h];
  const float* DT = (const float*)(ws + W_DT); const bf16_t* ZB = (const bf16_t*)(ws + W_ZB); bf16_t* Y3 = (bf16_t*)(ws + W_Y3); float* SSQP = (float*)(ws + W_SSQP);
  LAS unsigned char* Bs = lds; LAS unsigned char* Cs = lds + 17408; LAS unsigned char* BT = lds + 34816;
  LAS unsigned char* XT = lds + 53248 + wid * 4608;
  LAS float* acum_l = (LAS float*)(lds + 90112 + wid * 768); LAS float* dtv_l = acum_l + 64; LAS float* wend_l = acum_l + 128;
  f32x4 hT[8][2];
#pragma unroll
  for (int nt = 0; nt < 8; ++nt)
#pragma unroll
    for (int pt = 0; pt < 2; ++pt) {
      if (sample) hT[nt][pt] = *(const f32x4*)(P.in[6] + ((size_t)(b * 32 + h) * 64 + pb + pt * 16 + r16) * 128 + nt * 16 + 4 * q);
      else hT[nt][pt] = (f32x4){0.f, 0.f, 0.f, 0.f};
    }
  const bf16_t* XCT = (const bf16_t*)(ws + W_XCT); const bf16_t* BCN = (const bf16_t*)(ws + W_BCN); const bf16_t* BTT = (const bf16_t*)(ws + W_BTT);
  float dtl; u32x4 rx[4], rb[2], rc[2], rt[2];
#define SSD_LOAD(c_) do { const int t0_ = (c_) * 64; const int cidx_ = sample ? 512 + b : b * 32 + (c_);                         \
    dtl = DT[(rowbase + t0_ + lane) * 32 + h];                                                                                  \
    const bf16_t* xs_ = XCT + ((size_t)(cidx_ * 32 + h) * 64 + pb) * 64;                                                        \
    _Pragma("unroll") for (int j = 0; j < 4; ++j) rx[j] = *(const u32x4*)(xs_ + (j * 64 + lane) * 8);                           \
    const bf16_t* bts_ = BTT + (size_t)(cidx_ * 4 + g) * 8192;                                                                  \
    _Pragma("unroll") for (int j = 0; j < 2; ++j) { const int id = tid + 512 * j; const int s = id >> 4, k = id & 15;           \
      rb[j] = *(const u32x4*)(BCN + (rowbase + t0_ + s) * 1024 + g * 128 + k * 8);                                              \
      rc[j] = *(const u32x4*)(BCN + (rowbase + t0_ + s) * 1024 + 512 + g * 128 + k * 8);                                        \
      rt[j] = *(const u32x4*)(bts_ + id * 8); } } while (0)
  SSD_LOAD(0);
  for (int c = 0; c < nch; ++c) {
    const int t0 = c * 64;
    float cdec;
    { float ac = dtl * A_h;
#pragma unroll
      for (int o = 1; o < 64; o <<= 1) { const float t = __shfl_up(ac, o); if (lane >= o) ac += t; }
      const float tot = __shfl(ac, 63);
      acum_l[lane] = ac; dtv_l[lane] = dtl; wend_l[lane] = __expf(tot - ac) * dtl; cdec = __expf(tot); }
#pragma unroll
    for (int j = 0; j < 4; ++j) { const int e8 = j * 64 + lane; *(LAS u32x4*)(XT + (e8 >> 3) * 144 + (e8 & 7) * 16) = rx[j]; }
    __syncthreads();
#pragma unroll
    for (int j = 0; j < 2; ++j) { const int id = tid + 512 * j;
      *(LAS u32x4*)(Bs + (id >> 4) * 272 + (id & 15) * 16) = rb[j];
      *(LAS u32x4*)(Cs + (id >> 4) * 272 + (id & 15) * 16) = rc[j];
      *(LAS u32x4*)(BT + (id >> 3) * 144 + (id & 7) * 16) = rt[j]; }
    __syncthreads();
    if (c + 1 < nch) SSD_LOAD(c + 1);
    u32x2 znext[2];
#pragma unroll
    for (int pt = 0; pt < 2; ++pt) znext[pt] = *(const u32x2*)(ZB + (rowbase + t0 + r16) * 2048 + h * 64 + pb + pt * 16 + 4 * q);
#pragma unroll
    for (int lt = 0; lt < 4; ++lt) {
      const int l = lt * 16 + r16;
      const size_t row = rowbase + t0 + l;
      u32x2 zraw[2];
#pragma unroll
      for (int pt = 0; pt < 2; ++pt) zraw[pt] = znext[pt];
      { const int ln = (lt < 3 ? lt + 1 : 3) * 16 + r16;
#pragma unroll
        for (int pt = 0; pt < 2; ++pt) znext[pt] = *(const u32x2*)(ZB + (rowbase + t0 + ln) * 2048 + h * 64 + pb + pt * 16 + 4 * q); }
      f32x4 y[2];
#pragma unroll
      for (int pt = 0; pt < 2; ++pt) y[pt] = (f32x4){0.f, 0.f, 0.f, 0.f};
#pragma unroll
      for (int np = 0; np < 4; ++np) {
        const u32x2 clo = *(const LAS u32x2*)(Cs + l * 272 + (32 * np + 4 * q) * 2), chi = *(const LAS u32x2*)(Cs + l * 272 + (32 * np + 16 + 4 * q) * 2);
        const bf16x8 bfrag = cat8(clo, chi);
#pragma unroll
        for (int pt = 0; pt < 2; ++pt) y[pt] = MFMA16(pack8a(hT[2 * np][pt], hT[2 * np + 1][pt]), bfrag, y[pt]);
      }
      const float al = acum_l[l]; const float el = __expf(al);
#pragma unroll
      for (int pt = 0; pt < 2; ++pt) y[pt] *= el;
      const int nsp = (lt >> 1) + 1;
#pragma unroll
      for (int sp = 0; sp < nsp; ++sp) {
        f32x4 cb0 = {0.f, 0.f, 0.f, 0.f}, cb1 = {0.f, 0.f, 0.f, 0.f};
#pragma unroll
        for (int ks = 0; ks < 4; ++ks) {
          const bf16x8 cf = *(const LAS bf16x8*)(Cs + l * 272 + (32 * ks + 8 * q) * 2);
          const bf16x8 b0 = *(const LAS bf16x8*)(Bs + (32 * sp + r16) * 272 + (32 * ks + 8 * q) * 2);
          const bf16x8 b1 = *(const LAS bf16x8*)(Bs + (32 * sp + 16 + r16) * 272 + (32 * ks + 8 * q) * 2);
          cb0 = MFMA16(b0, cf, cb0); cb1 = MFMA16(b1, cf, cb1);
        }
        const int s0 = 32 * sp + 4 * q, s1 = s0 + 16;
        const f32x4 as0 = *(const LAS f32x4*)(acum_l + s0), as1 = *(const LAS f32x4*)(acum_l + s1);
        const f32x4 d0 = *(const LAS f32x4*)(dtv_l + s0), d1 = *(const LAS f32x4*)(dtv_l + s1);
        f32x4 m0, m1;
#pragma unroll
        for (int e = 0; e < 4; ++e) {
          m0[e] = (s0 + e <= l) ? cb0[e] * __expf(al - as0[e]) * d0[e] : 0.f;
          m1[e] = (s1 + e <= l) ? cb1[e] * __expf(al - as1[e]) * d1[e] : 0.f;
        }
        const bf16x8 mfrag = pack8a(m0, m1);
#pragma unroll
        for (int pt = 0; pt < 2; ++pt) { const int p = pt * 16 + r16;
          const u32x2 xlo = *(const LAS u32x2*)(XT + p * 144 + s0 * 2), xhi = *(const LAS u32x2*)(XT + p * 144 + s1 * 2);
          y[pt] = MFMA16(cat8(xlo, xhi), mfrag, y[pt]); }
      }
      float ssq = 0.f;
#pragma unroll
      for (int pt = 0; pt < 2; ++pt) { const int p0 = pt * 16 + 4 * q;
        const f32x4 zz = {bflo(zraw[pt][0]), bfhi(zraw[pt][0]), bflo(zraw[pt][1]), bfhi(zraw[pt][1])};
        f32x4 v;
#pragma unroll
        for (int e = 0; e < 4; ++e) { const float xv = bf2f(*(const LAS bf16_t*)(XT + (p0 + e) * 144 + l * 2));
          v[e] = (y[pt][e] + dsk * xv) * zz[e]; ssq += v[e] * v[e]; }
        st_bf4a(Y3 + row * 6144 + h * 64 + pb + p0, v); }
      ssq += __shfl_xor(ssq, 16); ssq += __shfl_xor(ssq, 32);
      if (q == 0) SSQP[row * 64 + h * 2 + ph] = ssq;
    }
#pragma unroll
    for (int nt = 0; nt < 8; ++nt)
#pragma unroll
      for (int pt = 0; pt < 2; ++pt) hT[nt][pt] *= cdec;
#pragma unroll
    for (int ks = 0; ks < 2; ++ks) {
      bf16x8 bfr[2];
      const f32x4 w0 = *(const LAS f32x4*)(wend_l + 32 * ks + 8 * q), w1 = *(const LAS f32x4*)(wend_l + 32 * ks + 8 * q + 4);
#pragma unroll
      for (int pt = 0; pt < 2; ++pt) { const int p = pt * 16 + r16;
        const u32x4 xr = *(const LAS u32x4*)(XT + p * 144 + (32 * ks + 8 * q) * 2);
        const f32x4 a = {bflo(xr[0]) * w0[0], bfhi(xr[0]) * w0[1], bflo(xr[1]) * w0[2], bfhi(xr[1]) * w0[3]};
        const f32x4 bq = {bflo(xr[2]) * w1[0], bfhi(xr[2]) * w1[1], bflo(xr[3]) * w1[2], bfhi(xr[3]) * w1[3]};
        bfr[pt] = pack8a(a, bq); }
#pragma unroll
      for (int nt = 0; nt < 8; ++nt) { const bf16x8 af = *(const LAS bf16x8*)(BT + (nt * 16 + r16) * 144 + (32 * ks + 8 * q) * 2);
#pragma unroll
        for (int pt = 0; pt < 2; ++pt) hT[nt][pt] = MFMA16(af, bfr[pt], hT[nt][pt]); }
    }
  }
#undef SSD_LOAD
  float* so = P.out + (sample ? O_SSDS : O_SSDP) + (size_t)(b * 32 + h) * 8192;
#pragma unroll
  for (int nt = 0; nt < 8; ++nt)
#pragma unroll
    for (int pt = 0; pt < 2; ++pt) *(f32x4*)(so + (size_t)(pb + pt * 16 + r16) * 128 + nt * 16 + 4 * q) = hT[nt][pt];
  __syncthreads();
}

__global__ __launch_bounds__(512) void mk_forward(Params Parg) {
#if defined(__HIP_DEVICE_COMPILE__)
  extern __shared__ __attribute__((aligned(16))) unsigned char lds_raw[];
  LAS unsigned char* lds = (LAS unsigned char*)lds_raw;
  cg::grid_group grid = cg::this_grid();
  const int G = gridDim.x, cblk = blockIdx.x;
  typedef __attribute__((address_space(4))) const Params* KP;
  const KP kp = (KP)__builtin_amdgcn_kernarg_segment_ptr();
#define PHASE_PARAMS() KP kq_ = kp; asm volatile("" : "+s"(kq_)); const Params P = *kq_; unsigned char* ws = P.ws; (void)ws
#ifndef PH
#define PH 255
#endif
#ifndef DUPMASK
#define DUPMASK 0
#endif
  for (int rep0_ = 0; rep0_ < ((DUPMASK & 1) ? 2 : 1); ++rep0_)
  if (PH & 1) { PHASE_PARAMS(); phase0(P, lds); }
  grid.sync();
  for (int rep_ = 0; rep_ < ((DUPMASK & 2) ? 2 : 1); ++rep_)
  if (PH & 2) { PHASE_PARAMS();
    SchedP1 S; S.c = cblk; S.G = G; S.XB = (const char*)(ws + W_XB); S.WIN = (const char*)(ws + W_WIN); S.MB = (const char*)(ws + W_MB); S.WMEM = (const char*)(ws + W_WMEM);
    EpiIn E; E.P = P; E.ldsb = lds; pg8::Gemm g; g.lda = 2048; g.ldb = 2048; g.K = 2048; g.delay = 0;
    pg8::gemm_phase(lds, g, S, E);
    if (cblk >= 58) p1_tail_convert(P, cblk - 58, 198); }
  grid.sync();
  { PHASE_PARAMS(); conv_pass(P); }
  grid.sync();
  for (int rep_ = 0; rep_ < 1; ++rep_) {
  if (cblk < 128) { PHASE_PARAMS(); ssd_item(P, lds, cblk); }
  else { PHASE_PARAMS();
    if (cblk < 192) ssd_item(P, lds, cblk);
    SchedS S; S.c = cblk - 128; S.G = 128; S.MQ = (const char*)(ws + W_MQ); S.MKP = (const char*)(ws + W_MKP); S.MKS = (const char*)(ws + W_MKS);
    EpiS E; E.P = P; pg8::Gemm g; g.lda = 2048; g.ldb = 2048; g.K = 512; g.delay = 0;
    pg8::gemm_phase(lds, g, S, E); }
  if (PH & 16) { PHASE_PARAMS(); unsigned* ctl = (unsigned*)(ws + W_CTL) + rep_ * 32;
    LAS char* l8 = (LAS char*)lds_raw;
    int L = fetch_item(ctl + 16, l8);
    if (L < fa::NFOX) {
      fa::BlockRef cur = fa::fox_decode(P, L);
      fa::Seam S;
      fa::build_bias(cur.lf, cur.nkeys, l8);
      fa::fox_prime(cur, l8, S);
      for (;;) {
        const int Ln = fetch_item(ctl + 16, l8);
        fa::fox_block(cur, Ln, P, l8, S);
        if (Ln >= fa::NFOX) break;
        cur = fa::fox_decode(P, Ln);
        fa::build_bias(cur.lf, cur.nkeys, l8);
      }
    }
  }
  }
  grid.sync();
  for (int rep3_ = 0; rep3_ < ((DUPMASK & 32) ? 2 : 1); ++rep3_)
  if (PH & 32) { PHASE_PARAMS();
    { const float* SSQP = (const float*)(ws + W_SSQP); float* RS = (float*)(ws + W_RS);
      int tid = threadIdx.x; asm volatile("" : "+v"(tid));
      for (int r = cblk * 512 + tid; r < MT; r += G * 512) { float s = 0.f;
#pragma unroll
        for (int j = 0; j < 16; ++j) { const f32x4 v = *(const f32x4*)(SSQP + (size_t)r * 64 + 4 * j); s += (v[0] + v[1]) + (v[2] + v[3]); }
        RS[r] = rsqrtf(s * (1.f / 2048.f) + EPS); } }
    SchedPV S; S.c = cblk; S.G = G; S.PM = (const char*)(ws + W_PM); S.VTP = (const char*)(ws + W_VTP); S.VTS = (const char*)(ws + W_VTS);
    EpiPV E; E.P = P; pg8::Gemm g; g.lda = 1024; g.ldb = 256; g.K = 256; g.delay = 0;
    pg8::gemm_phase(lds, g, S, E); }
  grid.sync();
  for (int rep4_ = 0; rep4_ < ((DUPMASK & 64) ? 2 : 1); ++rep4_)
  if (PH & 64) { PHASE_PARAMS();
    SchedMerge S; S.c = cblk; S.G = G; S.A = (const char*)(ws + W_Y3); S.B = (const char*)(ws + W_WO);
    EpiMerge E; E.P = P; pg8::Gemm g; g.lda = 6144; g.ldb = 6144; g.K = 2048; g.delay = 0;
    pg8::gemm_phase(lds, g, S, E); }
  grid.sync();
  { PHASE_PARAMS(); const float* PARTM = (const float*)(ws + W_PARTM); bf16_t* MRG = (bf16_t*)(ws + W_MRG);
    int tid = threadIdx.x; asm volatile("" : "+v"(tid));
    for (int i = cblk * 512 + tid; i < MS * 2048 / 4; i += G * 512) {
      const f32x4 a = *(const f32x4*)(PARTM + (size_t)i * 4), b2 = *(const f32x4*)(PARTM + (size_t)MS * 2048 + (size_t)i * 4), c2 = *(const f32x4*)(PARTM + (size_t)2 * MS * 2048 + (size_t)i * 4);
      st_bf4(MRG + (size_t)MP * 2048 + (size_t)i * 4, a + b2 + c2); } }
  grid.sync();
  if (PH & 128) { PHASE_PARAMS();
    { SchedOutS S; S.c = cblk; S.A = (const char*)(ws + W_MRG); S.B = (const char*)(ws + W_WOUT);
      EpiOut E; E.P = P; pg8::Gemm g; g.lda = 2048; g.ldb = 2048; g.K = 512; g.delay = 0;
      pg8::gemm_phase(lds, g, S, E); }
    { SchedOutP S; S.c = cblk; S.A = (const char*)(ws + W_MRG); S.B = (const char*)(ws + W_WOUT);
      EpiOut E; E.P = P; pg8::Gemm g; g.lda = 2048; g.ldb = 2048; g.K = 2048; g.delay = 0;
      pg8::gemm_phase(lds, g, S, E); } }
  grid.sync();
  { PHASE_PARAMS();
    const float* PARTO = (const float*)(ws + W_PARTO); const float* gf = P.in[25];
    int tid = threadIdx.x; asm volatile("" : "+v"(tid)); const int wid = tid >> 6, lane = tid & 63;
    for (int r = cblk * 8 + wid; r < MT; r += G * 8) {
      f32x4* y = (f32x4*)(P.out + (size_t)r * 2048) + lane; const f32x4* gv = (const f32x4*)gf + lane;
      if (r < MP) {
        const float pv = lane < 32 ? PARTO[(size_t)r * 32 + lane] : 0.f;
        const float sc = rsqrtf(wave_sum(pv) * (1.f / 2048.f) + EPS);
#pragma unroll
        for (int j = 0; j < 8; ++j) { f32x4 v = y[64 * j]; const f32x4 gg = gv[64 * j]; y[64 * j] = v * sc * gg; }
      } else {
        const int rs = r - MP; const f32x4* xr = (const f32x4*)(P.in[1] + (size_t)rs * 2048) + lane;
        const f32x4* p5 = (const f32x4*)((const float*)(ws + W_PART5) + (size_t)rs * 2048) + lane;
        f32x4 v[8]; float ss = 0.f;
#pragma unroll
        for (int j = 0; j < 8; ++j) { v[j] = xr[64 * j];
#pragma unroll
          for (int kq = 0; kq < 4; ++kq) v[j] += p5[(size_t)kq * MS * 512 + 64 * j];
          ss += (v[j][0] * v[j][0] + v[j][1] * v[j][1]) + (v[j][2] * v[j][2] + v[j][3] * v[j][3]); }
        const float sc = rsqrtf(wave_sum(ss) * (1.f / 2048.f) + EPS);
#pragma unroll
        for (int j = 0; j < 8; ++j) y[64 * j] = v[j] * sc * gv[64 * j];
      }
    } }
#endif
}

extern "C" void kernel_launch(void* const* d_in, const int* in_sizes, int n_in,
                              void* d_out, int out_size, void* d_ws, size_t ws_size,
                              hipStream_t stream) {
  static int grid = 0;
  if (grid == 0) {
    int dev = 0, cus = 0, per_cu = 0;
    (void)hipGetDevice(&dev);
    (void)hipDeviceGetAttribute(&cus, hipDeviceAttributeMultiprocessorCount, dev);
    (void)hipFuncSetAttribute((const void*)mk_forward, hipFuncAttributeMaxDynamicSharedMemorySize, LDS_BYTES);
    (void)hipOccupancyMaxActiveBlocksPerMultiprocessor(&per_cu, (const void*)mk_forward, 512, LDS_BYTES);
    if (per_cu < 1) per_cu = 1;
    grid = cus * per_cu;
    if (ws_size < W_END) { fprintf(stderr, "workspace too small: %zu < %zu\n", ws_size, (size_t)W_END); grid = -1; }
  }
  if (grid < 0) return;
  Params p{};
  for (int i = 0; i < 26; ++i) p.in[i] = (const float*)d_in[i];
  p.out = (float*)d_out; p.ws = (unsigned char*)d_ws;
  void* args[] = {&p};
  hipError_t e = hipLaunchCooperativeKernel((const void*)mk_forward, dim3(grid), dim3(512), args, LDS_BYTES, stream);
  if (e != hipSuccess) fprintf(stderr, "cooperative launch failed: %s (grid %d)\n", hipGetErrorString(e), grid);
}
```

```cpp
#include <hip/hip_runtime.h>
#include <hip/hip_cooperative_groups.h>
#include <cstdio>
#include <cstdint>
namespace cg = cooperative_groups;

#define LAS __attribute__((address_space(3)))
#define DI __device__ __forceinline__
typedef unsigned short bf16_t;
typedef short bf16x8 __attribute__((ext_vector_type(8)));
typedef short s16x4 __attribute__((ext_vector_type(4)));
typedef float f32x4 __attribute__((ext_vector_type(4)));
typedef float f32x16 __attribute__((ext_vector_type(16)));
typedef unsigned u32x4 __attribute__((ext_vector_type(4)));
typedef unsigned u32x2 __attribute__((ext_vector_type(2)));

constexpr int DM = 2048;
constexpr int MP = 32768, MS = 512, MT = MP + MS, MPADR = MT + 256;
constexpr int NIN = 23808;
constexpr int LDS_BYTES = 147456;
constexpr float EPS = 1e-6f;

constexpr long O_YP = 0;
constexpr long O_YS = 67108864L;
constexpr long O_FKP = O_YS + 1048576L;
constexpr long O_FVP = O_FKP + 67108864L;
constexpr long O_FLP = O_FVP + 67108864L;
constexpr long O_SSDP = O_FLP + 524288L;
constexpr long O_CONVP = O_SSDP + 4194304L;
constexpr long O_MKP = O_CONVP + 147456L;
constexpr long O_MVP = O_MKP + 8388608L;
constexpr long O_FKS = O_MVP + 8388608L;
constexpr long O_FVS = O_FKS + 1048576L;
constexpr long O_FLS = O_FVS + 1048576L;
constexpr long O_SSDS = O_FLS + 8192L;
constexpr long O_CONVS = O_SSDS + 2097152L;

constexpr size_t al256(size_t x) { return (x + 255) & ~(size_t)255; }
constexpr size_t W_CTL = 0;
constexpr size_t W_R1 = 4096;
constexpr size_t W_RM = al256(W_R1 + (size_t)MT * 4);
constexpr size_t W_RS = al256(W_RM + 4096 * 4);
constexpr size_t W_XB = al256(W_RS + (size_t)MT * 4);
constexpr size_t W_MB = al256(W_XB + (size_t)MT * DM * 2);
constexpr size_t W_WIN = al256(W_MB + (size_t)4096 * DM * 2);
constexpr size_t W_WMEM = al256(W_WIN + (size_t)NIN * DM * 2);
constexpr size_t W_WO = al256(W_WMEM + (size_t)4096 * DM * 2);
constexpr size_t W_WOUT = al256(W_WO + (size_t)2048 * 6144 * 2);
constexpr size_t W_ZB = al256(W_WOUT + (size_t)2048 * 2048 * 2);
constexpr size_t W_XBCP = al256(W_ZB + (size_t)MT * DM * 2);
constexpr size_t W_XBCS = al256(W_XBCP + (size_t)16 * 2051 * 3072 * 2);
constexpr size_t W_DT = al256(W_XBCS + (size_t)8 * 67 * 3072 * 2);
constexpr size_t W_FQ = al256(W_DT + (size_t)MT * 32 * 4);
constexpr size_t W_FK = al256(W_FQ + (size_t)MPADR * DM * 2);
constexpr size_t W_FV = al256(W_FK + (size_t)MP * DM * 2);
constexpr size_t W_KS = al256(W_FV + (size_t)MP * DM * 2);
constexpr size_t W_VS = al256(W_KS + (size_t)8 * 1088 * DM * 2);
constexpr size_t W_FG = al256(W_VS + (size_t)8 * 1088 * DM * 2);
constexpr size_t W_MQ = al256(W_FG + (size_t)MPADR * DM * 2);
constexpr size_t W_MG = al256(W_MQ + (size_t)MPADR * DM * 2);
constexpr size_t W_G3 = al256(W_MG + (size_t)MT * DM * 2);
constexpr size_t W_LFT = al256(W_G3 + (size_t)MT * 6144 * 2);
constexpr size_t W_LFS = al256(W_LFT + (size_t)256 * 2048 * 4);
constexpr size_t W_MKP = al256(W_LFS + (size_t)128 * 1088 * 4);
constexpr size_t W_VTP = al256(W_MKP + (size_t)4096 * DM * 2);
constexpr size_t W_MKS = al256(W_VTP + (size_t)4096 * DM * 2);
constexpr size_t W_VTS = al256(W_MKS + (size_t)2048 * DM * 2);
constexpr size_t W_PM = al256(W_VTS + (size_t)2048 * DM * 2);
constexpr size_t W_PSUM = al256(W_PM + (size_t)MPADR * 1024 * 2);
constexpr size_t W_Y3 = al256(W_PSUM + (size_t)MT * 16 * 4);
constexpr size_t W_SSQP = al256(W_Y3 + (size_t)MT * 6144 * 2);
constexpr size_t W_MRG = al256(W_SSQP + (size_t)MT * 64 * 4);
constexpr size_t W_PARTO = al256(W_MRG + (size_t)MT * DM * 2);
constexpr size_t W_TMP = al256(W_PARTO + (size_t)MT * 32 * 4);
constexpr size_t W_PARTM = al256(W_TMP + (size_t)MT * DM * 4);
constexpr size_t W_PART5 = al256(W_PARTM + (size_t)3 * MS * DM * 4);
constexpr size_t W_XCT = al256(W_PART5 + (size_t)4 * MS * DM * 4);
constexpr size_t W_BCN = al256(W_XCT + (size_t)520 * 32 * 4096 * 2);
constexpr size_t W_BTT = al256(W_BCN + (size_t)MT * 1024 * 2);
constexpr size_t W_END = al256(W_BTT + (size_t)520 * 4 * 8192 * 2);

struct Params { const float* in[26]; float* out; unsigned char* ws; };

typedef __bf16 bf16x2_t __attribute__((ext_vector_type(2)));
typedef float f32x2_t __attribute__((ext_vector_type(2)));
DI unsigned pk2a(float lo, float hi) { unsigned r; asm volatile("v_cvt_pk_bf16_f32 %0, %1, %2" : "=v"(r) : "v"(lo), "v"(hi)); return r; }
DI unsigned pk2(float lo, float hi) { f32x2_t f = {lo, hi}; bf16x2_t v = __builtin_convertvector(f, bf16x2_t); return __builtin_bit_cast(unsigned, v); }
DI float bf2f(unsigned short b) { return __uint_as_float(((unsigned)b) << 16); }
DI float bflo(unsigned w) { return __uint_as_float(w << 16); }
DI float bfhi(unsigned w) { return __uint_as_float(w & 0xffff0000u); }
DI float sigmoidf_(float x) { return __builtin_amdgcn_rcpf(1.f + __builtin_amdgcn_exp2f(-1.4426950408889634f * x)); }
DI float siluf_(float x) { return x * __builtin_amdgcn_rcpf(1.f + __builtin_amdgcn_exp2f(-1.4426950408889634f * x)); }
DI float softplusf_(float x) { return x > 20.f ? x : log1pf(__expf(x)); }
DI float wave_sum(float v) {
#pragma unroll
  for (int o = 1; o < 64; o <<= 1) v += __shfl_xor(v, o);
  return v;
}
DI bf16x8 pack8(f32x4 a, f32x4 b) {
  u32x4 w = {pk2(a[0], a[1]), pk2(a[2], a[3]), pk2(b[0], b[1]), pk2(b[2], b[3])};
  return __builtin_bit_cast(bf16x8, w);
}
DI bf16x8 pack8a(f32x4 a, f32x4 b) {
  u32x4 w = {pk2a(a[0], a[1]), pk2a(a[2], a[3]), pk2a(b[0], b[1]), pk2a(b[2], b[3])};
  return __builtin_bit_cast(bf16x8, w);
}
DI bf16x8 cat8(u32x2 lo, u32x2 hi) { u32x4 w = {lo[0], lo[1], hi[0], hi[1]}; return __builtin_bit_cast(bf16x8, w); }
#define MFMA16(a, b, c) __builtin_amdgcn_mfma_f32_16x16x32_bf16((a), (b), (c), 0, 0, 0)

namespace pg8 {
constexpr int BM = 256, BK = 64, HALF = 128, HTB = HALF * BK * 2, STAGE_BYTES = 8 * HTB, NXCD = 8, WGM = 8;
DI int lds_byte(int r, int c) { const int st = (r >> 4) * 2 + (c >> 5), rr = r & 15, cc = c & 31, ob = rr * 64 + cc * 2; return st * 1024 + (ob ^ (((ob >> 9) & 1) << 5)); }
DI void stage_rc(int b, int& R, int& C) { const int st = b / 1024, sb = b % 1024, swz = sb ^ (((sb >> 9) & 1) << 5); R = (st >> 1) * 16 + swz / 64; C = (st & 1) * 32 + (swz % 64) / 2; }

struct Unit { const char* A; const char* B; int row0, col0, kind, nvalid, aux; };
struct Gemm { int lda, ldb, K; int delay; };

DI void tile_order(int L, int nM, int nN, int& pm, int& pn) {
  const int nwg = nM * nN; int wgid = L;
  { const int q = nwg / NXCD, r = nwg % NXCD, xcd = wgid % NXCD, off = wgid / NXCD; wgid = (xcd < r ? xcd * (q + 1) : r * (q + 1) + (xcd - r) * q) + off; }
  const int nig = WGM * nN, gid = wgid / nig, fm = gid * WGM, gsz = (nM - fm) < WGM ? (nM - fm) : WGM;
  pm = fm + ((wgid % nig) % gsz); pn = (wgid % nig) / gsz;
}

template <class Epi, class Sched>
DI void gemm_phase(LAS unsigned char* lds, const Gemm g, const Sched& S, const Epi& E) {
  int tid = threadIdx.x; asm volatile("" : "+v"(tid));
  const int wid = __builtin_amdgcn_readfirstlane(tid >> 6), lane = tid & 63, wr = wid >> 2, wc = wid & 3, fr = lane & 15, fq = lane >> 4;
  int K = g.K; asm volatile("" : "+s"(K));
  const int nt = K / BK;
  unsigned voffA[2], voffB[2];
#pragma unroll
  for (int i = 0; i < 2; ++i) { int R, C; stage_rc(tid * 16 + i * 8192, R, C);
    voffA[i] = (unsigned)(R * g.lda + C) * 2u; voffB[i] = (unsigned)(R * g.ldb + C) * 2u; }
  const size_t kstep = (size_t)(BK * 2);
  const size_t hstepA = (size_t)HALF * g.lda * 2, hstepB = (size_t)HALF * g.ldb * 2;
  const unsigned ldsw = (unsigned)wid * 1024u;
  const int aoff = lds_byte(wr * 64 + fr, fq * 8), boff = lds_byte(wc * 32 + fr, fq * 8);
#define PG8_SA(b, h) (((b) * 2 + (h)) * HTB)
#define PG8_SB(b, h) ((4 + (b) * 2 + (h)) * HTB)
#define PG8_STAGE(bufoff, gbase, voff) do { _Pragma("unroll") for (int _i = 0; _i < 2; ++_i) \
        __builtin_amdgcn_global_load_lds((const unsigned*)((const char*)(gbase) + (voff)[_i]), (LAS unsigned*)(lds + (bufoff) + ldsw + _i * 8192), 16, 0, 0); } while (0)
#define PG8_LDA(dst, b, h) do { _Pragma("unroll") for (int m = 0; m < 4; ++m) _Pragma("unroll") for (int k = 0; k < 2; ++k) dst[m][k] = *(const LAS bf16x8*)(lds + PG8_SA(b, h) + aoff + m * 2048 + k * 1024); } while (0)
#define PG8_LDB(dst, b, h) do { _Pragma("unroll") for (int n = 0; n < 2; ++n) _Pragma("unroll") for (int k = 0; k < 2; ++k) dst[n][k] = *(const LAS bf16x8*)(lds + PG8_SB(b, h) + boff + n * 2048 + k * 1024); } while (0)
#define PG8_MMA(ai, bj, At, Bt) do { __builtin_amdgcn_s_setprio(1); _Pragma("unroll") for (int m = 0; m < 4; ++m) _Pragma("unroll") for (int n = 0; n < 2; ++n) _Pragma("unroll") for (int k = 0; k < 2; ++k) \
        acc[ai][bj][m][n] = __builtin_amdgcn_mfma_f32_16x16x32_bf16(Bt[n][k], At[m][k], acc[ai][bj][m][n], 0, 0, 0); __builtin_amdgcn_s_setprio(0); } while (0)
#define PG8_WAIT_V(n) asm volatile("s_waitcnt vmcnt(" #n ")" ::: "memory")
#define PG8_WAIT_L(n) asm volatile("s_waitcnt lgkmcnt(" #n ")" ::: "memory")
#define PG8_BAR __builtin_amdgcn_s_barrier()
#define PG8_SCHED __builtin_amdgcn_sched_barrier(0)
  Unit cur, nxt; int ui = 0;
  if (!S.next(0, cur)) return;
  if (g.delay > 0) { const unsigned long long t0_ = __builtin_amdgcn_s_memrealtime(); while ((long long)(__builtin_amdgcn_s_memrealtime() - t0_) < (long long)g.delay) __builtin_amdgcn_s_sleep(16); }
  f32x4 acc[2][2][4][2];
#pragma unroll
  for (int a = 0; a < 2; ++a)
#pragma unroll
    for (int b = 0; b < 2; ++b)
#pragma unroll
      for (int m = 0; m < 4; ++m)
#pragma unroll
        for (int n = 0; n < 2; ++n) acc[a][b][m][n] = (f32x4){0.f, 0.f, 0.f, 0.f};
  bf16x8 At[4][2], B0[2][2], B1[2][2];
  const char* cA = cur.A; const char* cB = cur.B;
  PG8_STAGE(PG8_SB(0, 0), cB, voffB); PG8_STAGE(PG8_SA(0, 0), cA, voffA); PG8_STAGE(PG8_SB(0, 1), cB + hstepB, voffB); PG8_STAGE(PG8_SA(0, 1), cA + hstepA, voffA);
  if (wr == 1) PG8_BAR;
  PG8_WAIT_V(4); PG8_BAR;
  PG8_STAGE(PG8_SB(1, 0), cB + kstep, voffB); PG8_STAGE(PG8_SA(1, 0), cA + kstep, voffA); PG8_STAGE(PG8_SB(1, 1), cB + hstepB + kstep, voffB);
  PG8_WAIT_V(6); PG8_BAR;
  for (;;) {
    const bool has_next = S.next(ui + 1, nxt);
    const char* nA = has_next ? nxt.A : cA; const char* nB = has_next ? nxt.B : cB;
    for (int t = 0; t < nt; t += 2) {
      const bool last = (t == nt - 2);
      if constexpr (Epi::HOOK) { if (t == 32 || t == 64) E.rescale(acc, cur, t >> 5, wr, wc, fr, fq); }
      const char* a1 = cA + (size_t)(t + 1) * kstep;
      const char* a2 = last ? nA : cA + (size_t)(t + 2) * kstep; const char* b2 = last ? nB : cB + (size_t)(t + 2) * kstep;
      const char* a3 = a2 + kstep; const char* b3 = b2 + kstep;
      PG8_LDB(B0, 0, 0); PG8_SCHED; PG8_LDA(At, 0, 0); PG8_STAGE(PG8_SA(1, 1), a1 + hstepA, voffA);
      PG8_WAIT_L(8); PG8_BAR; PG8_WAIT_L(0); PG8_MMA(0, 0, At, B0); PG8_BAR; PG8_SCHED;
      PG8_LDB(B1, 0, 1); PG8_STAGE(PG8_SB(0, 0), b2, voffB);
      PG8_BAR; PG8_WAIT_L(0); PG8_MMA(0, 1, At, B1); PG8_BAR;
      PG8_LDA(At, 0, 1); PG8_STAGE(PG8_SA(0, 0), a2, voffA);
      PG8_BAR; PG8_WAIT_L(0); PG8_MMA(1, 0, At, B0); PG8_BAR; PG8_SCHED;
      PG8_STAGE(PG8_SB(0, 1), b2 + hstepB, voffB);
      PG8_WAIT_V(6); PG8_BAR; PG8_MMA(1, 1, At, B1); PG8_BAR;
      PG8_LDB(B0, 1, 0); PG8_SCHED; PG8_LDA(At, 1, 0); PG8_STAGE(PG8_SA(0, 1), a2 + hstepA, voffA);
      PG8_WAIT_L(8); PG8_BAR; PG8_WAIT_L(0); PG8_MMA(0, 0, At, B0); PG8_BAR; PG8_SCHED;
      PG8_LDB(B1, 1, 1); PG8_STAGE(PG8_SB(1, 0), b3, voffB);
      PG8_BAR; PG8_WAIT_L(0); PG8_MMA(0, 1, At, B1); PG8_BAR;
      PG8_LDA(At, 1, 1); PG8_STAGE(PG8_SA(1, 0), a3, voffA);
      PG8_BAR; PG8_WAIT_L(0); PG8_MMA(1, 0, At, B0); PG8_BAR; PG8_SCHED;
      PG8_STAGE(PG8_SB(1, 1), b3 + hstepB, voffB);
      PG8_WAIT_V(6); PG8_BAR; PG8_MMA(1, 1, At, B1); PG8_BAR;
    }
    E(acc, cur, wr, wc, fr, fq);
    if (!has_next) break;
#pragma unroll
    for (int a = 0; a < 2; ++a)
#pragma unroll
      for (int b = 0; b < 2; ++b)
#pragma unroll
        for (int m = 0; m < 4; ++m)
#pragma unroll
          for (int n = 0; n < 2; ++n) acc[a][b][m][n] = (f32x4){0.f, 0.f, 0.f, 0.f};
    cur = nxt; cA = nA; cB = nB; ++ui;
  }
  PG8_WAIT_V(0);
  if (wr == 0) PG8_BAR;
  PG8_BAR;
#undef PG8_SA
#undef PG8_SB
#undef PG8_STAGE
#undef PG8_LDA
#undef PG8_LDB
#undef PG8_MMA
#undef PG8_WAIT_V
#undef PG8_WAIT_L
#undef PG8_BAR
#undef PG8_SCHED
}
}
using pg8::Unit;
typedef const f32x4 (&AccRef)[2][2][4][2];

DI void st_bf4(bf16_t* p, f32x4 v) { u32x2 w = {pk2(v[0], v[1]), pk2(v[2], v[3])}; *(u32x2*)p = w; }
DI void st_bf4a(bf16_t* p, f32x4 v) { u32x2 w = {pk2a(v[0], v[1]), pk2a(v[2], v[3])}; *(u32x2*)p = w; }
DI f32x4 ld_bf4(const bf16_t* p) { u32x2 w = *(const u32x2*)p; return (f32x4){bflo(w[0]), bfhi(w[0]), bflo(w[1]), bfhi(w[1])}; }

struct EpiIn {
  static constexpr bool HOOK = false;
  Params P; LAS unsigned char* ldsb;
  DI void rescale(f32x4 (&)[2][2][4][2], const Unit&, int, int, int, int, int) const {}
  DI void operator()(AccRef acc, const Unit& u, int wr, int wc, int fr, int fq) const {
    unsigned char* ws = P.ws; float* out = P.out;
    if (u.kind == 1) {
      const bool isV = u.col0 >= 2048; const int cb = isV ? u.col0 - 2048 : u.col0;
      float* fo = out + (isV ? O_MVP : O_MKP);
      bf16_t* MKP = (bf16_t*)(ws + W_MKP); bf16_t* VTP = (bf16_t*)(ws + W_VTP);
#pragma unroll
      for (int ai = 0; ai < 2; ++ai)
#pragma unroll
        for (int m = 0; m < 4; ++m) {
          const int row = u.row0 + ai * 128 + wr * 64 + m * 16 + fr;
#pragma unroll
          for (int bj = 0; bj < 2; ++bj)
#pragma unroll
            for (int n = 0; n < 2; ++n) {
              const int c = cb + bj * 128 + wc * 32 + n * 16 + 4 * fq;
              const f32x4 v = acc[ai][bj][m][n];
              *(f32x4*)(fo + (size_t)row * 2048 + c) = v;
              if (!isV) st_bf4(MKP + (size_t)row * 2048 + c, v);
              else { const int b = row >> 8, key = row & 255, h = c >> 9, d = c & 511;
                bf16_t* vt = VTP + ((size_t)((b * 4 + h) * 512 + d)) * 256 + key;
                const unsigned w0 = pk2(v[0], v[1]), w1 = pk2(v[2], v[3]);
                vt[0] = (bf16_t)(w0 & 0xffff); vt[256] = (bf16_t)(w0 >> 16); vt[512] = (bf16_t)(w1 & 0xffff); vt[768] = (bf16_t)(w1 >> 16); }
            }
        }
      return;
    }
    const bool sample = u.row0 >= MP;
    const int T = sample ? 64 : 2048;
    const int col0 = u.col0;
    if (col0 >= 23552) {
      if (wc > 1) return;
      const float* dtb = P.in[14]; const float* bfg = P.in[18];
      float* DT = (float*)(ws + W_DT);
      float* LFT = (float*)(ws + W_LFT); float* LFS = (float*)(ws + W_LFS);
#pragma unroll
      for (int ai = 0; ai < 2; ++ai)
#pragma unroll
        for (int m = 0; m < 4; ++m) {
          const int row = u.row0 + ai * 128 + wr * 64 + m * 16 + fr;
          const int rs = row - MP; const int b = sample ? (rs >> 6) : (row >> 11), t = sample ? (rs & 63) : (row & 2047);
#pragma unroll
          for (int n = 0; n < 2; ++n) {
            const int c = wc * 32 + n * 16 + 4 * fq;
            const f32x4 v = acc[ai][0][m][n];
            if (c < 32) { f32x4 o;
#pragma unroll
              for (int e = 0; e < 4; ++e) o[e] = softplusf_(v[e] + dtb[c + e]);
              *(f32x4*)(DT + (size_t)row * 32 + c) = o; }
            else if (c < 48) { const int h0 = c - 32; f32x4 o;
#pragma unroll
              for (int e = 0; e < 4; ++e) o[e] = -softplusf_(-(v[e] + bfg[h0 + e]));
              float* lo = sample ? out + O_FLS + (size_t)rs * 16 + h0 : out + O_FLP + (size_t)row * 16 + h0;
              *(f32x4*)lo = o;
#pragma unroll
              for (int e = 0; e < 4; ++e) { if (sample) LFS[(size_t)(b * 16 + h0 + e) * 1088 + 1024 + t] = o[e]; else LFT[(size_t)(b * 16 + h0 + e) * 2048 + t] = o[e]; }
            }
          }
        }
      return;
    }
    const bool smp = sample;
    if (col0 < 2048) seg_store<1, 0, false, false>(acc, u, wr, wc, fr, fq, (bf16_t*)(ws + W_ZB), 2048, col0, nullptr, nullptr, smp);
    else if (col0 < 5120) seg_store<0, 1, false, true>(acc, u, wr, wc, fr, fq, (bf16_t*)(ws + (smp ? W_XBCS : W_XBCP)), 3072, col0 - 2048, nullptr, out + (smp ? O_CONVS : O_CONVP), smp);
    else if (col0 < 7168) seg_store<0, 0, false, false>(acc, u, wr, wc, fr, fq, (bf16_t*)(ws + W_FQ), 2048, col0 - 5120, nullptr, nullptr, smp);
    else if (col0 < 9216) seg_store<0, 2, true, false>(acc, u, wr, wc, fr, fq, (bf16_t*)(ws + (smp ? W_KS : W_FK)), 2048, col0 - 7168, out + (smp ? O_FKS : O_FKP), nullptr, smp);
    else if (col0 < 11264) seg_store<0, 2, true, false>(acc, u, wr, wc, fr, fq, (bf16_t*)(ws + (smp ? W_VS : W_FV)), 2048, col0 - 9216, out + (smp ? O_FVS : O_FVP), nullptr, smp);
    else if (col0 < 13312) seg_store<1, 0, false, false>(acc, u, wr, wc, fr, fq, (bf16_t*)(ws + W_FG), 2048, col0 - 11264, nullptr, nullptr, smp);
    else if (col0 < 15360) seg_store<0, 0, false, false>(acc, u, wr, wc, fr, fq, (bf16_t*)(ws + W_MQ), 2048, col0 - 13312, nullptr, nullptr, smp);
    else if (col0 < 17408) seg_store<1, 0, false, false>(acc, u, wr, wc, fr, fq, (bf16_t*)(ws + W_MG), 2048, col0 - 15360, nullptr, nullptr, smp);
    else seg_store<2, 0, false, false>(acc, u, wr, wc, fr, fq, (bf16_t*)(ws + W_G3), 6144, col0 - 17408, nullptr, nullptr, smp);
  }
  template <int ACT, int ROWMODE, bool HASF, bool HASCONV>
  DI void seg_store(AccRef acc, const Unit& u, int wr, int wc, int fr, int fq, bf16_t* dst, int ld, int c0, float* fout, float* convout, bool sample) const {
    const int T = sample ? 64 : 2048;
    const int cl = c0 + wc * 32 + 4 * fq;
    const int lane = fr + 16 * fq, wid = wr * 4 + wc;
    LAS unsigned char* stg = ldsb + 131072 + wid * 1280;
    const int rS = lane >> 2, cS = (lane & 3) * 8;
#pragma unroll
    for (int ai = 0; ai < 2; ++ai)
#pragma unroll
      for (int m = 0; m < 4; ++m) {
        const int row = u.row0 + ai * 128 + wr * 64 + m * 16 + fr;
        const int rs = row - MP; const int b = sample ? (rs >> 6) : (row >> 11), t = sample ? (rs & 63) : (row & 2047);
        float* fp = HASF ? fout + (sample ? (size_t)rs : (size_t)row) * 2048 + cl : nullptr;
        const bool ctail = HASCONV && t >= T - 3;
        float* cp = HASCONV ? convout + (size_t)(b * 3 + t - (T - 3)) * 3072 + cl : nullptr;
        const int rowS = u.row0 + ai * 128 + wr * 64 + m * 16 + rS;
        size_t drow = (size_t)rowS;
        if (ROWMODE != 0) { const int rsS = rowS - MP; const int bS = sample ? (rsS >> 6) : (rowS >> 11), tS = sample ? (rsS & 63) : (rowS & 2047);
          if (ROWMODE == 1) drow = sample ? (size_t)(bS * 67 + 3 + tS) : (size_t)(bS * 2051 + 3 + tS);
          else drow = sample ? (size_t)(bS * 1088 + 1024 + tS) : (size_t)rowS; }
        bf16_t* dp = dst + drow * ld + c0 + wc * 32 + cS;
#pragma unroll
        for (int bj = 0; bj < 2; ++bj) {
#pragma unroll
          for (int n = 0; n < 2; ++n) {
            const int co = bj * 128 + n * 16;
            f32x4 v = acc[ai][bj][m][n];
            if (HASF) *(f32x4*)(fp + co) = v;
            if (HASCONV) { if (ctail) *(f32x4*)(cp + co) = v; }
            if (ACT == 1) {
#pragma unroll
              for (int e = 0; e < 4; ++e) v[e] = siluf_(v[e]);
            } else if (ACT == 2) {
#pragma unroll
              for (int e = 0; e < 4; ++e) v[e] = sigmoidf_(v[e]);
            }
            u32x2 w = {pk2(v[0], v[1]), pk2(v[2], v[3])};
            *(LAS u32x2*)(stg + fr * 80 + n * 32 + fq * 8) = w;
          }
          const u32x4 o = *(const LAS u32x4*)(stg + rS * 80 + cS * 2);
          *(u32x4*)(dp + bj * 128) = o;
        }
      }
  }
};
struct SchedP1 {
  int c, G; const char* XB; const char* WIN; const char* MB; const char* WMEM;
  DI bool next(int i, Unit& u) const {
    const int L = i * G + c;
    constexpr int N1 = 130 * 93;
    if (L < N1) { int pm, pn; pg8::tile_order(L, 130, 93, pm, pn);
      u.A = XB + (size_t)pm * 256 * 2048 * 2; u.B = WIN + (size_t)pn * 256 * 2048 * 2; u.row0 = pm * 256; u.col0 = pn * 256; u.kind = 0; u.nvalid = 256; u.aux = 0; return true; }
    const int L2 = L - N1; if (L2 >= 256) return false;
    int pm, pn; pg8::tile_order(L2, 16, 16, pm, pn);
    u.A = MB + (size_t)pm * 256 * 2048 * 2; u.B = WMEM + (size_t)pn * 256 * 2048 * 2; u.row0 = pm * 256; u.col0 = pn * 256; u.kind = 1; u.nvalid = 256; u.aux = 0; return true;
  }
};

struct EpiS {
  static constexpr bool HOOK = false;
  Params P;
  DI void rescale(f32x4 (&)[2][2][4][2], const Unit&, int, int, int, int, int) const {}
  DI void operator()(AccRef acc, const Unit& u, int wr, int wc, int fr, int fq) const {
    bf16_t* PM = (bf16_t*)(P.ws + W_PM); float* PSUM = (float*)(P.ws + W_PSUM);
    const float c2 = 0.044194173824159216f * 1.4426950408889634f;
    const int h = u.aux;
#pragma unroll
    for (int ai = 0; ai < 2; ++ai)
#pragma unroll
      for (int m = 0; m < 4; ++m) {
        const int rr = ai * 128 + wr * 64 + m * 16 + fr; const int row = u.row0 + rr; const bool ok = rr < u.nvalid;
        float s = 0.f;
#pragma unroll
        for (int bj = 0; bj < 2; ++bj)
#pragma unroll
          for (int n = 0; n < 2; ++n) {
            const int c = bj * 128 + wc * 32 + n * 16 + 4 * fq;
            f32x4 e;
#pragma unroll
            for (int k = 0; k < 4; ++k) { e[k] = __builtin_amdgcn_exp2f(fminf(acc[ai][bj][m][n][k] * c2, 100.f)); s += e[k]; }
            if (ok) st_bf4(PM + (size_t)row * 1024 + h * 256 + c, e);
          }
        s += __shfl_xor(s, 16); s += __shfl_xor(s, 32);
        if (ok && fq == 0) PSUM[(size_t)row * 16 + h * 4 + wc] = s;
      }
  }
};
struct SchedS {
  int c, G; const char* MQ; const char* MKP; const char* MKS;
  DI bool next(int i, Unit& u) const {
    const int L = i * G + c; if (L >= 544) return false;
    u.col0 = 0; u.kind = 0;
    if (L < 512) { const int b = L >> 5, h = (L >> 3) & 3, mt = L & 7; u.row0 = b * 2048 + mt * 256; u.nvalid = 256; u.aux = h;
      u.A = MQ + ((size_t)u.row0 * 2048 + h * 512) * 2; u.B = MKP + ((size_t)(b * 256) * 2048 + h * 512) * 2; }
    else { const int j = L - 512, b = j >> 2, h = j & 3; u.row0 = MP + b * 64; u.nvalid = 64; u.aux = h;
      u.A = MQ + ((size_t)u.row0 * 2048 + h * 512) * 2; u.B = MKS + ((size_t)(b * 256) * 2048 + h * 512) * 2; }
    return true;
  }
};
struct EpiPV {
  static constexpr bool HOOK = false;
  Params P;
  DI void rescale(f32x4 (&)[2][2][4][2], const Unit&, int, int, int, int, int) const {}
  DI void operator()(AccRef acc, const Unit& u, int wr, int wc, int fr, int fq) const {
    const float* PSUM = (const float*)(P.ws + W_PSUM); const bf16_t* MG = (const bf16_t*)(P.ws + W_MG); bf16_t* Y3 = (bf16_t*)(P.ws + W_Y3);
    const int h = u.aux >> 9;
#pragma unroll
    for (int ai = 0; ai < 2; ++ai)
#pragma unroll
      for (int m = 0; m < 4; ++m) {
        int rr = ai * 128 + wr * 64 + m * 16 + fr; asm volatile("" : "+v"(rr)); const int row = u.row0 + rr;
        if (!(m & 1)) __builtin_amdgcn_sched_barrier(0);
        if (rr < u.nvalid) {
          const f32x4 ps = *(const f32x4*)(PSUM + (size_t)row * 16 + h * 4);
          const float inv = 1.f / ((ps[0] + ps[1]) + (ps[2] + ps[3]));
#pragma unroll
          for (int bj = 0; bj < 2; ++bj)
#pragma unroll
            for (int n = 0; n < 2; ++n) {
              const int c = u.aux + bj * 128 + wc * 32 + n * 16 + 4 * fq;
              const f32x4 gte = ld_bf4(MG + (size_t)row * 2048 + c);
              st_bf4(Y3 + (size_t)row * 6144 + 4096 + c, acc[ai][bj][m][n] * gte * inv);
            }
        }
      }
  }
};
struct SchedPV {
  int c, G; const char* PM; const char* VTP; const char* VTS;
  DI bool next(int i, Unit& u) const {
    const int L = i * G + c; if (L >= 1088) return false;
    u.col0 = 0; u.kind = 0;
    if (L < 1024) { const int b = L >> 6, h = (L >> 4) & 3, mt = (L >> 1) & 7, n2 = L & 1; u.row0 = b * 2048 + mt * 256; u.nvalid = 256; u.aux = h * 512 + n2 * 256;
      u.A = PM + ((size_t)u.row0 * 1024 + h * 256) * 2; u.B = VTP + ((size_t)((b * 4 + h) * 512 + n2 * 256) * 256) * 2; }
    else { const int j = L - 1024, b = j >> 3, h = (j >> 1) & 3, n2 = j & 1; u.row0 = MP + b * 64; u.nvalid = 64; u.aux = h * 512 + n2 * 256;
      u.A = PM + ((size_t)u.row0 * 1024 + h * 256) * 2; u.B = VTS + ((size_t)((b * 4 + h) * 512 + n2 * 256) * 256) * 2; }
    return true;
  }
};

struct EpiMerge {
  static constexpr bool HOOK = false;
  Params P;
  DI void rescale(f32x4 (&)[2][2][4][2], const Unit&, int, int, int, int, int) const {}
  DI void operator()(AccRef acc, const Unit& u, int wr, int wc, int fr, int fq) const {
    const bf16_t* G3 = (const bf16_t*)(P.ws + W_G3); bf16_t* MRG = (bf16_t*)(P.ws + W_MRG); bf16_t* TMP = (bf16_t*)(P.ws + W_TMP);
    float* PARTM = (float*)(P.ws + W_PARTM);
    const float* RS = (const float*)(P.ws + W_RS);
    const int seg = u.kind >= 3 ? u.kind - 3 : u.kind; const bool part = u.kind >= 3;
#pragma unroll
    for (int ai = 0; ai < 2; ++ai)
#pragma unroll
      for (int m = 0; m < 4; ++m) {
        int row = u.row0 + ai * 128 + wr * 64 + m * 16 + fr; asm volatile("" : "+v"(row));
        const float rs = (seg == 0) ? RS[row] : 1.f;
#pragma unroll
        for (int bj = 0; bj < 2; ++bj)
#pragma unroll
          for (int n = 0; n < 2; ++n) {
            const int c = u.col0 + bj * 128 + wc * 32 + n * 16 + 4 * fq;
            const f32x4 gte = ld_bf4(G3 + (size_t)row * 6144 + seg * 2048 + c);
            f32x4 v = acc[ai][bj][m][n] * gte * rs;
            const size_t to = (size_t)row * 2048 + c;
            if (part) { *(f32x4*)(PARTM + ((size_t)seg * MS + (row - MP)) * 2048 + c) = v; }
            else {
              if (seg > 0) v += ld_bf4(TMP + to);
              if (seg < 2) st_bf4(TMP + to, v); else st_bf4(MRG + to, v);
            }
          }
        if (m & 1) __builtin_amdgcn_sched_barrier(0);
      }
  }
};
struct SchedMerge {
  int c, G; const char* A; const char* B;
  DI bool next(int i, Unit& u) const {
    int pm, pn, seg, kind;
    if (i < 12) { const int ti = i / 3; seg = i - ti * 3; const int L = ti * 256 + c; pm = (L >> 6) * 8 + (L & 7); pn = (L >> 3) & 7; kind = seg; }
    else if (i == 12 && c < 48) { const int e = c / 3; seg = c - e * 3; pm = 128 + (e >> 3); pn = e & 7; kind = 3 + seg; }
    else return false;
    u.A = A + ((size_t)pm * 256 * 6144 + seg * 2048) * 2; u.B = B + ((size_t)pn * 256 * 6144 + seg * 2048) * 2; u.row0 = pm * 256; u.col0 = pn * 256; u.kind = kind; u.nvalid = 256; u.aux = pn; return true;
  }
};
struct SchedOutP {
  int c; const char* A; const char* B;
  DI bool next(int i, Unit& u) const {
    if (i >= 4) return false;
    const int L = i * 256 + c; const int pm = (L >> 6) * 8 + (L & 7), pn = (L >> 3) & 7;
    u.A = A + (size_t)pm * 256 * 2048 * 2; u.B = B + (size_t)pn * 256 * 2048 * 2; u.row0 = pm * 256; u.col0 = pn * 256; u.kind = 0; u.nvalid = 256; u.aux = pn; return true;
  }
};
struct SchedOutS {
  int c; const char* A; const char* B;
  DI bool next(int i, Unit& u) const {
    if (i >= 1 || c >= 64) return false;
    const int e = c >> 2, kq = c & 3; const int pm = 128 + (e >> 3), pn = e & 7;
    u.A = A + ((size_t)pm * 256 * 2048 + kq * 512) * 2; u.B = B + ((size_t)pn * 256 * 2048 + kq * 512) * 2; u.row0 = pm * 256; u.col0 = pn * 256; u.kind = 1; u.nvalid = kq; u.aux = pn; return true;
  }
};
struct SchedTile {
  int c, G, nM, nN; const char* A; const char* B; size_t astep, bstep;
  DI bool next(int i, Unit& u) const {
    const int L = i * G + c; if (L >= nM * nN) return false;
    int pm, pn; pg8::tile_order(L, nM, nN, pm, pn);
    u.A = A + (size_t)pm * astep; u.B = B + (size_t)pn * bstep; u.row0 = pm * 256; u.col0 = pn * 256; u.kind = 0; u.nvalid = 256; u.aux = pn; return true;
  }
};
struct EpiOut {
  static constexpr bool HOOK = false;
  Params P;
  DI void rescale(f32x4 (&)[2][2][4][2], const Unit&, int, int, int, int, int) const {}
  DI void operator()(AccRef acc, const Unit& u, int wr, int wc, int fr, int fq) const {
    float* out = P.out; float* PARTO = (float*)(P.ws + W_PARTO);
    if (u.kind == 1) {
      float* PART5 = (float*)(P.ws + W_PART5) + (size_t)u.nvalid * MS * 2048;
#pragma unroll
      for (int ai = 0; ai < 2; ++ai)
#pragma unroll
        for (int m = 0; m < 4; ++m) {
          const int row = u.row0 + ai * 128 + wr * 64 + m * 16 + fr - MP;
#pragma unroll
          for (int bj = 0; bj < 2; ++bj)
#pragma unroll
            for (int n = 0; n < 2; ++n) *(f32x4*)(PART5 + (size_t)row * 2048 + u.col0 + bj * 128 + wc * 32 + n * 16 + 4 * fq) = acc[ai][bj][m][n];
        }
      return;
    }
    const float* xin = P.in[0];
#pragma unroll
    for (int ai = 0; ai < 2; ++ai)
#pragma unroll
      for (int m = 0; m < 4; ++m) {
        const int row = u.row0 + ai * 128 + wr * 64 + m * 16 + fr;
        float s = 0.f;
#pragma unroll
        for (int bj = 0; bj < 2; ++bj)
#pragma unroll
          for (int n = 0; n < 2; ++n) {
            const int c = u.col0 + bj * 128 + wc * 32 + n * 16 + 4 * fq;
            const f32x4 xo = acc[ai][bj][m][n] + *(const f32x4*)(xin + (size_t)row * 2048 + c);
            *(f32x4*)(out + (size_t)row * 2048 + c) = xo;
            s += xo[0] * xo[0] + xo[1] * xo[1] + xo[2] * xo[2] + xo[3] * xo[3];
          }
        s += __shfl_xor(s, 16); s += __shfl_xor(s, 32);
        if (fq == 0) PARTO[(size_t)row * 32 + u.aux * 4 + wc] = s;
      }
  }
};

DI void row_to_bf16(const float* src, bf16_t* dst, float* rs, int lane) {
  const f32x4* s = (const f32x4*)src + lane; f32x4 v[8]; float ss = 0.f;
#pragma unroll
  for (int j = 0; j < 8; ++j) { v[j] = s[64 * j]; ss += (v[j][0] * v[j][0] + v[j][1] * v[j][1]) + (v[j][2] * v[j][2] + v[j][3] * v[j][3]); }
  float sc = 1.f;
  if (rs) { ss = wave_sum(ss); sc = rsqrtf(ss * (1.f / 2048.f) + EPS); }
  u32x2* d = (u32x2*)dst + lane;
#pragma unroll
  for (int j = 0; j < 8; ++j) { u32x2 w = {pk2(v[j][0] * sc, v[j][1] * sc), pk2(v[j][2] * sc, v[j][3] * sc)}; d[64 * j] = w; }
}
DI void transpose_item(const float* W, int ldw, int scol0, int nvalid, const float* scale, bf16_t* WT, int ldd, int drow0, int dcol0, int kb, LAS float* scr, int lane) {
  const int k0 = 64 * kb;
  float tv[32];
  const bool ok_ = (lane & 31) < nvalid;
#pragma unroll
  for (int i = 0; i < 32; ++i) { const int kk = 2 * i + (lane >> 5); tv[i] = ok_ ? W[(size_t)(k0 + kk) * ldw + scol0 + (lane & 31)] : 0.f; }
#pragma unroll
  for (int i = 0; i < 32; ++i) { const int kk = 2 * i + (lane >> 5), n = lane & 31;
    float v = tv[i]; if (scale) v *= scale[k0 + kk];
    scr[kk * 33 + n] = v; }
  asm volatile("s_waitcnt lgkmcnt(0)" ::: "memory");
  const int c = lane & 7;
#pragma unroll
  for (int j = 0; j < 4; ++j) { const int n = (lane >> 3) + 8 * j; const LAS float* s = scr + (8 * c) * 33 + n;
    u32x4 o; o[0] = pk2(s[0 * 33], s[1 * 33]); o[1] = pk2(s[2 * 33], s[3 * 33]); o[2] = pk2(s[4 * 33], s[5 * 33]); o[3] = pk2(s[6 * 33], s[7 * 33]);
    *(u32x4*)(WT + (size_t)(drow0 + n) * ldd + dcol0 + k0 + 8 * c) = o; }
  asm volatile("s_waitcnt lgkmcnt(0)" ::: "memory");
}
DI void phase0(const Params& P, LAS unsigned char* lds) {
  unsigned char* ws = P.ws;
  int tid = threadIdx.x; asm volatile("" : "+v"(tid));
  const int wid = tid >> 6, lane = tid & 63;
  const int gw = blockIdx.x * 8 + wid, NGW = gridDim.x * 8;
  if (blockIdx.x == 0 && tid < 64) ((unsigned*)(ws + W_CTL))[tid] = 0u;
  constexpr int NR = MT + 4096 + 8192;
  for (int r = gw; r < NR; r += NGW) {
    if (r < MP) row_to_bf16(P.in[0] + (size_t)r * 2048, (bf16_t*)(ws + W_XB) + (size_t)r * 2048, (float*)(ws + W_R1), lane);
    else if (r < MT) row_to_bf16(P.in[1] + (size_t)(r - MP) * 2048, (bf16_t*)(ws + W_XB) + (size_t)r * 2048, (float*)(ws + W_R1), lane);
    else if (r < MT + 4096) { const int q = r - MT; row_to_bf16(P.in[2] + (size_t)q * 2048, (bf16_t*)(ws + W_MB) + (size_t)q * 2048, (float*)(ws + W_RM), lane); }
    else if (r < MT + 4096 + 8192) { const int q = r - MT - 4096, b = q >> 10, j = q & 1023; row_to_bf16(P.in[3] + (size_t)q * 2048, (bf16_t*)(ws + W_KS) + (size_t)(b * 1088 + j) * 2048, nullptr, lane); }
    else if (r < MT + 4096 + 16384) { continue; }
    else { continue; }
  }
  LAS float* scr = (LAS float*)(lds + wid * 8448);
  constexpr int I_IN = 744 * 32, I_MEM = 128 * 32, I_O = 64 * 32;
  constexpr int NITEMS = I_IN + I_MEM + 4 * I_O;
  for (int it = gw; it < NITEMS; it += NGW) {
    int r = it;
    if (r < I_IN) { const int nb = r >> 5, kb = r & 31, d = nb * 32; int src, nv = 32;
      if (d < 5120) src = d; else if (d < 13312) src = d + 32; else if (d < 23552) src = d + 48;
      else if (d == 23552) src = 5120; else if (d == 23584) { src = 13344; nv = 16; } else { src = 0; nv = 0; }
      transpose_item(P.in[11], 23600, src, nv, P.in[10], (bf16_t*)(ws + W_WIN), 2048, d, 0, kb, scr, lane); continue; }
    r -= I_IN;
    if (r < I_MEM) { const int nb = r >> 5, kb = r & 31; transpose_item(P.in[20], 4096, nb * 32, 32, P.in[19], (bf16_t*)(ws + W_WMEM), 2048, nb * 32, 0, kb, scr, lane); continue; }
    r -= I_MEM;
    if (r < I_O) { const int nb = r >> 5, kb = r & 31; transpose_item(P.in[21], 2048, nb * 32, 32, P.in[17], (bf16_t*)(ws + W_WO), 6144, nb * 32, 0, kb, scr, lane); continue; }
    r -= I_O;
    if (r < I_O) { const int nb = r >> 5, kb = r & 31; transpose_item(P.in[22], 2048, nb * 32, 32, nullptr, (bf16_t*)(ws + W_WO), 6144, nb * 32, 2048, kb, scr, lane); continue; }
    r -= I_O;
    if (r < I_O) { const int nb = r >> 5, kb = r & 31; transpose_item(P.in[23], 2048, nb * 32, 32, nullptr, (bf16_t*)(ws + W_WO), 6144, nb * 32, 4096, kb, scr, lane); continue; }
    r -= I_O;
    { const int nb = r >> 5, kb = r & 31; transpose_item(P.in[24], 2048, nb * 32, 32, nullptr, (bf16_t*)(ws + W_WOUT), 2048, nb * 32, 0, kb, scr, lane); }
  }
  const long gt = (long)blockIdx.x * 512 + tid, NT = (long)gridDim.x * 512;
  for (long i = gt; i < 8L * 1024 * 16; i += NT) { const int h = (int)(i & 15), j = (int)((i >> 4) & 1023), b = (int)(i >> 14);
    ((float*)(ws + W_LFS))[(size_t)(b * 16 + h) * 1088 + j] = P.in[5][i]; }
  for (long i = gt; i < 8L * 3 * 3072; i += NT) { const int c = (int)(i % 3072), r = (int)((i / 3072) % 3), b = (int)(i / 9216);
    ((bf16_t*)(ws + W_XBCS))[(size_t)(b * 67 + r) * 3072 + c] = (bf16_t)(pk2(P.in[7][i], 0.f) & 0xffff); }
  for (long i = gt; i < 16L * 3 * 3072; i += NT) { const int c = (int)(i % 3072), r = (int)((i / 3072) % 3), b = (int)(i / 9216);
    ((bf16_t*)(ws + W_XBCP))[(size_t)(b * 2051 + r) * 3072 + c] = 0; }
}

DI void p1_tail_convert(const Params& P, int part, int nparts) {
  unsigned char* ws = P.ws;
  int tid = threadIdx.x; asm volatile("" : "+v"(tid));
  const int wid = tid >> 6, lane = tid & 63;
  for (int q = part * 8 + wid; q < 8192; q += nparts * 8) { const int b = q >> 10, j = q & 1023;
    row_to_bf16(P.in[4] + (size_t)q * 2048, (bf16_t*)(ws + W_VS) + (size_t)(b * 1088 + j) * 2048, nullptr, lane); }
  for (int q = part * 8 + wid; q < 2048; q += nparts * 8) row_to_bf16(P.in[8] + (size_t)q * 2048, (bf16_t*)(ws + W_MKS) + (size_t)q * 2048, nullptr, lane);
  const long gt = (long)part * 512 + tid, NT = (long)nparts * 512;
  for (long i = gt; i < 8L * 32 * 2048; i += NT) {
    const int hd = (int)(i & 2047), kg = (int)((i >> 11) & 31), b = (int)(i >> 16);
    const float* s = P.in[9] + ((size_t)(b * 256 + kg * 8) * 2048 + hd);
    u32x4 o; o[0] = pk2(s[0], s[2048]); o[1] = pk2(s[2 * 2048], s[3 * 2048]); o[2] = pk2(s[4 * 2048], s[5 * 2048]); o[3] = pk2(s[6 * 2048], s[7 * 2048]);
    *(u32x4*)((bf16_t*)(ws + W_VTS) + ((size_t)(b * 2048 + hd)) * 256 + kg * 8) = o;
  }
}

namespace fa {
constexpr int D = 128, LD = 2048, LDO = 6144;
constexpr float SCALE = 0.08838834764831845f;
constexpr float THR = 8.f;
constexpr int NW = 8, QBLK = 32, KVBLK = 64, QB = NW * QBLK;
constexpr int SHM_V = KVBLK * D * 2, SHM_K = KVBLK * D * 2;
constexpr int TAB_OFF = 2 * SHM_V + 2 * SHM_K + NW * 64 * 4;
constexpr unsigned WBIG = 0x7fffffffu;
constexpr int OSTG_OFF = 77824;
#define KSWZ(row, colB) ((row) * 256 + ((colB) ^ (((row) & 7) << 4)))
#define SBAR() __builtin_amdgcn_sched_barrier(0)
DI int v_st(int k, int c) { const int kk = (k & ~0xC) | ((k & 4) << 1) | ((k & 8) >> 1); return ((kk >> 3) * 4 + (c >> 5)) * 512 + ((kk & 7) * 32 + (c & 31)) * 2; }
DI int v_rd_base(int lane) { return ((lane & 3) << 3) | (((lane >> 2) & 3) << 6) | (((lane >> 4) & 1) << 5) | (((lane >> 5) & 1) << 8); }
constexpr int v_rd_off(int d0, int ks, int half) { return d0 * 512 + ks * 4096 + half * 2048; }
DI int crow(int r, int hi) { return (r & 3) + 8 * (r >> 2) + 4 * hi; }
DI bf16x8 load8(const bf16_t* p) { return *reinterpret_cast<const bf16x8*>(p); }
DI void mask_tile(f32x16& p0, f32x16& p1, int dq, unsigned W) {
  const float NEG = -__builtin_inff();
#pragma unroll
  for (int r = 0; r < 16; ++r) {
    const int c = (r & 3) + 8 * (r >> 2);
    if ((unsigned)(dq - c) >= W) p0[r] = NEG;
    if ((unsigned)(dq - c - 32) >= W) p1[r] = NEG;
  }
}
DI void partialSM(f32x16& p0, f32x16& p1, float& m_reg, float& mn, float& alpha) {
  float pmax = p0[0];
#pragma unroll
  for (int r = 1; r < 16; ++r) pmax = fmaxf(pmax, p0[r]);
#pragma unroll
  for (int r = 0; r < 16; ++r) pmax = fmaxf(pmax, p1[r]);
  { auto rr = __builtin_amdgcn_permlane32_swap(__float_as_uint(pmax), __float_as_uint(pmax), false, false);
    pmax = fmaxf(__uint_as_float(rr[0]), __uint_as_float(rr[1])); }
  constexpr float C2 = 1.4426950408889634f * SCALE;
  if (__builtin_expect(__all((pmax - m_reg) * SCALE <= THR), 1)) { mn = m_reg; alpha = 1.f; }
  else { mn = fmaxf(m_reg, pmax); alpha = __builtin_amdgcn_exp2f((m_reg - mn) * C2); m_reg = mn; }
  const float mnL = -mn * C2;
#pragma unroll
  for (int r = 0; r < 16; ++r) p0[r] = fmaf(p0[r], C2, mnL);
#pragma unroll
  for (int r = 0; r < 16; ++r) p1[r] = fmaf(p1[r], C2, mnL);
#pragma unroll
  for (int r = 0; r < 16; ++r) p0[r] = __builtin_amdgcn_exp2f(p0[r]);
}
DI void finishSM(f32x16& p0, f32x16& p1, float alpha, float& l_reg, bf16x8& pa0, bf16x8& pa1, bf16x8& pa2, bf16x8& pa3) {
#pragma unroll
  for (int r = 0; r < 16; ++r) p1[r] = __builtin_amdgcn_exp2f(p1[r]);
  float ps = 0;
#pragma unroll
  for (int r = 0; r < 16; ++r) ps += p0[r];
#pragma unroll
  for (int r = 0; r < 16; ++r) ps += p1[r];
  { auto rr = __builtin_amdgcn_permlane32_swap(__float_as_uint(ps), __float_as_uint(ps), false, false);
    ps = __uint_as_float(rr[0]) + __uint_as_float(rr[1]); }
  l_reg = l_reg * alpha + ps;
#define PK4(P, B_, OUT) do { unsigned a0 = pk2a(P[B_+0], P[B_+1]), a1 = pk2a(P[B_+2], P[B_+3]);                          \
        unsigned b0 = pk2a(P[B_+4], P[B_+5]), b1 = pk2a(P[B_+6], P[B_+7]);                                             \
        auto r0 = __builtin_amdgcn_permlane32_swap(a0, b0, false, false); auto r1 = __builtin_amdgcn_permlane32_swap(a1, b1, false, false); \
        u32x4 w = {r0[0], r1[0], r0[1], r1[1]}; OUT = *reinterpret_cast<bf16x8*>(&w); } while (0)
  PK4(p0, 0, pa0); PK4(p0, 8, pa1); PK4(p1, 0, pa2); PK4(p1, 8, pa3);
#undef PK4
}
template <int KB>
DI void qkt(f32x16& p0, f32x16& p1, const LAS char* K_lds, const LAS float* tabk, int r32, int hi, const bf16x8* qr) {
#pragma unroll
  for (int g = 0; g < 4; ++g) { const f32x4 t0 = *(const LAS f32x4*)(tabk + 8 * g + 4 * hi), t1 = *(const LAS f32x4*)(tabk + 32 + 8 * g + 4 * hi);
#pragma unroll
    for (int e = 0; e < 4; ++e) { p0[4 * g + e] = t0[e]; p1[4 * g + e] = t1[e]; } }
  const LAS char* kb[4];
#pragma unroll
  for (int dd = 0; dd < 4; ++dd) kb[dd] = K_lds + KB * SHM_K + KSWZ(r32, (dd * 16 + hi * 8) * 2);
#pragma unroll
  for (int d0 = 0; d0 < 8; ++d0) { const LAS char* a = kb[d0 & 3] + (d0 >> 2) * 128;
    bf16x8 b0 = *(const LAS bf16x8*)(a);
    bf16x8 b1 = *(const LAS bf16x8*)(a + 32 * 256);
    p0 = __builtin_amdgcn_mfma_f32_32x32x16_bf16(b0, qr[d0], p0, 0, 0, 0);
    p1 = __builtin_amdgcn_mfma_f32_32x32x16_bf16(b1, qr[d0], p1, 0, 0, 0); }
}
template <int VB>
DI void pv_tile(f32x16* o, int vb0, bf16x8 pa0, bf16x8 pa1, bf16x8 pa2, bf16x8 pa3) {
#define TRRD(dst, off) asm volatile("ds_read_b64_tr_b16 %0, %1 offset:%2" : "=&v"(dst) : "v"(vb0), "i"(off) : "memory")
#define PV_D0(d0) do { s16x4 l0, l1, l2, l3, h0, h1, h2, h3; constexpr int b_ = VB * SHM_V + v_rd_off(d0, 0, 0); \
        TRRD(l0, b_); TRRD(h0, b_ + 2048); TRRD(l1, b_ + 4096); TRRD(h1, b_ + 6144); TRRD(l2, b_ + 8192); TRRD(h2, b_ + 10240); TRRD(l3, b_ + 12288); TRRD(h3, b_ + 14336); \
        asm volatile("s_waitcnt lgkmcnt(0)" ::: "memory"); SBAR();   \
        o[d0] = __builtin_amdgcn_mfma_f32_32x32x16_bf16(pa0, (bf16x8){l0[0], l0[1], l0[2], l0[3], h0[0], h0[1], h0[2], h0[3]}, o[d0], 0, 0, 0);   \
        o[d0] = __builtin_amdgcn_mfma_f32_32x32x16_bf16(pa1, (bf16x8){l1[0], l1[1], l1[2], l1[3], h1[0], h1[1], h1[2], h1[3]}, o[d0], 0, 0, 0);   \
        o[d0] = __builtin_amdgcn_mfma_f32_32x32x16_bf16(pa2, (bf16x8){l2[0], l2[1], l2[2], l2[3], h2[0], h2[1], h2[2], h2[3]}, o[d0], 0, 0, 0);   \
        o[d0] = __builtin_amdgcn_mfma_f32_32x32x16_bf16(pa3, (bf16x8){l3[0], l3[1], l3[2], l3[3], h3[0], h3[1], h3[2], h3[3]}, o[d0], 0, 0, 0); } while (0)
  PV_D0(0); PV_D0(1); PV_D0(2); PV_D0(3);
#undef PV_D0
#undef TRRD
}
struct BlockRef { const bf16_t* Q; const bf16_t* K; const bf16_t* V; bf16_t* O; const bf16_t* G; const float* lf; int P0, skv, nvalid, nkeys; };
struct Seam { bf16x8 qr[8]; bf16x8 st_v0, st_v1, st_k0, st_k1; };
constexpr int NFOX = 2048 + 128;
DI BlockRef fox_decode(const Params& P, int L) {
  unsigned char* ws = P.ws; BlockRef r;
  const bf16_t* FQ = (const bf16_t*)(ws + W_FQ); const bf16_t* FG = (const bf16_t*)(ws + W_FG); bf16_t* Y3 = (bf16_t*)(ws + W_Y3);
  if (L < 2048) { const int bh = L >> 3, qb = 7 - (L & 7), b = bh >> 4, h = bh & 15;
    const size_t row = (size_t)b * 2048 + qb * 256;
    r.lf = (const float*)(ws + W_LFT) + (size_t)bh * 2048; r.nkeys = 2048;
    r.Q = FQ + row * 2048 + h * 128; r.K = (const bf16_t*)(ws + W_FK) + (size_t)b * 2048 * 2048 + h * 128; r.V = (const bf16_t*)(ws + W_FV) + (size_t)b * 2048 * 2048 + h * 128;
    r.O = Y3 + row * 6144 + 2048 + h * 128; r.G = FG + row * 2048 + h * 128; r.P0 = qb * 256; r.skv = 2048; r.nvalid = 256;
  } else { const int j = L - 2048, b = j >> 4, h = j & 15;
    r.lf = (const float*)(ws + W_LFS) + (size_t)j * 1088; r.nkeys = 1088;
    const size_t row = (size_t)MP + b * 64;
    r.Q = FQ + row * 2048 + h * 128; r.K = (const bf16_t*)(ws + W_KS) + (size_t)b * 1088 * 2048 + h * 128; r.V = (const bf16_t*)(ws + W_VS) + (size_t)b * 1088 * 2048 + h * 128;
    r.O = Y3 + row * 6144 + 2048 + h * 128; r.G = FG + row * 2048 + h * 128; r.P0 = 1024; r.skv = 1088; r.nvalid = 64; }
  return r;
}

#define ROW(p, k0, rr) ((p) + (size_t)((k0) + 32 * (rr)) * LD + rowoff0)
#define VMW() asm volatile("s_waitcnt vmcnt(0)" ::: "memory")
#define VMWN(n) asm volatile("s_waitcnt vmcnt(%0)" :: "i"(n) : "memory")
#define SLOAD_H(Kp, Vp, k0) do { S.st_v0 = load8(ROW(Vp, k0, 0)); S.st_v1 = load8(ROW(Vp, k0, 1));              \
                         S.st_k0 = load8(ROW(Kp, k0, 0)); S.st_k1 = load8(ROW(Kp, k0, 1)); } while (0)
#define SWRITE_HK(bf) do { *(LAS bf16x8*)(K_lds + (bf) * SHM_K + kws) = S.st_k0; *(LAS bf16x8*)(K_lds + (bf) * SHM_K + kws + 32 * 256) = S.st_k1; } while (0)
#define SWRITE_HV(bf) do { *(LAS bf16x8*)(V_lds + (bf) * SHM_V + vst0) = S.st_v0; *(LAS bf16x8*)(V_lds + (bf) * SHM_V + vst0 + vst1d) = S.st_v1; } while (0)
#define SWRITE_H(bf) do { SWRITE_HV(bf); SWRITE_HK(bf); } while (0)
DI void fox_prime(const BlockRef& cur, LAS char* lds, Seam& S) {
  int tid = threadIdx.x; asm volatile("" : "+v"(tid));
  const int wid = __builtin_amdgcn_readfirstlane(tid >> 6), lane = tid & 63, r32 = lane & 31, hi = lane >> 5;
  const int sr = tid >> 4, sc = (tid & 15) * 8, kws = KSWZ(sr, sc * 2); LAS char* K_lds = lds + 2 * SHM_V;
  const unsigned rowoff0 = (unsigned)(sr * LD + sc);
  const unsigned qoff = (unsigned)((wid * QBLK + r32) * LD + hi * 8);
#pragma unroll
  for (int d0 = 0; d0 < 8; ++d0) S.qr[d0] = load8(cur.Q + qoff + d0 * 16);
  SLOAD_H(cur.K, cur.V, 0); VMW(); SWRITE_HK(0);
  __syncthreads();
}
DI void fox_block(const BlockRef& cur, int Ln, const Params& P, LAS char* lds, Seam& S) {
  int tid = threadIdx.x; asm volatile("" : "+v"(tid));
  const int wid = __builtin_amdgcn_readfirstlane(tid >> 6), lane = tid & 63, r32 = lane & 31, hi = lane >> 5;
  int j_hi = (cur.P0 + QB - 1) / KVBLK + 1; if (j_hi > cur.skv / KVBLK) j_hi = cur.skv / KVBLK;
  const int NT = j_hi;
  const int qlo = cur.P0 + wid * QBLK, qm = qlo + r32 - 4 * hi;
  LAS char* V_lds = lds; LAS char* K_lds = lds + 2 * SHM_V;
  LAS float* ws = (LAS float*)(lds + 2 * SHM_V + 2 * SHM_K) + wid * 64; LAS float* li_l = ws; LAS float* al_l = ws + 32;
  const LAS float* tab = (const LAS float*)(lds + TAB_OFF);
  float m_reg = -1e30f, l_reg = 0; f32x16 o[4] = {};
  const int sr = tid >> 4, sc = (tid & 15) * 8, vst0 = v_st(sr, sc), kws = KSWZ(sr, sc * 2);
  constexpr int vst1d = 8192;
  const unsigned rowoff0 = (unsigned)(sr * LD + sc);
  const int vb0 = (int)(uintptr_t)V_lds + v_rd_base(lane);
  const bf16_t* Kh = cur.K; const bf16_t* Vh = cur.V;
#define RESC(a) do { if (__any((a) < 1.f)) { if (hi == 0) al_l[r32] = (a); asm volatile("s_waitcnt lgkmcnt(0)" ::: "memory");              \
                     for (int d_ = 0; d_ < 4; ++d_) for (int r = 0; r < 16; ++r) o[d_][r] *= al_l[crow(r, hi)]; } } while (0)
#define KBASE(t) ((t) * KVBLK)
#define MASKT(P0_, P1_, t) do { const int kb_ = KBASE(t); if (kb_ + KVBLK - 1 > qlo) mask_tile(P0_, P1_, qm - kb_, WBIG); } while (0)
#define SEAM_K0() do { VMWN(8); SWRITE_HK(0); SBAR(); } while (0)
  f32x16 pA0, pA1, pB0, pB1; float mnA, mnB, alA, alB; bf16x8 pa0, pa1, pa2, pa3;
  SWRITE_HV(0); SBAR();
  if (NT > 1) { SLOAD_H(Kh, Vh, KBASE(1)); }
  SBAR(); qkt<0>(pA0, pA1, K_lds, tab + KBASE(0), r32, hi, S.qr);
  MASKT(pA0, pA1, 0); partialSM(pA0, pA1, m_reg, mnA, alA);
  if (NT > 1) { VMW(); SWRITE_H(1); }
  __syncthreads();
#define HALF_STEP(PX0, PX1, mnX, alX, PY0, PY1, alY, t, KB, VB, SB) do {                                                      \
        SBAR(); qkt<KB>(PX0, PX1, K_lds, tab + KBASE(t), r32, hi, S.qr);                                             \
        finishSM(PY0, PY1, alY, l_reg, pa0, pa1, pa2, pa3); SBAR();                                                           \
        if ((t) + 1 < NT) { SLOAD_H(Kh, Vh, KBASE((t) + 1)); SBAR(); }                                               \
        pv_tile<VB>(o, vb0, pa0, pa1, pa2, pa3); MASKT(PX0, PX1, (t)); partialSM(PX0, PX1, m_reg, mnX, alX);                                        \
        __syncthreads();                                                                                                      \
        if ((t) + 1 < NT) { VMW(); SWRITE_H(SB); }                                                                          \
        RESC(alX); __syncthreads(); } while (0)
  for (int t = 1; t + 1 < NT; t += 2) {
    HALF_STEP(pB0, pB1, mnB, alB, pA0, pA1, alA, t, 1, 0, 0);
    HALF_STEP(pA0, pA1, mnA, alA, pB0, pB1, alB, t + 1, 0, 1, 1);
  }
  const bool even = (NT & 1) == 0;
  if (even) { SBAR(); qkt<1>(pB0, pB1, K_lds, tab + KBASE(NT - 1), r32, hi, S.qr); SBAR(); }
  const BlockRef nxt = (Ln < NFOX) ? fox_decode(P, Ln) : cur;
  SLOAD_H(nxt.K, nxt.V, 0); SBAR();
  unsigned qoff; { int l2 = lane; asm volatile("" : "+v"(l2)); qoff = (unsigned)((wid * QBLK + (l2 & 31)) * LD + (l2 >> 5) * 8); }
#pragma unroll
  for (int d0 = 0; d0 < 8; ++d0) S.qr[d0] = load8(nxt.Q + qoff + d0 * 16);
  SBAR();
  finishSM(pA0, pA1, alA, l_reg, pa0, pa1, pa2, pa3); SBAR();
  pv_tile<0>(o, vb0, pa0, pa1, pa2, pa3);
  if (even) { MASKT(pB0, pB1, NT - 1); partialSM(pB0, pB1, m_reg, mnB, alB); __syncthreads(); RESC(alB);
    finishSM(pB0, pB1, alB, l_reg, pa0, pa1, pa2, pa3); SBAR(); pv_tile<1>(o, vb0, pa0, pa1, pa2, pa3); }
  SBAR(); SEAM_K0();
  if (hi == 0) li_l[r32] = l_reg; asm volatile("s_waitcnt lgkmcnt(0)" ::: "memory");
  { int lane_o = lane; asm volatile("" : "+v"(lane_o));
    LAS char* stg = lds + OSTG_OFF + wid * 8448;
    const int rw = lane_o >> 4, cw = (lane_o & 15) * 8; const int r32 = lane_o & 31, hi = lane_o >> 5;
#pragma unroll
    for (int half = 0; half < 2; ++half) {
#pragma unroll
      for (int rr = 0; rr < 8; ++rr) { const int r = half * 8 + rr; const int orow = crow(r, hi); const float rl = __builtin_amdgcn_rcpf(li_l[orow]);
#pragma unroll
        for (int d0 = 0; d0 < 4; ++d0) *(LAS float*)(stg + (orow - 16 * half) * 528 + (d0 * 32 + r32) * 4) = o[d0][r] * rl; }
      asm volatile("s_waitcnt lgkmcnt(0)" ::: "memory");
#pragma unroll
      for (int i = 0; i < 4; ++i) { const int lr = i * 4 + rw; const int brow = wid * QBLK + half * 16 + lr;
        const f32x4 v0 = *(const LAS f32x4*)(stg + lr * 528 + cw * 4), v1 = *(const LAS f32x4*)(stg + lr * 528 + cw * 4 + 16);
        const u32x4 gw = *(const u32x4*)(cur.G + (unsigned)(brow * LD + cw));
        u32x4 ow; ow[0] = pk2a(v0[0] * bflo(gw[0]), v0[1] * bfhi(gw[0])); ow[1] = pk2a(v0[2] * bflo(gw[1]), v0[3] * bfhi(gw[1]));
        ow[2] = pk2a(v1[0] * bflo(gw[2]), v1[1] * bfhi(gw[2])); ow[3] = pk2a(v1[2] * bflo(gw[3]), v1[3] * bfhi(gw[3]));
        if (brow < cur.nvalid) *(u32x4*)(cur.O + (unsigned)(brow * LDO + cw)) = ow; }
      asm volatile("s_waitcnt lgkmcnt(0)" ::: "memory");
    } }
  __syncthreads();
#undef RESC
#undef KBASE
#undef MASKT
#undef SEAM_K0
#undef HALF_STEP
}
#undef ROW
#undef VMW
#undef VMWN
#undef SLOAD_H
#undef SWRITE_HK
#undef SWRITE_HV
#undef SWRITE_H
DI void build_bias(const float* src, int nkeys, LAS char* lds) {
  LAS float* tab = (LAS float*)(lds + TAB_OFF); LAS float* wsum = tab + 2048;
  int tid = threadIdx.x; asm volatile("" : "+v"(tid));
  const int lane = tid & 63, wid = tid >> 6;
  f32x4 v = {0.f, 0.f, 0.f, 0.f}; if (tid * 4 < nkeys) v = *(const f32x4*)(src + tid * 4);
  const float s0 = v[0], s1 = s0 + v[1], s2 = s1 + v[2], s3 = s2 + v[3];
  float incl = s3;
#pragma unroll
  for (int o = 1; o < 64; o <<= 1) { const int sl = lane >= o ? lane - o : lane;
    const float t = __int_as_float(__builtin_amdgcn_ds_bpermute(sl * 4, __float_as_int(incl))); if (lane >= o) incl += t; }
  if (lane == 63) wsum[wid] = incl;
  __syncthreads();
  float off = incl - s3;
  for (int w = 0; w < wid; ++w) off += wsum[w];
  const float kk = -11.313708498984761f;
  f32x4 o = {(off + s0) * kk, (off + s1) * kk, (off + s2) * kk, (off + s3) * kk};
  *(LAS f32x4*)(tab + tid * 4) = o;
  __syncthreads();
}
}

DI int fetch_fox(unsigned* ctl, LAS char* lds, int xcd, bool first) {
  volatile LAS int* slot = (volatile LAS int*)(lds + LDS_BYTES - 64);
  __syncthreads();
  if (threadIdx.x == 0) {
    int q = first ? 0 : slot[1]; int item = 2048 + 128;
    for (; q < 8; ++q) { const int xq = (xcd + q) & 7; const int v = (int)atomicAdd(ctl + 16 + xq, 1u);
      if (v < 272) { item = v < 256 ? (((v >> 3) * 8 + xq) * 8 + (v & 7)) : 2048 + (v - 256) * 8 + xq; break; } }
    slot[1] = q; slot[0] = item;
  }
  __syncthreads();
  return __builtin_amdgcn_readfirstlane(slot[0]);
}
DI int fetch_item(unsigned* ctr, LAS char* lds) {
  volatile LAS int* slot = (volatile LAS int*)(lds + LDS_BYTES - 64);
  __syncthreads();
  if (threadIdx.x == 0) *slot = (int)atomicAdd(ctr, 1u);
  __syncthreads();
  return __builtin_amdgcn_readfirstlane(*slot);
}


DI void conv_pass(const Params& P) {
  unsigned char* ws = P.ws;
  int tid = threadIdx.x; asm volatile("" : "+v"(tid));
  const float* wconv = P.in[12]; const float* bconv = P.in[13];
  bf16_t* XCT = (bf16_t*)(ws + W_XCT); bf16_t* BCN = (bf16_t*)(ws + W_BCN); bf16_t* BTT = (bf16_t*)(ws + W_BTT);
  const int lane = tid & 63, wv = blockIdx.x * 8 + (tid >> 6), NWV = gridDim.x * 8;
  const int tg = lane & 7, ccl = lane >> 3;
  for (int it = wv; it < 520 * 48; it += NWV) {
    const int cidx = it / 48, ccg = it - cidx * 48; const int cc = ccg * 8 + ccl; const int ch = cc * 8;
    const bool sample = cidx >= 512; const int b = sample ? cidx - 512 : cidx >> 5, c = sample ? 0 : cidx & 31;
    const bf16_t* xbc = sample ? (const bf16_t*)(ws + W_XBCS) + (size_t)b * 67 * 3072 : (const bf16_t*)(ws + W_XBCP) + (size_t)b * 2051 * 3072;
    const size_t rowbase = sample ? (size_t)MP + b * 64 : (size_t)b * 2048;
    const int t0 = c * 64 + tg * 8;
    u32x4 raw[11];
#pragma unroll
    for (int j = 0; j < 11; ++j) raw[j] = *(const u32x4*)(xbc + (size_t)(t0 + j) * 3072 + ch);
    f32x4 wv4[4][2], bv[2];
#pragma unroll
    for (int i = 0; i < 4; ++i) { wv4[i][0] = *(const f32x4*)(wconv + i * 3072 + ch); wv4[i][1] = *(const f32x4*)(wconv + i * 3072 + ch + 4); }
    bv[0] = *(const f32x4*)(bconv + ch); bv[1] = *(const f32x4*)(bconv + ch + 4);
    unsigned op[8][4];
    u32x4 on[8];
    float prev[8];
#pragma unroll
    for (int j = 0; j < 8; ++j) {
      float o[8];
#pragma unroll
      for (int e = 0; e < 8; ++e) { float a = bv[e >> 2][e & 3];
#pragma unroll
        for (int i = 0; i < 4; ++i) { const unsigned w = raw[j + i][e >> 1]; const float xv = (e & 1) ? bfhi(w) : bflo(w); a += wv4[i][e >> 2][e & 3] * xv; }
        o[e] = siluf_(a); }
      on[j][0] = pk2(o[0], o[1]); on[j][1] = pk2(o[2], o[3]); on[j][2] = pk2(o[4], o[5]); on[j][3] = pk2(o[6], o[7]);
      if (j & 1) {
#pragma unroll
        for (int e = 0; e < 8; ++e) op[e][j >> 1] = pk2(prev[e], o[e]);
      } else {
#pragma unroll
        for (int e = 0; e < 8; ++e) prev[e] = o[e];
      }
    }
    if (ch < 2048) { const int h = ch >> 6, p0 = ch & 63;
      bf16_t* dst = XCT + ((size_t)(cidx * 32 + h) * 64 + p0) * 64 + tg * 8;
#pragma unroll
      for (int e = 0; e < 8; ++e) { u32x4 w = {op[e][0], op[e][1], op[e][2], op[e][3]}; *(u32x4*)(dst + e * 64) = w; }
    } else {
      const int cb = ch - 2048;
      bf16_t* dn = BCN + (rowbase + t0) * 1024 + cb;
#pragma unroll
      for (int j = 0; j < 8; ++j) *(u32x4*)(dn + (size_t)j * 1024) = on[j];
      if (cb < 512) { const int g = cb >> 7, n0 = cb & 127;
        bf16_t* dt_ = BTT + ((size_t)(cidx * 4 + g) * 128 + n0) * 64 + tg * 8;
#pragma unroll
        for (int e = 0; e < 8; ++e) { u32x4 w = {op[e][0], op[e][1], op[e][2], op[e][3]}; *(u32x4*)(dt_ + e * 64) = w; }
      }
    }
  }
}

DI void ssd_item(const Params& P, LAS unsigned char* lds, int item) {
  unsigned char* ws = P.ws;
  int tid = threadIdx.x; asm volatile("" : "+v"(tid));
  const int wid = __builtin_amdgcn_readfirstlane(tid >> 6), lane = tid & 63, r16 = lane & 15, q = lane >> 4;
  const bool sample = item >= 128; const int i2 = sample ? item - 128 : item; const int b = i2 >> 3, g = (i2 >> 1) & 3, hh = i2 & 1;
  const int nch = sample ? 1 : 32;
  const size_t rowbase = sample ? (size_t)MP + b * 64 : (size_t)b * 2048;
  const int h = g * 8 + hh * 4 + (wid >> 1), ph = wid & 1, pb = ph * 32;
  const float A_h = -__expf(P.in[15][h]), dsk = P.in[16][h];
  const float* DT = (const float*)(ws + W_DT); const bf16_t* ZB = (const bf16_t*)(ws + W_ZB); bf16_t* Y3 = (bf16_t*)(ws + W_Y3); float* SSQP = (float*)(ws + W_SSQP);
  LAS unsigned char* Bs = lds; LAS unsigned char* Cs = lds + 17408; LAS unsigned char* BT = lds + 34816;
  LAS unsigned char* XT = lds + 53248 + wid * 4608;
  LAS float* acum_l = (LAS float*)(lds + 90112 + wid * 768); LAS float* dtv_l = acum_l + 64; LAS float* wend_l = acum_l + 128;
  f32x4 hT[8][2];
#pragma unroll
  for (int nt = 0; nt < 8; ++nt)
#pragma unroll
    for (int pt = 0; pt < 2; ++pt) {
      if (sample) hT[nt][pt] = *(const f32x4*)(P.in[6] + ((size_t)(b * 32 + h) * 64 + pb + pt * 16 + r16) * 128 + nt * 16 + 4 * q);
      else hT[nt][pt] = (f32x4){0.f, 0.f, 0.f, 0.f};
    }
  const bf16_t* XCT = (const bf16_t*)(ws + W_XCT); const bf16_t* BCN = (const bf16_t*)(ws + W_BCN); const bf16_t* BTT = (const bf16_t*)(ws + W_BTT);
  float dtl; u32x4 rx[4], rb[2], rc[2], rt[2];
#define SSD_LOAD(c_) do { const int t0_ = (c_) * 64; const int cidx_ = sample ? 512 + b : b * 32 + (c_);                         \
    dtl = DT[(rowbase + t0_ + lane) * 32 + h];                                                                                  \
    const bf16_t* xs_ = XCT + ((size_t)(cidx_ * 32 + h) * 64 + pb) * 64;                                                        \
    _Pragma("unroll") for (int j = 0; j < 4; ++j) rx[j] = *(const u32x4*)(xs_ + (j * 64 + lane) * 8);                           \
    const bf16_t* bts_ = BTT + (size_t)(cidx_ * 4 + g) * 8192;                                                                  \
    _Pragma("unroll") for (int j = 0; j < 2; ++j) { const int id = tid + 512 * j; const int s = id >> 4, k = id & 15;           \
      rb[j] = *(const u32x4*)(BCN + (rowbase + t0_ + s) * 1024 + g * 128 + k * 8);                                              \
      rc[j] = *(const u32x4*)(BCN + (rowbase + t0_ + s) * 1024 + 512 + g * 128 + k * 8);                                        \
      rt[j] = *(const u32x4*)(bts_ + id * 8); } } while (0)
  SSD_LOAD(0);
  for (int c = 0; c < nch; ++c) {
    const int t0 = c * 64;
    float cdec;
    { float ac = dtl * A_h;
#pragma unroll
      for (int o = 1; o < 64; o <<= 1) { const float t = __shfl_up(ac, o); if (lane >= o) ac += t; }
      const float tot = __shfl(ac, 63);
      acum_l[lane] = ac; dtv_l[lane] = dtl; wend_l[lane] = __expf(tot - ac) * dtl; cdec = __expf(tot); }
#pragma unroll
    for (int j = 0; j < 4; ++j) { const int e8 = j * 64 + lane; *(LAS u32x4*)(XT + (e8 >> 3) * 144 + (e8 & 7) * 16) = rx[j]; }
    __syncthreads();
#pragma unroll
    for (int j = 0; j < 2; ++j) { const int id = tid + 512 * j;
      *(LAS u32x4*)(Bs + (id >> 4) * 272 + (id & 15) * 16) = rb[j];
      *(LAS u32x4*)(Cs + (id >> 4) * 272 + (id & 15) * 16) = rc[j];
      *(LAS u32x4*)(BT + (id >> 3) * 144 + (id & 7) * 16) = rt[j]; }
    __syncthreads();
    if (c + 1 < nch) SSD_LOAD(c + 1);
    u32x2 znext[2];
#pragma unroll
    for (int pt = 0; pt < 2; ++pt) znext[pt] = *(const u32x2*)(ZB + (rowbase + t0 + r16) * 2048 + h * 64 + pb + pt * 16 + 4 * q);
#pragma unroll
    for (int lt = 0; lt < 4; ++lt) {
      const int l = lt * 16 + r16;
      const size_t row = rowbase + t0 + l;
      u32x2 zraw[2];
#pragma unroll
      for (int pt = 0; pt < 2; ++pt) zraw[pt] = znext[pt];
      { const int ln = (lt < 3 ? lt + 1 : 3) * 16 + r16;
#pragma unroll
        for (int pt = 0; pt < 2; ++pt) znext[pt] = *(const u32x2*)(ZB + (rowbase + t0 + ln) * 2048 + h * 64 + pb + pt * 16 + 4 * q); }
      f32x4 y[2];
#pragma unroll
      for (int pt = 0; pt < 2; ++pt) y[pt] = (f32x4){0.f, 0.f, 0.f, 0.f};
#pragma unroll
      for (int np = 0; np < 4; ++np) {
        const u32x2 clo = *(const LAS u32x2*)(Cs + l * 272 + (32 * np + 4 * q) * 2), chi = *(const LAS u32x2*)(Cs + l * 272 + (32 * np + 16 + 4 * q) * 2);
        const bf16x8 bfrag = cat8(clo, chi);
#pragma unroll
        for (int pt = 0; pt < 2; ++pt) y[pt] = MFMA16(pack8a(hT[2 * np][pt], hT[2 * np + 1][pt]), bfrag, y[pt]);
      }
      const float al = acum_l[l]; const float el = __expf(al);
#pragma unroll
      for (int pt = 0; pt < 2; ++pt) y[pt] *= el;
      const int nsp = (lt >> 1) + 1;
#pragma unroll
      for (int sp = 0; sp < nsp; ++sp) {
        f32x4 cb0 = {0.f, 0.f, 0.f, 0.f}, cb1 = {0.f, 0.f, 0.f, 0.f};
#pragma unroll
        for (int ks = 0; ks < 4; ++ks) {
          const bf16x8 cf = *(const LAS bf16x8*)(Cs + l * 272 + (32 * ks + 8 * q) * 2);
          const bf16x8 b0 = *(const LAS bf16x8*)(Bs + (32 * sp + r16) * 272 + (32 * ks + 8 * q) * 2);
          const bf16x8 b1 = *(const LAS bf16x8*)(Bs + (32 * sp + 16 + r16) * 272 + (32 * ks + 8 * q) * 2);
          cb0 = MFMA16(b0, cf, cb0); cb1 = MFMA16(b1, cf, cb1);
        }
        const int s0 = 32 * sp + 4 * q, s1 = s0 + 16;
        const f32x4 as0 = *(const LAS f32x4*)(acum_l + s0), as1 = *(const LAS f32x4*)(acum_l + s1);
        const f32x4 d0 = *(const LAS f32x4*)(dtv_l + s0), d1 = *(const LAS f32x4*)(dtv_l + s1);
        f32x4 m0, m1;
#pragma unroll
        for (int e = 0; e < 4; ++e) {
          m0[e] = (s0 + e <= l) ? cb0[e] * __expf(al - as0[e]) * d0[e] : 0.f;
          m1[e] = (s1 + e <= l) ? cb1[e] * __expf(al - as1[e]) * d1[e] : 0.f;
        }
        const bf16x8 mfrag = pack8a(m0, m1);
#pragma unroll
        for (int pt = 0; pt < 2; ++pt) { const int p = pt * 16 + r16;
          const u32x2 xlo = *(const LAS u32x2*)(XT + p * 144 + s0 * 2), xhi = *(const LAS u32x2*)(XT + p * 144 + s1 * 2);
          y[pt] = MFMA16(cat8(xlo, xhi), mfrag, y[pt]); }
      }
      float ssq = 0.f;
#pragma unroll
      for (int pt = 0; pt < 2; ++pt) { const int p0 = pt * 16 + 4 * q;
        const f32x4 zz = {bflo(zraw[pt][0]), bfhi(zraw[pt][0]), bflo(zraw[pt][1]), bfhi(zraw[pt][1])};
        f32x4 v;
#pragma unroll
        for (int e = 0; e < 4; ++e) { const float xv = bf2f(*(const LAS bf16_t*)(XT + (p0 + e) * 144 + l * 2));
          v[e] = (y[pt][e] + dsk * xv) * zz[e]; ssq += v[e] * v[e]; }
        st_bf4a(Y3 + row * 6144 + h * 64 + pb + p0, v); }
      ssq += __shfl_xor(ssq, 16); ssq += __shfl_xor(ssq, 32);
      if (q == 0) SSQP[row * 64 + h * 2 + ph] = ssq;
    }
#pragma unroll
    for (int nt = 0; nt < 8; ++nt)
#pragma unroll
      for (int pt = 0; pt < 2; ++pt) hT[nt][pt] *= cdec;
#pragma unroll
    for (int ks = 0; ks < 2; ++ks) {
      bf16x8 bfr[2];
      const f32x4 w0 = *(const LAS f32x4*)(wend_l + 32 * ks + 8 * q), w1 = *(const LAS f32x4*)(wend_l + 32 * ks + 8 * q + 4);
#pragma unroll
      for (int pt = 0; pt < 2; ++pt) { const int p = pt * 16 + r16;
        const u32x4 xr = *(const LAS u32x4*)(XT + p * 144 + (32 * ks + 8 * q) * 2);
        const f32x4 a = {bflo(xr[0]) * w0[0], bfhi(xr[0]) * w0[1], bflo(xr[1]) * w0[2], bfhi(xr[1]) * w0[3]};
        const f32x4 bq = {bflo(xr[2]) * w1[0], bfhi(xr[2]) * w1[1], bflo(xr[3]) * w1[2], bfhi(xr[3]) * w1[3]};
        bfr[pt] = pack8a(a, bq); }
#pragma unroll
      for (int nt = 0; nt < 8; ++nt) { const bf16x8 af = *(const LAS bf16x8*)(BT + (nt * 16 + r16) * 144 + (32 * ks + 8 * q) * 2);
#pragma unroll
        for (int pt = 0; pt < 2; ++pt) hT[nt][pt] = MFMA16(af, bfr[pt], hT[nt][pt]); }
    }
  }
#undef SSD_LOAD
  float* so = P.out + (sample ? O_SSDS : O_SSDP) + (size_t)(b * 32 + h) * 8192;
#pragma unroll
  for (int nt = 0; nt < 8; ++nt)
#pragma unroll
    for (int pt = 0; pt < 2; ++pt) *(f32x4*)(so + (size_t)(pb + pt * 16 + r16) * 128 + nt * 16 + 4 * q) = hT[nt][pt];
  __syncthreads();
}

__global__ __launch_bounds__(512) void mk_forward(Params Parg) {
#if defined(__HIP_DEVICE_COMPILE__)
  extern __shared__ __attribute__((aligned(16))) unsigned char lds_raw[];
  LAS unsigned char* lds = (LAS unsigned char*)lds_raw;
  cg::grid_group grid = cg::this_grid();
  const int G = gridDim.x, cblk = blockIdx.x;
  typedef __attribute__((address_space(4))) const Params* KP;
  const KP kp = (KP)__builtin_amdgcn_kernarg_segment_ptr();
#define PHASE_PARAMS() KP kq_ = kp; asm volatile("" : "+s"(kq_)); const Params P = *kq_; unsigned char* ws = P.ws; (void)ws
#ifndef PH
#define PH 255
#endif
#ifndef DUPMASK
#define DUPMASK 0
#endif
  for (int rep0_ = 0; rep0_ < ((DUPMASK & 1) ? 2 : 1); ++rep0_)
  if (PH & 1) { PHASE_PARAMS(); phase0(P, lds); }
  grid.sync();
  for (int rep_ = 0; rep_ < ((DUPMASK & 2) ? 2 : 1); ++rep_)
  if (PH & 2) { PHASE_PARAMS();
    SchedP1 S; S.c = cblk; S.G = G; S.XB = (const char*)(ws + W_XB); S.WIN = (const char*)(ws + W_WIN); S.MB = (const char*)(ws + W_MB); S.WMEM = (const char*)(ws + W_WMEM);
    EpiIn E; E.P = P; E.ldsb = lds; pg8::Gemm g; g.lda = 2048; g.ldb = 2048; g.K = 2048; g.delay = 0;
    pg8::gemm_phase(lds, g, S, E);
    if (cblk >= 58) p1_tail_convert(P, cblk - 58, 198); }
  grid.sync();
  { PHASE_PARAMS(); conv_pass(P); }
  grid.sync();
  for (int rep_ = 0; rep_ < 1; ++rep_) {
  if (cblk < 128) { PHASE_PARAMS(); ssd_item(P, lds, cblk); }
  else { PHASE_PARAMS();
    if (cblk < 192) ssd_item(P, lds, cblk);
    SchedS S; S.c = cblk - 128; S.G = 128; S.MQ = (const char*)(ws + W_MQ); S.MKP = (const char*)(ws + W_MKP); S.MKS = (const char*)(ws + W_MKS);
    EpiS E; E.P = P; pg8::Gemm g; g.lda = 2048; g.ldb = 2048; g.K = 512; g.delay = 0;
    pg8::gemm_phase(lds, g, S, E); }
  if (PH & 16) { PHASE_PARAMS(); unsigned* ctl = (unsigned*)(ws + W_CTL) + rep_ * 32;
    LAS char* l8 = (LAS char*)lds_raw;
    const int xcd = cblk & 7;
    int L = fetch_fox(ctl, l8, xcd, true);
    if (L < fa::NFOX) {
      fa::BlockRef cur = fa::fox_decode(P, L);
      fa::Seam S;
      fa::build_bias(cur.lf, cur.nkeys, l8);
      fa::fox_prime(cur, l8, S);
      for (;;) {
        const int Ln = fetch_fox(ctl, l8, xcd, false);
        fa::fox_block(cur, Ln, P, l8, S);
        if (Ln >= fa::NFOX) break;
        cur = fa::fox_decode(P, Ln);
        fa::build_bias(cur.lf, cur.nkeys, l8);
      }
    }
  }
  }
  grid.sync();
  for (int rep3_ = 0; rep3_ < ((DUPMASK & 32) ? 2 : 1); ++rep3_)
  if (PH & 32) { PHASE_PARAMS();
    { const float* SSQP = (const float*)(ws + W_SSQP); float* RS = (float*)(ws + W_RS);
      int tid = threadIdx.x; asm volatile("" : "+v"(tid));
      for (int r = cblk * 512 + tid; r < MT; r += G * 512) { float s = 0.f;
#pragma unroll
        for (int j = 0; j < 16; ++j) { const f32x4 v = *(const f32x4*)(SSQP + (size_t)r * 64 + 4 * j); s += (v[0] + v[1]) + (v[2] + v[3]); }
        RS[r] = rsqrtf(s * (1.f / 2048.f) + EPS); } }
    SchedPV S; S.c = cblk; S.G = G; S.PM = (const char*)(ws + W_PM); S.VTP = (const char*)(ws + W_VTP); S.VTS = (const char*)(ws + W_VTS);
    EpiPV E; E.P = P; pg8::Gemm g; g.lda = 1024; g.ldb = 256; g.K = 256; g.delay = 0;
    pg8::gemm_phase(lds, g, S, E); }
  grid.sync();
  for (int rep4_ = 0; rep4_ < ((DUPMASK & 64) ? 2 : 1); ++rep4_)
  if (PH & 64) { PHASE_PARAMS();
    SchedMerge S; S.c = cblk; S.G = G; S.A = (const char*)(ws + W_Y3); S.B = (const char*)(ws + W_WO);
    EpiMerge E; E.P = P; pg8::Gemm g; g.lda = 6144; g.ldb = 6144; g.K = 2048; g.delay = 0;
    pg8::gemm_phase(lds, g, S, E); }
  grid.sync();
  { PHASE_PARAMS(); const float* PARTM = (const float*)(ws + W_PARTM); bf16_t* MRG = (bf16_t*)(ws + W_MRG);
    int tid = threadIdx.x; asm volatile("" : "+v"(tid));
    for (int i = cblk * 512 + tid; i < MS * 2048 / 4; i += G * 512) {
      const f32x4 a = *(const f32x4*)(PARTM + (size_t)i * 4), b2 = *(const f32x4*)(PARTM + (size_t)MS * 2048 + (size_t)i * 4), c2 = *(const f32x4*)(PARTM + (size_t)2 * MS * 2048 + (size_t)i * 4);
      st_bf4(MRG + (size_t)MP * 2048 + (size_t)i * 4, a + b2 + c2); } }
  grid.sync();
  if (PH & 128) { PHASE_PARAMS();
    { SchedOutS S; S.c = cblk; S.A = (const char*)(ws + W_MRG); S.B = (const char*)(ws + W_WOUT);
      EpiOut E; E.P = P; pg8::Gemm g; g.lda = 2048; g.ldb = 2048; g.K = 512; g.delay = 0;
      pg8::gemm_phase(lds, g, S, E); }
    { SchedOutP S; S.c = cblk; S.A = (const char*)(ws + W_MRG); S.B = (const char*)(ws + W_WOUT);
      EpiOut E; E.P = P; pg8::Gemm g; g.lda = 2048; g.ldb = 2048; g.K = 2048; g.delay = 0;
      pg8::gemm_phase(lds, g, S, E); } }
  grid.sync();
  { PHASE_PARAMS();
    const float* PARTO = (const float*)(ws + W_PARTO); const float* gf = P.in[25];
    int tid = threadIdx.x; asm volatile("" : "+v"(tid)); const int wid = tid >> 6, lane = tid & 63;
    for (int r = cblk * 8 + wid; r < MT; r += G * 8) {
      f32x4* y = (f32x4*)(P.out + (size_t)r * 2048) + lane; const f32x4* gv = (const f32x4*)gf + lane;
      if (r < MP) {
        const float pv = lane < 32 ? PARTO[(size_t)r * 32 + lane] : 0.f;
        const float sc = rsqrtf(wave_sum(pv) * (1.f / 2048.f) + EPS);
#pragma unroll
        for (int j = 0; j < 8; ++j) { f32x4 v = y[64 * j]; const f32x4 gg = gv[64 * j]; y[64 * j] = v * sc * gg; }
      } else {
        const int rs = r - MP; const f32x4* xr = (const f32x4*)(P.in[1] + (size_t)rs * 2048) + lane;
        const f32x4* p5 = (const f32x4*)((const float*)(ws + W_PART5) + (size_t)rs * 2048) + lane;
        f32x4 v[8]; float ss = 0.f;
#pragma unroll
        for (int j = 0; j < 8; ++j) { v[j] = xr[64 * j];
#pragma unroll
          for (int kq = 0; kq < 4; ++kq) v[j] += p5[(size_t)kq * MS * 512 + 64 * j];
          ss += (v[j][0] * v[j][0] + v[j][1] * v[j][1]) + (v[j][2] * v[j][2] + v[j][3] * v[j][3]); }
        const float sc = rsqrtf(wave_sum(ss) * (1.f / 2048.f) + EPS);
#pragma unroll
        for (int j = 0; j < 8; ++j) y[64 * j] = v[j] * sc * gv[64 * j];
      }
    } }
#endif
}

extern "C" void kernel_launch(void* const* d_in, const int* in_sizes, int n_in,
                              void* d_out, int out_size, void* d_ws, size_t ws_size,
                              hipStream_t stream) {
  static int grid = 0;
  if (grid == 0) {
    int dev = 0, cus = 0, per_cu = 0;
    (void)hipGetDevice(&dev);
    (void)hipDeviceGetAttribute(&cus, hipDeviceAttributeMultiprocessorCount, dev);
    (void)hipFuncSetAttribute((const void*)mk_forward, hipFuncAttributeMaxDynamicSharedMemorySize, LDS_BYTES);
    (void)hipOccupancyMaxActiveBlocksPerMultiprocessor(&per_cu, (const void*)mk_forward, 512, LDS_BYTES);
    if (per_cu < 1) per_cu = 1;
    grid = cus * per_cu;
    if (ws_size < W_END) { fprintf(stderr, "workspace too small: %zu < %zu\n", ws_size, (size_t)W_END); grid = -1; }
  }
  if (grid < 0) return;
  Params p{};
  for (int i = 0; i < 26; ++i) p.in[i] = (const float*)d_in[i];
  p.out = (float*)d_out; p.ws = (unsigned char*)d_ws;
  void* args[] = {&p};
  hipError_t e = hipLaunchCooperativeKernel((const void*)mk_forward, dim3(grid), dim3(512), args, LDS_BYTES, stream);
  if (e != hipSuccess) fprintf(stderr, "cooperative launch failed: %s (grid %d)\n", hipGetErrorString(e), grid);
}
```

```cpp
#include <hip/hip_runtime.h>
#include <hip/hip_cooperative_groups.h>
#include <cstdio>
#include <cstdint>
namespace cg = cooperative_groups;

#define LAS __attribute__((address_space(3)))
#define DI __device__ __forceinline__
typedef unsigned short bf16_t;
typedef short bf16x8 __attribute__((ext_vector_type(8)));
typedef short s16x4 __attribute__((ext_vector_type(4)));
typedef float f32x4 __attribute__((ext_vector_type(4)));
typedef float f32x16 __attribute__((ext_vector_type(16)));
typedef unsigned u32x4 __attribute__((ext_vector_type(4)));
typedef unsigned u32x2 __attribute__((ext_vector_type(2)));

constexpr int DM = 2048;
constexpr int MP = 32768, MS = 512, MT = MP + MS, MPADR = MT + 256;
constexpr int NIN = 23808;
constexpr int LDS_BYTES = 147456;
constexpr float EPS = 1e-6f;

constexpr long O_YP = 0;
constexpr long O_YS = 67108864L;
constexpr long O_FKP = O_YS + 1048576L;
constexpr long O_FVP = O_FKP + 67108864L;
constexpr long O_FLP = O_FVP + 67108864L;
constexpr long O_SSDP = O_FLP + 524288L;
constexpr long O_CONVP = O_SSDP + 4194304L;
constexpr long O_MKP = O_CONVP + 147456L;
constexpr long O_MVP = O_MKP + 8388608L;
constexpr long O_FKS = O_MVP + 8388608L;
constexpr long O_FVS = O_FKS + 1048576L;
constexpr long O_FLS = O_FVS + 1048576L;
constexpr long O_SSDS = O_FLS + 8192L;
constexpr long O_CONVS = O_SSDS + 2097152L;

constexpr size_t al256(size_t x) { return (x + 255) & ~(size_t)255; }
constexpr size_t W_CTL = 0;
constexpr size_t W_R1 = 4096;
constexpr size_t W_RM = al256(W_R1 + (size_t)MT * 4);
constexpr size_t W_RS = al256(W_RM + 4096 * 4);
constexpr size_t W_XB = al256(W_RS + (size_t)MT * 4);
constexpr size_t W_MB = al256(W_XB + (size_t)MT * DM * 2);
constexpr size_t W_WIN = al256(W_MB + (size_t)4096 * DM * 2);
constexpr size_t W_WMEM = al256(W_WIN + (size_t)NIN * DM * 2);
constexpr size_t W_WO = al256(W_WMEM + (size_t)4096 * DM * 2);
constexpr size_t W_WOUT = al256(W_WO + (size_t)2048 * 6144 * 2);
constexpr size_t W_ZB = al256(W_WOUT + (size_t)2048 * 2048 * 2);
constexpr size_t W_XBCP = al256(W_ZB + (size_t)MT * DM * 2);
constexpr size_t W_XBCS = al256(W_XBCP + (size_t)16 * 2051 * 3072 * 2);
constexpr size_t W_DT = al256(W_XBCS + (size_t)8 * 67 * 3072 * 2);
constexpr size_t W_FQ = al256(W_DT + (size_t)MT * 32 * 4);
constexpr size_t W_FK = al256(W_FQ + (size_t)MPADR * DM * 2);
constexpr size_t W_FV = al256(W_FK + (size_t)MP * DM * 2);
constexpr size_t W_KS = al256(W_FV + (size_t)MP * DM * 2);
constexpr size_t W_VS = al256(W_KS + (size_t)8 * 1088 * DM * 2);
constexpr size_t W_FG = al256(W_VS + (size_t)8 * 1088 * DM * 2);
constexpr size_t W_MQ = al256(W_FG + (size_t)MPADR * DM * 2);
constexpr size_t W_MG = al256(W_MQ + (size_t)MPADR * DM * 2);
constexpr size_t W_G3 = al256(W_MG + (size_t)MT * DM * 2);
constexpr size_t W_LFT = al256(W_G3 + (size_t)MT * 6144 * 2);
constexpr size_t W_LFS = al256(W_LFT + (size_t)256 * 2048 * 4);
constexpr size_t W_MKP = al256(W_LFS + (size_t)128 * 1088 * 4);
constexpr size_t W_VTP = al256(W_MKP + (size_t)4096 * DM * 2);
constexpr size_t W_MKS = al256(W_VTP + (size_t)4096 * DM * 2);
constexpr size_t W_VTS = al256(W_MKS + (size_t)2048 * DM * 2);
constexpr size_t W_PM = al256(W_VTS + (size_t)2048 * DM * 2);
constexpr size_t W_PSUM = al256(W_PM + (size_t)MPADR * 1024 * 2);
constexpr size_t W_Y3 = al256(W_PSUM + (size_t)MT * 16 * 4);
constexpr size_t W_SSQP = al256(W_Y3 + (size_t)MT * 6144 * 2);
constexpr size_t W_MRG = al256(W_SSQP + (size_t)MT * 64 * 4);
constexpr size_t W_PARTO = al256(W_MRG + (size_t)MT * DM * 2);
constexpr size_t W_TMP = al256(W_PARTO + (size_t)MT * 32 * 4);
constexpr size_t W_PARTM = al256(W_TMP + (size_t)MT * DM * 4);
constexpr size_t W_PART5 = al256(W_PARTM + (size_t)3 * MS * DM * 4);
constexpr size_t W_XCT = al256(W_PART5 + (size_t)4 * MS * DM * 4);
constexpr size_t W_BCN = al256(W_XCT + (size_t)520 * 32 * 4096 * 2);
constexpr size_t W_BTT = al256(W_BCN + (size_t)MT * 1024 * 2);
constexpr size_t W_END = al256(W_BTT + (size_t)520 * 4 * 8192 * 2);

struct Params { const float* in[26]; float* out; unsigned char* ws; };

typedef __bf16 bf16x2_t __attribute__((ext_vector_type(2)));
typedef float f32x2_t __attribute__((ext_vector_type(2)));
DI unsigned pk2a(float lo, float hi) { unsigned r; asm volatile("v_cvt_pk_bf16_f32 %0, %1, %2" : "=v"(r) : "v"(lo), "v"(hi)); return r; }
DI unsigned pk2(float lo, float hi) { f32x2_t f = {lo, hi}; bf16x2_t v = __builtin_convertvector(f, bf16x2_t); return __builtin_bit_cast(unsigned, v); }
DI float bf2f(unsigned short b) { return __uint_as_float(((unsigned)b) << 16); }
DI float bflo(unsigned w) { return __uint_as_float(w << 16); }
DI float bfhi(unsigned w) { return __uint_as_float(w & 0xffff0000u); }
DI float sigmoidf_(float x) { return __builtin_amdgcn_rcpf(1.f + __builtin_amdgcn_exp2f(-1.4426950408889634f * x)); }
DI float siluf_(float x) { return x * __builtin_amdgcn_rcpf(1.f + __builtin_amdgcn_exp2f(-1.4426950408889634f * x)); }
DI float softplusf_(float x) { return x > 20.f ? x : log1pf(__expf(x)); }
DI float wave_sum(float v) {
#pragma unroll
  for (int o = 1; o < 64; o <<= 1) v += __shfl_xor(v, o);
  return v;
}
DI bf16x8 pack8(f32x4 a, f32x4 b) {
  u32x4 w = {pk2(a[0], a[1]), pk2(a[2], a[3]), pk2(b[0], b[1]), pk2(b[2], b[3])};
  return __builtin_bit_cast(bf16x8, w);
}
DI bf16x8 pack8a(f32x4 a, f32x4 b) {
  u32x4 w = {pk2a(a[0], a[1]), pk2a(a[2], a[3]), pk2a(b[0], b[1]), pk2a(b[2], b[3])};
  return __builtin_bit_cast(bf16x8, w);
}
DI bf16x8 cat8(u32x2 lo, u32x2 hi) { u32x4 w = {lo[0], lo[1], hi[0], hi[1]}; return __builtin_bit_cast(bf16x8, w); }
#define MFMA16(a, b, c) __builtin_amdgcn_mfma_f32_16x16x32_bf16((a), (b), (c), 0, 0, 0)

namespace pg8 {
constexpr int BM = 256, BK = 64, HALF = 128, HTB = HALF * BK * 2, STAGE_BYTES = 8 * HTB, NXCD = 8, WGM = 8;
DI int lds_byte(int r, int c) { const int st = (r >> 4) * 2 + (c >> 5), rr = r & 15, cc = c & 31, ob = rr * 64 + cc * 2; return st * 1024 + (ob ^ (((ob >> 9) & 1) << 5)); }
DI void stage_rc(int b, int& R, int& C) { const int st = b / 1024, sb = b % 1024, swz = sb ^ (((sb >> 9) & 1) << 5); R = (st >> 1) * 16 + swz / 64; C = (st & 1) * 32 + (swz % 64) / 2; }

struct Unit { const char* A; const char* B; int row0, col0, kind, nvalid, aux; };
struct Gemm { int lda, ldb, K; int delay; };

DI void tile_order(int L, int nM, int nN, int& pm, int& pn) {
  const int nwg = nM * nN; int wgid = L;
  { const int q = nwg / NXCD, r = nwg % NXCD, xcd = wgid % NXCD, off = wgid / NXCD; wgid = (xcd < r ? xcd * (q + 1) : r * (q + 1) + (xcd - r) * q) + off; }
  const int nig = WGM * nN, gid = wgid / nig, fm = gid * WGM, gsz = (nM - fm) < WGM ? (nM - fm) : WGM;
  pm = fm + ((wgid % nig) % gsz); pn = (wgid % nig) / gsz;
}

template <class Epi, class Sched>
DI void gemm_phase(LAS unsigned char* lds, const Gemm g, const Sched& S, const Epi& E) {
  int tid = threadIdx.x; asm volatile("" : "+v"(tid));
  const int wid = __builtin_amdgcn_readfirstlane(tid >> 6), lane = tid & 63, wr = wid >> 2, wc = wid & 3, fr = lane & 15, fq = lane >> 4;
  int K = g.K; asm volatile("" : "+s"(K));
  const int nt = K / BK;
  unsigned voffA[2], voffB[2];
#pragma unroll
  for (int i = 0; i < 2; ++i) { int R, C; stage_rc(tid * 16 + i * 8192, R, C);
    voffA[i] = (unsigned)(R * g.lda + C) * 2u; voffB[i] = (unsigned)(R * g.ldb + C) * 2u; }
  const size_t kstep = (size_t)(BK * 2);
  const size_t hstepA = (size_t)HALF * g.lda * 2, hstepB = (size_t)HALF * g.ldb * 2;
  const unsigned ldsw = (unsigned)wid * 1024u;
  const int aoff = lds_byte(wr * 64 + fr, fq * 8), boff = lds_byte(wc * 32 + fr, fq * 8);
#define PG8_SA(b, h) (((b) * 2 + (h)) * HTB)
#define PG8_SB(b, h) ((4 + (b) * 2 + (h)) * HTB)
#define PG8_STAGE(bufoff, gbase, voff) do { _Pragma("unroll") for (int _i = 0; _i < 2; ++_i) \
        __builtin_amdgcn_global_load_lds((const unsigned*)((const char*)(gbase) + (voff)[_i]), (LAS unsigned*)(lds + (bufoff) + ldsw + _i * 8192), 16, 0, 0); } while (0)
#define PG8_LDA(dst, b, h) do { _Pragma("unroll") for (int m = 0; m < 4; ++m) _Pragma("unroll") for (int k = 0; k < 2; ++k) dst[m][k] = *(const LAS bf16x8*)(lds + PG8_SA(b, h) + aoff + m * 2048 + k * 1024); } while (0)
#define PG8_LDB(dst, b, h) do { _Pragma("unroll") for (int n = 0; n < 2; ++n) _Pragma("unroll") for (int k = 0; k < 2; ++k) dst[n][k] = *(const LAS bf16x8*)(lds + PG8_SB(b, h) + boff + n * 2048 + k * 1024); } while (0)
#define PG8_MMA(ai, bj, At, Bt) do { __builtin_amdgcn_s_setprio(1); _Pragma("unroll") for (int m = 0; m < 4; ++m) _Pragma("unroll") for (int n = 0; n < 2; ++n) _Pragma("unroll") for (int k = 0; k < 2; ++k) \
        acc[ai][bj][m][n] = __builtin_amdgcn_mfma_f32_16x16x32_bf16(Bt[n][k], At[m][k], acc[ai][bj][m][n], 0, 0, 0); __builtin_amdgcn_s_setprio(0); } while (0)
#define PG8_WAIT_V(n) asm volatile("s_waitcnt vmcnt(" #n ")" ::: "memory")
#define PG8_WAIT_L(n) asm volatile("s_waitcnt lgkmcnt(" #n ")" ::: "memory")
#define PG8_BAR __builtin_amdgcn_s_barrier()
#define PG8_SCHED __builtin_amdgcn_sched_barrier(0)
  Unit cur, nxt; int ui = 0;
  if (!S.next(0, cur)) return;
  if (g.delay > 0) { const unsigned long long t0_ = __builtin_amdgcn_s_memrealtime(); while ((long long)(__builtin_amdgcn_s_memrealtime() - t0_) < (long long)g.delay) __builtin_amdgcn_s_sleep(16); }
  f32x4 acc[2][2][4][2];
#pragma unroll
  for (int a = 0; a < 2; ++a)
#pragma unroll
    for (int b = 0; b < 2; ++b)
#pragma unroll
      for (int m = 0; m < 4; ++m)
#pragma unroll
        for (int n = 0; n < 2; ++n) acc[a][b][m][n] = (f32x4){0.f, 0.f, 0.f, 0.f};
  bf16x8 At[4][2], B0[2][2], B1[2][2];
  const char* cA = cur.A; const char* cB = cur.B;
  PG8_STAGE(PG8_SB(0, 0), cB, voffB); PG8_STAGE(PG8_SA(0, 0), cA, voffA); PG8_STAGE(PG8_SB(0, 1), cB + hstepB, voffB); PG8_STAGE(PG8_SA(0, 1), cA + hstepA, voffA);
  if (wr == 1) PG8_BAR;
  PG8_WAIT_V(4); PG8_BAR;
  PG8_STAGE(PG8_SB(1, 0), cB + kstep, voffB); PG8_STAGE(PG8_SA(1, 0), cA + kstep, voffA); PG8_STAGE(PG8_SB(1, 1), cB + hstepB + kstep, voffB);
  PG8_WAIT_V(6); PG8_BAR;
  for (;;) {
    const bool has_next = S.next(ui + 1, nxt);
    const char* nA = has_next ? nxt.A : cA; const char* nB = has_next ? nxt.B : cB;
    for (int t = 0; t < nt; t += 2) {
      const bool last = (t == nt - 2);
      if constexpr (Epi::HOOK) { if (t == 32 || t == 64) E.rescale(acc, cur, t >> 5, wr, wc, fr, fq); }
      const char* a1 = cA + (size_t)(t + 1) * kstep;
      const char* a2 = last ? nA : cA + (size_t)(t + 2) * kstep; const char* b2 = last ? nB : cB + (size_t)(t + 2) * kstep;
      const char* a3 = a2 + kstep; const char* b3 = b2 + kstep;
      PG8_LDB(B0, 0, 0); PG8_SCHED; PG8_LDA(At, 0, 0); PG8_STAGE(PG8_SA(1, 1), a1 + hstepA, voffA);
      PG8_WAIT_L(8); PG8_BAR; PG8_WAIT_L(0); PG8_MMA(0, 0, At, B0); PG8_BAR; PG8_SCHED;
      PG8_LDB(B1, 0, 1); PG8_STAGE(PG8_SB(0, 0), b2, voffB);
      PG8_BAR; PG8_WAIT_L(0); PG8_MMA(0, 1, At, B1); PG8_BAR;
      PG8_LDA(At, 0, 1); PG8_STAGE(PG8_SA(0, 0), a2, voffA);
      PG8_BAR; PG8_WAIT_L(0); PG8_MMA(1, 0, At, B0); PG8_BAR; PG8_SCHED;
      PG8_STAGE(PG8_SB(0, 1), b2 + hstepB, voffB);
      PG8_WAIT_V(6); PG8_BAR; PG8_MMA(1, 1, At, B1); PG8_BAR;
      PG8_LDB(B0, 1, 0); PG8_SCHED; PG8_LDA(At, 1, 0); PG8_STAGE(PG8_SA(0, 1), a2 + hstepA, voffA);
      PG8_WAIT_L(8); PG8_BAR; PG8_WAIT_L(0); PG8_MMA(0, 0, At, B0); PG8_BAR; PG8_SCHED;
      PG8_LDB(B1, 1, 1); PG8_STAGE(PG8_SB(1, 0), b3, voffB);
      PG8_BAR; PG8_WAIT_L(0); PG8_MMA(0, 1, At, B1); PG8_BAR;
      PG8_LDA(At, 1, 1); PG8_STAGE(PG8_SA(1, 0), a3, voffA);
      PG8_BAR; PG8_WAIT_L(0); PG8_MMA(1, 0, At, B0); PG8_BAR; PG8_SCHED;
      PG8_STAGE(PG8_SB(1, 1), b3 + hstepB, voffB);
      PG8_WAIT_V(6); PG8_BAR; PG8_MMA(1, 1, At, B1); PG8_BAR;
    }
    E(acc, cur, wr, wc, fr, fq);
    if (!has_next) break;
#pragma unroll
    for (int a = 0; a < 2; ++a)
#pragma unroll
      for (int b = 0; b < 2; ++b)
#pragma unroll
        for (int m = 0; m < 4; ++m)
#pragma unroll
          for (int n = 0; n < 2; ++n) acc[a][b][m][n] = (f32x4){0.f, 0.f, 0.f, 0.f};
    cur = nxt; cA = nA; cB = nB; ++ui;
  }
  PG8_WAIT_V(0);
  if (wr == 0) PG8_BAR;
  PG8_BAR;
#undef PG8_SA
#undef PG8_SB
#undef PG8_STAGE
#undef PG8_LDA
#undef PG8_LDB
#undef PG8_MMA
#undef PG8_WAIT_V
#undef PG8_WAIT_L
#undef PG8_BAR
#undef PG8_SCHED
}
}
using pg8::Unit;
typedef const f32x4 (&AccRef)[2][2][4][2];

DI void st_bf4(bf16_t* p, f32x4 v) { u32x2 w = {pk2(v[0], v[1]), pk2(v[2], v[3])}; *(u32x2*)p = w; }
DI void st_bf4a(bf16_t* p, f32x4 v) { u32x2 w = {pk2a(v[0], v[1]), pk2a(v[2], v[3])}; *(u32x2*)p = w; }
DI f32x4 ld_bf4(const bf16_t* p) { u32x2 w = *(const u32x2*)p; return (f32x4){bflo(w[0]), bfhi(w[0]), bflo(w[1]), bfhi(w[1])}; }

struct EpiIn {
  static constexpr bool HOOK = false;
  Params P; LAS unsigned char* ldsb;
  DI void rescale(f32x4 (&)[2][2][4][2], const Unit&, int, int, int, int, int) const {}
  DI void operator()(AccRef acc, const Unit& u, int wr, int wc, int fr, int fq) const {
    unsigned char* ws = P.ws; float* out = P.out;
    if (u.kind == 1) {
      const bool isV = u.col0 >= 2048; const int cb = isV ? u.col0 - 2048 : u.col0;
      float* fo = out + (isV ? O_MVP : O_MKP);
      bf16_t* MKP = (bf16_t*)(ws + W_MKP); bf16_t* VTP = (bf16_t*)(ws + W_VTP);
#pragma unroll
      for (int ai = 0; ai < 2; ++ai)
#pragma unroll
        for (int m = 0; m < 4; ++m) {
          const int row = u.row0 + ai * 128 + wr * 64 + m * 16 + fr;
#pragma unroll
          for (int bj = 0; bj < 2; ++bj)
#pragma unroll
            for (int n = 0; n < 2; ++n) {
              const int c = cb + bj * 128 + wc * 32 + n * 16 + 4 * fq;
              const f32x4 v = acc[ai][bj][m][n];
              *(f32x4*)(fo + (size_t)row * 2048 + c) = v;
              if (!isV) st_bf4(MKP + (size_t)row * 2048 + c, v);
              else { const int b = row >> 8, key = row & 255, h = c >> 9, d = c & 511;
                bf16_t* vt = VTP + ((size_t)((b * 4 + h) * 512 + d)) * 256 + key;
                const unsigned w0 = pk2(v[0], v[1]), w1 = pk2(v[2], v[3]);
                vt[0] = (bf16_t)(w0 & 0xffff); vt[256] = (bf16_t)(w0 >> 16); vt[512] = (bf16_t)(w1 & 0xffff); vt[768] = (bf16_t)(w1 >> 16); }
            }
        }
      return;
    }
    const bool sample = u.row0 >= MP;
    const int T = sample ? 64 : 2048;
    const int col0 = u.col0;
    if (col0 >= 23552) {
      if (wc > 1) return;
      const float* dtb = P.in[14]; const float* bfg = P.in[18];
      float* DT = (float*)(ws + W_DT);
      float* LFT = (float*)(ws + W_LFT); float* LFS = (float*)(ws + W_LFS);
#pragma unroll
      for (int ai = 0; ai < 2; ++ai)
#pragma unroll
        for (int m = 0; m < 4; ++m) {
          const int row = u.row0 + ai * 128 + wr * 64 + m * 16 + fr;
          const int rs = row - MP; const int b = sample ? (rs >> 6) : (row >> 11), t = sample ? (rs & 63) : (row & 2047);
#pragma unroll
          for (int n = 0; n < 2; ++n) {
            const int c = wc * 32 + n * 16 + 4 * fq;
            const f32x4 v = acc[ai][0][m][n];
            if (c < 32) { f32x4 o;
#pragma unroll
              for (int e = 0; e < 4; ++e) o[e] = softplusf_(v[e] + dtb[c + e]);
              *(f32x4*)(DT + (size_t)row * 32 + c) = o; }
            else if (c < 48) { const int h0 = c - 32; f32x4 o;
#pragma unroll
              for (int e = 0; e < 4; ++e) o[e] = -softplusf_(-(v[e] + bfg[h0 + e]));
              float* lo = sample ? out + O_FLS + (size_t)rs * 16 + h0 : out + O_FLP + (size_t)row * 16 + h0;
              *(f32x4*)lo = o;
#pragma unroll
              for (int e = 0; e < 4; ++e) { if (sample) LFS[(size_t)(b * 16 + h0 + e) * 1088 + 1024 + t] = o[e]; else LFT[(size_t)(b * 16 + h0 + e) * 2048 + t] = o[e]; }
            }
          }
        }
      return;
    }
    const bool smp = sample;
    if (col0 < 2048) seg_store<1, 0, false, false>(acc, u, wr, wc, fr, fq, (bf16_t*)(ws + W_ZB), 2048, col0, nullptr, nullptr, smp);
    else if (col0 < 5120) seg_store<0, 1, false, true>(acc, u, wr, wc, fr, fq, (bf16_t*)(ws + (smp ? W_XBCS : W_XBCP)), 3072, col0 - 2048, nullptr, out + (smp ? O_CONVS : O_CONVP), smp);
    else if (col0 < 7168) seg_store<0, 0, false, false>(acc, u, wr, wc, fr, fq, (bf16_t*)(ws + W_FQ), 2048, col0 - 5120, nullptr, nullptr, smp);
    else if (col0 < 9216) seg_store<0, 2, true, false>(acc, u, wr, wc, fr, fq, (bf16_t*)(ws + (smp ? W_KS : W_FK)), 2048, col0 - 7168, out + (smp ? O_FKS : O_FKP), nullptr, smp);
    else if (col0 < 11264) seg_store<0, 2, true, false>(acc, u, wr, wc, fr, fq, (bf16_t*)(ws + (smp ? W_VS : W_FV)), 2048, col0 - 9216, out + (smp ? O_FVS : O_FVP), nullptr, smp);
    else if (col0 < 13312) seg_store<1, 0, false, false>(acc, u, wr, wc, fr, fq, (bf16_t*)(ws + W_FG), 2048, col0 - 11264, nullptr, nullptr, smp);
    else if (col0 < 15360) seg_store<0, 0, false, false>(acc, u, wr, wc, fr, fq, (bf16_t*)(ws + W_MQ), 2048, col0 - 13312, nullptr, nullptr, smp);
    else if (col0 < 17408) seg_store<1, 0, false, false>(acc, u, wr, wc, fr, fq, (bf16_t*)(ws + W_MG), 2048, col0 - 15360, nullptr, nullptr, smp);
    else seg_store<2, 0, false, false>(acc, u, wr, wc, fr, fq, (bf16_t*)(ws + W_G3), 6144, col0 - 17408, nullptr, nullptr, smp);
  }
  template <int ACT, int ROWMODE, bool HASF, bool HASCONV>
  DI void seg_store(AccRef acc, const Unit& u, int wr, int wc, int fr, int fq, bf16_t* dst, int ld, int c0, float* fout, float* convout, bool sample) const {
    const int T = sample ? 64 : 2048;
    const int cl = c0 + wc * 32 + 4 * fq;
    const int lane = fr + 16 * fq, wid = wr * 4 + wc;
    LAS unsigned char* stg = ldsb + 131072 + wid * 1280;
    const int rS = lane >> 2, cS = (lane & 3) * 8;
#pragma unroll
    for (int ai = 0; ai < 2; ++ai)
#pragma unroll
      for (int m = 0; m < 4; ++m) {
        const int row = u.row0 + ai * 128 + wr * 64 + m * 16 + fr;
        const int rs = row - MP; const int b = sample ? (rs >> 6) : (row >> 11), t = sample ? (rs & 63) : (row & 2047);
        float* fp = HASF ? fout + (sample ? (size_t)rs : (size_t)row) * 2048 + cl : nullptr;
        const bool ctail = HASCONV && t >= T - 3;
        float* cp = HASCONV ? convout + (size_t)(b * 3 + t - (T - 3)) * 3072 + cl : nullptr;
        const int rowS = u.row0 + ai * 128 + wr * 64 + m * 16 + rS;
        size_t drow = (size_t)rowS;
        if (ROWMODE != 0) { const int rsS = rowS - MP; const int bS = sample ? (rsS >> 6) : (rowS >> 11), tS = sample ? (rsS & 63) : (rowS & 2047);
          if (ROWMODE == 1) drow = sample ? (size_t)(bS * 67 + 3 + tS) : (size_t)(bS * 2051 + 3 + tS);
          else drow = sample ? (size_t)(bS * 1088 + 1024 + tS) : (size_t)rowS; }
        bf16_t* dp = dst + drow * ld + c0 + wc * 32 + cS;
#pragma unroll
        for (int bj = 0; bj < 2; ++bj) {
#pragma unroll
          for (int n = 0; n < 2; ++n) {
            const int co = bj * 128 + n * 16;
            f32x4 v = acc[ai][bj][m][n];
            if (HASF) *(f32x4*)(fp + co) = v;
            if (HASCONV) { if (ctail) *(f32x4*)(cp + co) = v; }
            if (ACT == 1) {
#pragma unroll
              for (int e = 0; e < 4; ++e) v[e] = siluf_(v[e]);
            } else if (ACT == 2) {
#pragma unroll
              for (int e = 0; e < 4; ++e) v[e] = sigmoidf_(v[e]);
            }
            u32x2 w = {pk2(v[0], v[1]), pk2(v[2], v[3])};
            *(LAS u32x2*)(stg + fr * 80 + n * 32 + fq * 8) = w;
          }
          const u32x4 o = *(const LAS u32x4*)(stg + rS * 80 + cS * 2);
          *(u32x4*)(dp + bj * 128) = o;
        }
      }
  }
};
struct SchedP1 {
  int c, G; const char* XB; const char* WIN; const char* MB; const char* WMEM;
  DI bool next(int i, Unit& u) const {
    const int L = i * G + c;
    constexpr int N1 = 130 * 93;
    if (L < N1) { int pm, pn; pg8::tile_order(L, 130, 93, pm, pn);
      u.A = XB + (size_t)pm * 256 * 2048 * 2; u.B = WIN + (size_t)pn * 256 * 2048 * 2; u.row0 = pm * 256; u.col0 = pn * 256; u.kind = 0; u.nvalid = 256; u.aux = 0; return true; }
    const int L2 = L - N1; if (L2 >= 256) return false;
    int pm, pn; pg8::tile_order(L2, 16, 16, pm, pn);
    u.A = MB + (size_t)pm * 256 * 2048 * 2; u.B = WMEM + (size_t)pn * 256 * 2048 * 2; u.row0 = pm * 256; u.col0 = pn * 256; u.kind = 1; u.nvalid = 256; u.aux = 0; return true;
  }
};

struct EpiS {
  static constexpr bool HOOK = false;
  Params P;
  DI void rescale(f32x4 (&)[2][2][4][2], const Unit&, int, int, int, int, int) const {}
  DI void operator()(AccRef acc, const Unit& u, int wr, int wc, int fr, int fq) const {
    bf16_t* PM = (bf16_t*)(P.ws + W_PM); float* PSUM = (float*)(P.ws + W_PSUM);
    const float c2 = 0.044194173824159216f * 1.4426950408889634f;
    const int h = u.aux;
#pragma unroll
    for (int ai = 0; ai < 2; ++ai)
#pragma unroll
      for (int m = 0; m < 4; ++m) {
        const int rr = ai * 128 + wr * 64 + m * 16 + fr; const int row = u.row0 + rr; const bool ok = rr < u.nvalid;
        float s = 0.f;
#pragma unroll
        for (int bj = 0; bj < 2; ++bj)
#pragma unroll
          for (int n = 0; n < 2; ++n) {
            const int c = bj * 128 + wc * 32 + n * 16 + 4 * fq;
            f32x4 e;
#pragma unroll
            for (int k = 0; k < 4; ++k) { e[k] = __builtin_amdgcn_exp2f(fminf(acc[ai][bj][m][n][k] * c2, 100.f)); s += e[k]; }
            if (ok) st_bf4(PM + (size_t)row * 1024 + h * 256 + c, e);
          }
        s += __shfl_xor(s, 16); s += __shfl_xor(s, 32);
        if (ok && fq == 0) PSUM[(size_t)row * 16 + h * 4 + wc] = s;
      }
  }
};
struct SchedS {
  int c, G; const char* MQ; const char* MKP; const char* MKS;
  DI bool next(int i, Unit& u) const {
    const int L = i * G + c; if (L >= 544) return false;
    u.col0 = 0; u.kind = 0;
    if (L < 512) { const int b = L >> 5, h = (L >> 3) & 3, mt = L & 7; u.row0 = b * 2048 + mt * 256; u.nvalid = 256; u.aux = h;
      u.A = MQ + ((size_t)u.row0 * 2048 + h * 512) * 2; u.B = MKP + ((size_t)(b * 256) * 2048 + h * 512) * 2; }
    else { const int j = L - 512, b = j >> 2, h = j & 3; u.row0 = MP + b * 64; u.nvalid = 64; u.aux = h;
      u.A = MQ + ((size_t)u.row0 * 2048 + h * 512) * 2; u.B = MKS + ((size_t)(b * 256) * 2048 + h * 512) * 2; }
    return true;
  }
};
struct EpiPV {
  static constexpr bool HOOK = false;
  Params P;
  DI void rescale(f32x4 (&)[2][2][4][2], const Unit&, int, int, int, int, int) const {}
  DI void operator()(AccRef acc, const Unit& u, int wr, int wc, int fr, int fq) const {
    const float* PSUM = (const float*)(P.ws + W_PSUM); const bf16_t* MG = (const bf16_t*)(P.ws + W_MG); bf16_t* Y3 = (bf16_t*)(P.ws + W_Y3);
    const int h = u.aux >> 9;
#pragma unroll
    for (int ai = 0; ai < 2; ++ai)
#pragma unroll
      for (int m = 0; m < 4; ++m) {
        int rr = ai * 128 + wr * 64 + m * 16 + fr; asm volatile("" : "+v"(rr)); const int row = u.row0 + rr;
        if (!(m & 1)) __builtin_amdgcn_sched_barrier(0);
        if (rr < u.nvalid) {
          const f32x4 ps = *(const f32x4*)(PSUM + (size_t)row * 16 + h * 4);
          const float inv = 1.f / ((ps[0] + ps[1]) + (ps[2] + ps[3]));
#pragma unroll
          for (int bj = 0; bj < 2; ++bj)
#pragma unroll
            for (int n = 0; n < 2; ++n) {
              const int c = u.aux + bj * 128 + wc * 32 + n * 16 + 4 * fq;
              const f32x4 gte = ld_bf4(MG + (size_t)row * 2048 + c);
              st_bf4(Y3 + (size_t)row * 6144 + 4096 + c, acc[ai][bj][m][n] * gte * inv);
            }
        }
      }
  }
};
struct SchedPV {
  int c, G; const char* PM; const char* VTP; const char* VTS;
  DI bool next(int i, Unit& u) const {
    const int L = i * G + c; if (L >= 1088) return false;
    u.col0 = 0; u.kind = 0;
    if (L < 1024) { const int b = L >> 6, h = (L >> 4) & 3, mt = (L >> 1) & 7, n2 = L & 1; u.row0 = b * 2048 + mt * 256; u.nvalid = 256; u.aux = h * 512 + n2 * 256;
      u.A = PM + ((size_t)u.row0 * 1024 + h * 256) * 2; u.B = VTP + ((size_t)((b * 4 + h) * 512 + n2 * 256) * 256) * 2; }
    else { const int j = L - 1024, b = j >> 3, h = (j >> 1) & 3, n2 = j & 1; u.row0 = MP + b * 64; u.nvalid = 64; u.aux = h * 512 + n2 * 256;
      u.A = PM + ((size_t)u.row0 * 1024 + h * 256) * 2; u.B = VTS + ((size_t)((b * 4 + h) * 512 + n2 * 256) * 256) * 2; }
    return true;
  }
};

struct EpiMerge {
  static constexpr bool HOOK = false;
  Params P;
  DI void rescale(f32x4 (&)[2][2][4][2], const Unit&, int, int, int, int, int) const {}
  DI void operator()(AccRef acc, const Unit& u, int wr, int wc, int fr, int fq) const {
    const bf16_t* G3 = (const bf16_t*)(P.ws + W_G3); bf16_t* MRG = (bf16_t*)(P.ws + W_MRG); bf16_t* TMP = (bf16_t*)(P.ws + W_TMP);
    float* PARTM = (float*)(P.ws + W_PARTM);
    const float* RS = (const float*)(P.ws + W_RS);
    const int seg = u.kind >= 3 ? u.kind - 3 : u.kind; const bool part = u.kind >= 3;
#pragma unroll
    for (int ai = 0; ai < 2; ++ai)
#pragma unroll
      for (int m = 0; m < 4; ++m) {
        int row = u.row0 + ai * 128 + wr * 64 + m * 16 + fr; asm volatile("" : "+v"(row));
        const float rs = (seg == 0) ? RS[row] : 1.f;
#pragma unroll
        for (int bj = 0; bj < 2; ++bj)
#pragma unroll
          for (int n = 0; n < 2; ++n) {
            const int c = u.col0 + bj * 128 + wc * 32 + n * 16 + 4 * fq;
            const f32x4 gte = ld_bf4(G3 + (size_t)row * 6144 + seg * 2048 + c);
            f32x4 v = acc[ai][bj][m][n] * gte * rs;
            const size_t to = (size_t)row * 2048 + c;
            if (part) { *(f32x4*)(PARTM + ((size_t)seg * MS + (row - MP)) * 2048 + c) = v; }
            else {
              if (seg > 0) v += ld_bf4(TMP + to);
              if (seg < 2) st_bf4(TMP + to, v); else st_bf4(MRG + to, v);
            }
          }
        if (m & 1) __builtin_amdgcn_sched_barrier(0);
      }
  }
};
struct SchedMerge {
  int c, G; const char* A; const char* B;
  DI bool next(int i, Unit& u) const {
    int pm, pn, seg, kind;
    if (i < 12) { const int ti = i / 3; seg = i - ti * 3; const int L = ti * 256 + c; pm = (L >> 6) * 8 + (L & 7); pn = (L >> 3) & 7; kind = seg; }
    else if (i == 12 && c < 48) { const int e = c / 3; seg = c - e * 3; pm = 128 + (e >> 3); pn = e & 7; kind = 3 + seg; }
    else return false;
    u.A = A + ((size_t)pm * 256 * 6144 + seg * 2048) * 2; u.B = B + ((size_t)pn * 256 * 6144 + seg * 2048) * 2; u.row0 = pm * 256; u.col0 = pn * 256; u.kind = kind; u.nvalid = 256; u.aux = pn; return true;
  }
};
struct SchedOutP {
  int c; const char* A; const char* B;
  DI bool next(int i, Unit& u) const {
    if (i >= 4) return false;
    const int L = i * 256 + c; const int pm = (L >> 6) * 8 + (L & 7), pn = (L >> 3) & 7;
    u.A = A + (size_t)pm * 256 * 2048 * 2; u.B = B + (size_t)pn * 256 * 2048 * 2; u.row0 = pm * 256; u.col0 = pn * 256; u.kind = 0; u.nvalid = 256; u.aux = pn; return true;
  }
};
struct SchedOutS {
  int c; const char* A; const char* B;
  DI bool next(int i, Unit& u) const {
    if (i >= 1 || c >= 64) return false;
    const int e = c >> 2, kq = c & 3; const int pm = 128 + (e >> 3), pn = e & 7;
    u.A = A + ((size_t)pm * 256 * 2048 + kq * 512) * 2; u.B = B + ((size_t)pn * 256 * 2048 + kq * 512) * 2; u.row0 = pm * 256; u.col0 = pn * 256; u.kind = 1; u.nvalid = kq; u.aux = pn; return true;
  }
};
struct SchedTile {
  int c, G, nM, nN; const char* A; const char* B; size_t astep, bstep;
  DI bool next(int i, Unit& u) const {
    const int L = i * G + c; if (L >= nM * nN) return false;
    int pm, pn; pg8::tile_order(L, nM, nN, pm, pn);
    u.A = A + (size_t)pm * astep; u.B = B + (size_t)pn * bstep; u.row0 = pm * 256; u.col0 = pn * 256; u.kind = 0; u.nvalid = 256; u.aux = pn; return true;
  }
};
struct EpiOut {
  static constexpr bool HOOK = false;
  Params P;
  DI void rescale(f32x4 (&)[2][2][4][2], const Unit&, int, int, int, int, int) const {}
  DI void operator()(AccRef acc, const Unit& u, int wr, int wc, int fr, int fq) const {
    float* out = P.out; float* PARTO = (float*)(P.ws + W_PARTO);
    if (u.kind == 1) {
      float* PART5 = (float*)(P.ws + W_PART5) + (size_t)u.nvalid * MS * 2048;
#pragma unroll
      for (int ai = 0; ai < 2; ++ai)
#pragma unroll
        for (int m = 0; m < 4; ++m) {
          const int row = u.row0 + ai * 128 + wr * 64 + m * 16 + fr - MP;
#pragma unroll
          for (int bj = 0; bj < 2; ++bj)
#pragma unroll
            for (int n = 0; n < 2; ++n) *(f32x4*)(PART5 + (size_t)row * 2048 + u.col0 + bj * 128 + wc * 32 + n * 16 + 4 * fq) = acc[ai][bj][m][n];
        }
      return;
    }
    const float* xin = P.in[0];
#pragma unroll
    for (int ai = 0; ai < 2; ++ai)
#pragma unroll
      for (int m = 0; m < 4; ++m) {
        const int row = u.row0 + ai * 128 + wr * 64 + m * 16 + fr;
        float s = 0.f;
#pragma unroll
        for (int bj = 0; bj < 2; ++bj)
#pragma unroll
          for (int n = 0; n < 2; ++n) {
            const int c = u.col0 + bj * 128 + wc * 32 + n * 16 + 4 * fq;
            const f32x4 xo = acc[ai][bj][m][n] + *(const f32x4*)(xin + (size_t)row * 2048 + c);
            *(f32x4*)(out + (size_t)row * 2048 + c) = xo;
            s += xo[0] * xo[0] + xo[1] * xo[1] + xo[2] * xo[2] + xo[3] * xo[3];
          }
        s += __shfl_xor(s, 16); s += __shfl_xor(s, 32);
        if (fq == 0) PARTO[(size_t)row * 32 + u.aux * 4 + wc] = s;
      }
  }
};

DI void row_to_bf16(const float* src, bf16_t* dst, float* rs, int lane) {
  const f32x4* s = (const f32x4*)src + lane; f32x4 v[8]; float ss = 0.f;
#pragma unroll
  for (int j = 0; j < 8; ++j) { v[j] = s[64 * j]; ss += (v[j][0] * v[j][0] + v[j][1] * v[j][1]) + (v[j][2] * v[j][2] + v[j][3] * v[j][3]); }
  float sc = 1.f;
  if (rs) { ss = wave_sum(ss); sc = rsqrtf(ss * (1.f / 2048.f) + EPS); }
  u32x2* d = (u32x2*)dst + lane;
#pragma unroll
  for (int j = 0; j < 8; ++j) { u32x2 w = {pk2(v[j][0] * sc, v[j][1] * sc), pk2(v[j][2] * sc, v[j][3] * sc)}; d[64 * j] = w; }
}
DI void transpose_item(const float* W, int ldw, int scol0, int nvalid, const float* scale, bf16_t* WT, int ldd, int drow0, int dcol0, int kb, LAS float* scr, int lane) {
  const int k0 = 64 * kb;
  float tv[32];
  const bool ok_ = (lane & 31) < nvalid;
#pragma unroll
  for (int i = 0; i < 32; ++i) { const int kk = 2 * i + (lane >> 5); tv[i] = ok_ ? W[(size_t)(k0 + kk) * ldw + scol0 + (lane & 31)] : 0.f; }
#pragma unroll
  for (int i = 0; i < 32; ++i) { const int kk = 2 * i + (lane >> 5), n = lane & 31;
    float v = tv[i]; if (scale) v *= scale[k0 + kk];
    scr[kk * 33 + n] = v; }
  asm volatile("s_waitcnt lgkmcnt(0)" ::: "memory");
  const int c = lane & 7;
#pragma unroll
  for (int j = 0; j < 4; ++j) { const int n = (lane >> 3) + 8 * j; const LAS float* s = scr + (8 * c) * 33 + n;
    u32x4 o; o[0] = pk2(s[0 * 33], s[1 * 33]); o[1] = pk2(s[2 * 33], s[3 * 33]); o[2] = pk2(s[4 * 33], s[5 * 33]); o[3] = pk2(s[6 * 33], s[7 * 33]);
    *(u32x4*)(WT + (size_t)(drow0 + n) * ldd + dcol0 + k0 + 8 * c) = o; }
  asm volatile("s_waitcnt lgkmcnt(0)" ::: "memory");
}
DI void phase0(const Params& P, LAS unsigned char* lds) {
  unsigned char* ws = P.ws;
  int tid = threadIdx.x; asm volatile("" : "+v"(tid));
  const int wid = tid >> 6, lane = tid & 63;
  const int gw = blockIdx.x * 8 + wid, NGW = gridDim.x * 8;
  if (blockIdx.x == 0 && tid < 64) ((unsigned*)(ws + W_CTL))[tid] = 0u;
  constexpr int NR = MT + 4096 + 8192;
  for (int r = gw; r < NR; r += NGW) {
    if (r < MP) row_to_bf16(P.in[0] + (size_t)r * 2048, (bf16_t*)(ws + W_XB) + (size_t)r * 2048, (float*)(ws + W_R1), lane);
    else if (r < MT) row_to_bf16(P.in[1] + (size_t)(r - MP) * 2048, (bf16_t*)(ws + W_XB) + (size_t)r * 2048, (float*)(ws + W_R1), lane);
    else if (r < MT + 4096) { const int q = r - MT; row_to_bf16(P.in[2] + (size_t)q * 2048, (bf16_t*)(ws + W_MB) + (size_t)q * 2048, (float*)(ws + W_RM), lane); }
    else if (r < MT + 4096 + 8192) { const int q = r - MT - 4096, b = q >> 10, j = q & 1023; row_to_bf16(P.in[3] + (size_t)q * 2048, (bf16_t*)(ws + W_KS) + (size_t)(b * 1088 + j) * 2048, nullptr, lane); }
    else if (r < MT + 4096 + 16384) { continue; }
    else { continue; }
  }
  LAS float* scr = (LAS float*)(lds + wid * 8448);
  constexpr int I_IN = 744 * 32, I_MEM = 128 * 32, I_O = 64 * 32;
  constexpr int NITEMS = I_IN + I_MEM + 4 * I_O;
  for (int it = gw; it < NITEMS; it += NGW) {
    int r = it;
    if (r < I_IN) { const int nb = r >> 5, kb = r & 31, d = nb * 32; int src, nv = 32;
      if (d < 5120) src = d; else if (d < 13312) src = d + 32; else if (d < 23552) src = d + 48;
      else if (d == 23552) src = 5120; else if (d == 23584) { src = 13344; nv = 16; } else { src = 0; nv = 0; }
      transpose_item(P.in[11], 23600, src, nv, P.in[10], (bf16_t*)(ws + W_WIN), 2048, d, 0, kb, scr, lane); continue; }
    r -= I_IN;
    if (r < I_MEM) { const int nb = r >> 5, kb = r & 31; transpose_item(P.in[20], 4096, nb * 32, 32, P.in[19], (bf16_t*)(ws + W_WMEM), 2048, nb * 32, 0, kb, scr, lane); continue; }
    r -= I_MEM;
    if (r < I_O) { const int nb = r >> 5, kb = r & 31; transpose_item(P.in[21], 2048, nb * 32, 32, P.in[17], (bf16_t*)(ws + W_WO), 6144, nb * 32, 0, kb, scr, lane); continue; }
    r -= I_O;
    if (r < I_O) { const int nb = r >> 5, kb = r & 31; transpose_item(P.in[22], 2048, nb * 32, 32, nullptr, (bf16_t*)(ws + W_WO), 6144, nb * 32, 2048, kb, scr, lane); continue; }
    r -= I_O;
    if (r < I_O) { const int nb = r >> 5, kb = r & 31; transpose_item(P.in[23], 2048, nb * 32, 32, nullptr, (bf16_t*)(ws + W_WO), 6144, nb * 32, 4096, kb, scr, lane); continue; }
    r -= I_O;
    { const int nb = r >> 5, kb = r & 31; transpose_item(P.in[24], 2048, nb * 32, 32, nullptr, (bf16_t*)(ws + W_WOUT), 2048, nb * 32, 0, kb, scr, lane); }
  }
  const long gt = (long)blockIdx.x * 512 + tid, NT = (long)gridDim.x * 512;
  for (long i = gt; i < 8L * 1024 * 16; i += NT) { const int h = (int)(i & 15), j = (int)((i >> 4) & 1023), b = (int)(i >> 14);
    ((float*)(ws + W_LFS))[(size_t)(b * 16 + h) * 1088 + j] = P.in[5][i]; }
  for (long i = gt; i < 8L * 3 * 3072; i += NT) { const int c = (int)(i % 3072), r = (int)((i / 3072) % 3), b = (int)(i / 9216);
    ((bf16_t*)(ws + W_XBCS))[(size_t)(b * 67 + r) * 3072 + c] = (bf16_t)(pk2(P.in[7][i], 0.f) & 0xffff); }
  for (long i = gt; i < 16L * 3 * 3072; i += NT) { const int c = (int)(i % 3072), r = (int)((i / 3072) % 3), b = (int)(i / 9216);
    ((bf16_t*)(ws + W_XBCP))[(size_t)(b * 2051 + r) * 3072 + c] = 0; }
}

DI void p1_tail_convert(const Params& P, int part, int nparts) {
  unsigned char* ws = P.ws;
  int tid = threadIdx.x; asm volatile("" : "+v"(tid));
  const int wid = tid >> 6, lane = tid & 63;
  for (int q = part * 8 + wid; q < 8192; q += nparts * 8) { const int b = q >> 10, j = q & 1023;
    row_to_bf16(P.in[4] + (size_t)q * 2048, (bf16_t*)(ws + W_VS) + (size_t)(b * 1088 + j) * 2048, nullptr, lane); }
  for (int q = part * 8 + wid; q < 2048; q += nparts * 8) row_to_bf16(P.in[8] + (size_t)q * 2048, (bf16_t*)(ws + W_MKS) + (size_t)q * 2048, nullptr, lane);
  const long gt = (long)part * 512 + tid, NT = (long)nparts * 512;
  for (long i = gt; i < 8L * 32 * 2048; i += NT) {
    const int hd = (int)(i & 2047), kg = (int)((i >> 11) & 31), b = (int)(i >> 16);
    const float* s = P.in[9] + ((size_t)(b * 256 + kg * 8) * 2048 + hd);
    u32x4 o; o[0] = pk2(s[0], s[2048]); o[1] = pk2(s[2 * 2048], s[3 * 2048]); o[2] = pk2(s[4 * 2048], s[5 * 2048]); o[3] = pk2(s[6 * 2048], s[7 * 2048]);
    *(u32x4*)((bf16_t*)(ws + W_VTS) + ((size_t)(b * 2048 + hd)) * 256 + kg * 8) = o;
  }
}

namespace fa {
constexpr int D = 128, LD = 2048, LDO = 6144;
constexpr float SCALE = 0.08838834764831845f;
constexpr float THR = 12.f;
constexpr int NW = 8, QBLK = 32, KVBLK = 64, QB = NW * QBLK;
constexpr int SHM_V = KVBLK * D * 2, SHM_K = KVBLK * D * 2;
constexpr int TAB_OFF = 2 * SHM_V + 2 * SHM_K + NW * 64 * 4;
constexpr unsigned WBIG = 0x7fffffffu;
constexpr int OSTG_OFF = 77824;
#define KSWZ(row, colB) ((row) * 256 + ((colB) ^ (((row) & 7) << 4)))
#define SBAR() __builtin_amdgcn_sched_barrier(0)
DI int v_st(int k, int c) { const int kk = (k & ~0xC) | ((k & 4) << 1) | ((k & 8) >> 1); return ((kk >> 3) * 4 + (c >> 5)) * 512 + ((kk & 7) * 32 + (c & 31)) * 2; }
DI int v_rd_base(int lane) { return ((lane & 3) << 3) | (((lane >> 2) & 3) << 6) | (((lane >> 4) & 1) << 5) | (((lane >> 5) & 1) << 8); }
constexpr int v_rd_off(int d0, int ks, int half) { return d0 * 512 + ks * 4096 + half * 2048; }
DI int crow(int r, int hi) { return (r & 3) + 8 * (r >> 2) + 4 * hi; }
DI bf16x8 load8(const bf16_t* p) { return *reinterpret_cast<const bf16x8*>(p); }
DI void mask_tile(f32x16& p0, f32x16& p1, int dq, unsigned W) {
  const float NEG = -__builtin_inff();
#pragma unroll
  for (int r = 0; r < 16; ++r) {
    const int c = (r & 3) + 8 * (r >> 2);
    if ((unsigned)(dq - c) >= W) p0[r] = NEG;
    if ((unsigned)(dq - c - 32) >= W) p1[r] = NEG;
  }
}
DI void partialSM(f32x16& p0, f32x16& p1, float& m_reg, float& mn, float& alpha) {
  float pmax = p0[0];
#pragma unroll
  for (int r = 1; r < 16; ++r) pmax = fmaxf(pmax, p0[r]);
#pragma unroll
  for (int r = 0; r < 16; ++r) pmax = fmaxf(pmax, p1[r]);
  { auto rr = __builtin_amdgcn_permlane32_swap(__float_as_uint(pmax), __float_as_uint(pmax), false, false);
    pmax = fmaxf(__uint_as_float(rr[0]), __uint_as_float(rr[1])); }
  constexpr float C2 = 1.4426950408889634f * SCALE;
  if (__builtin_expect(__all((pmax - m_reg) * SCALE <= THR), 1)) { mn = m_reg; alpha = 1.f; }
  else { mn = fmaxf(m_reg, pmax); alpha = __builtin_amdgcn_exp2f((m_reg - mn) * C2); m_reg = mn; }
  const float mnL = -mn * C2;
#pragma unroll
  for (int r = 0; r < 16; ++r) p0[r] = fmaf(p0[r], C2, mnL);
#pragma unroll
  for (int r = 0; r < 16; ++r) p1[r] = fmaf(p1[r], C2, mnL);
#pragma unroll
  for (int r = 0; r < 16; ++r) p0[r] = __builtin_amdgcn_exp2f(p0[r]);
}
DI void finishSM(f32x16& p0, f32x16& p1, float alpha, float& l_reg, bf16x8& pa0, bf16x8& pa1, bf16x8& pa2, bf16x8& pa3) {
#pragma unroll
  for (int r = 0; r < 16; ++r) p1[r] = __builtin_amdgcn_exp2f(p1[r]);
  float ps = 0;
#pragma unroll
  for (int r = 0; r < 16; ++r) ps += p0[r];
#pragma unroll
  for (int r = 0; r < 16; ++r) ps += p1[r];
  { auto rr = __builtin_amdgcn_permlane32_swap(__float_as_uint(ps), __float_as_uint(ps), false, false);
    ps = __uint_as_float(rr[0]) + __uint_as_float(rr[1]); }
  l_reg = l_reg * alpha + ps;
#define PK4(P, B_, OUT) do { unsigned a0 = pk2a(P[B_+0], P[B_+1]), a1 = pk2a(P[B_+2], P[B_+3]);                          \
        unsigned b0 = pk2a(P[B_+4], P[B_+5]), b1 = pk2a(P[B_+6], P[B_+7]);                                             \
        auto r0 = __builtin_amdgcn_permlane32_swap(a0, b0, false, false); auto r1 = __builtin_amdgcn_permlane32_swap(a1, b1, false, false); \
        u32x4 w = {r0[0], r1[0], r0[1], r1[1]}; OUT = *reinterpret_cast<bf16x8*>(&w); } while (0)
  PK4(p0, 0, pa0); PK4(p0, 8, pa1); PK4(p1, 0, pa2); PK4(p1, 8, pa3);
#undef PK4
}
template <int KB>
DI void qkt(f32x16& p0, f32x16& p1, const LAS char* K_lds, const LAS float* tabk, int r32, int hi, const bf16x8* qr) {
#pragma unroll
  for (int g = 0; g < 4; ++g) { const f32x4 t0 = *(const LAS f32x4*)(tabk + 8 * g + 4 * hi), t1 = *(const LAS f32x4*)(tabk + 32 + 8 * g + 4 * hi);
#pragma unroll
    for (int e = 0; e < 4; ++e) { p0[4 * g + e] = t0[e]; p1[4 * g + e] = t1[e]; } }
  const LAS char* kb[4];
#pragma unroll
  for (int dd = 0; dd < 4; ++dd) kb[dd] = K_lds + KB * SHM_K + KSWZ(r32, (dd * 16 + hi * 8) * 2);
#pragma unroll
  for (int d0 = 0; d0 < 8; ++d0) { const LAS char* a = kb[d0 & 3] + (d0 >> 2) * 128;
    bf16x8 b0 = *(const LAS bf16x8*)(a);
    bf16x8 b1 = *(const LAS bf16x8*)(a + 32 * 256);
    p0 = __builtin_amdgcn_mfma_f32_32x32x16_bf16(b0, qr[d0], p0, 0, 0, 0);
    p1 = __builtin_amdgcn_mfma_f32_32x32x16_bf16(b1, qr[d0], p1, 0, 0, 0); }
}
template <int VB>
DI void pv_tile(f32x16* o, int vb0, bf16x8 pa0, bf16x8 pa1, bf16x8 pa2, bf16x8 pa3) {
#define TRRD(dst, off) asm volatile("ds_read_b64_tr_b16 %0, %1 offset:%2" : "=&v"(dst) : "v"(vb0), "i"(off) : "memory")
#define PV_D0(d0) do { s16x4 l0, l1, l2, l3, h0, h1, h2, h3; constexpr int b_ = VB * SHM_V + v_rd_off(d0, 0, 0); \
        TRRD(l0, b_); TRRD(h0, b_ + 2048); TRRD(l1, b_ + 4096); TRRD(h1, b_ + 6144); TRRD(l2, b_ + 8192); TRRD(h2, b_ + 10240); TRRD(l3, b_ + 12288); TRRD(h3, b_ + 14336); \
        asm volatile("s_waitcnt lgkmcnt(0)" ::: "memory"); SBAR();   \
        o[d0] = __builtin_amdgcn_mfma_f32_32x32x16_bf16(pa0, (bf16x8){l0[0], l0[1], l0[2], l0[3], h0[0], h0[1], h0[2], h0[3]}, o[d0], 0, 0, 0);   \
        o[d0] = __builtin_amdgcn_mfma_f32_32x32x16_bf16(pa1, (bf16x8){l1[0], l1[1], l1[2], l1[3], h1[0], h1[1], h1[2], h1[3]}, o[d0], 0, 0, 0);   \
        o[d0] = __builtin_amdgcn_mfma_f32_32x32x16_bf16(pa2, (bf16x8){l2[0], l2[1], l2[2], l2[3], h2[0], h2[1], h2[2], h2[3]}, o[d0], 0, 0, 0);   \
        o[d0] = __builtin_amdgcn_mfma_f32_32x32x16_bf16(pa3, (bf16x8){l3[0], l3[1], l3[2], l3[3], h3[0], h3[1], h3[2], h3[3]}, o[d0], 0, 0, 0); } while (0)
  PV_D0(0); PV_D0(1); PV_D0(2); PV_D0(3);
#undef PV_D0
#undef TRRD
}
struct BlockRef { const bf16_t* Q; const bf16_t* K; const bf16_t* V; bf16_t* O; const bf16_t* G; const float* lf; int P0, skv, nvalid, nkeys; };
struct Seam { bf16x8 qr[8]; bf16x8 st_v0, st_v1, st_k0, st_k1; };
constexpr int NFOX = 2048 + 128;
DI BlockRef fox_decode(const Params& P, int L) {
  unsigned char* ws = P.ws; BlockRef r;
  const bf16_t* FQ = (const bf16_t*)(ws + W_FQ); const bf16_t* FG = (const bf16_t*)(ws + W_FG); bf16_t* Y3 = (bf16_t*)(ws + W_Y3);
  if (L < 2048) { const int bh = L >> 3, qb = 7 - (L & 7), b = bh >> 4, h = bh & 15;
    const size_t row = (size_t)b * 2048 + qb * 256;
    r.lf = (const float*)(ws + W_LFT) + (size_t)bh * 2048; r.nkeys = 2048;
    r.Q = FQ + row * 2048 + h * 128; r.K = (const bf16_t*)(ws + W_FK) + (size_t)b * 2048 * 2048 + h * 128; r.V = (const bf16_t*)(ws + W_FV) + (size_t)b * 2048 * 2048 + h * 128;
    r.O = Y3 + row * 6144 + 2048 + h * 128; r.G = FG + row * 2048 + h * 128; r.P0 = qb * 256; r.skv = 2048; r.nvalid = 256;
  } else { const int j = L - 2048, b = j >> 4, h = j & 15;
    r.lf = (const float*)(ws + W_LFS) + (size_t)j * 1088; r.nkeys = 1088;
    const size_t row = (size_t)MP + b * 64;
    r.Q = FQ + row * 2048 + h * 128; r.K = (const bf16_t*)(ws + W_KS) + (size_t)b * 1088 * 2048 + h * 128; r.V = (const bf16_t*)(ws + W_VS) + (size_t)b * 1088 * 2048 + h * 128;
    r.O = Y3 + row * 6144 + 2048 + h * 128; r.G = FG + row * 2048 + h * 128; r.P0 = 1024; r.skv = 1088; r.nvalid = 64; }
  return r;
}

#define ROW(p, k0, rr) ((p) + (size_t)((k0) + 32 * (rr)) * LD + rowoff0)
#define VMW() asm volatile("s_waitcnt vmcnt(0)" ::: "memory")
#define VMWN(n) asm volatile("s_waitcnt vmcnt(%0)" :: "i"(n) : "memory")
#define SLOAD_H(Kp, Vp, k0) do { S.st_v0 = load8(ROW(Vp, k0, 0)); S.st_v1 = load8(ROW(Vp, k0, 1));              \
                         S.st_k0 = load8(ROW(Kp, k0, 0)); S.st_k1 = load8(ROW(Kp, k0, 1)); } while (0)
#define SWRITE_HK(bf) do { *(LAS bf16x8*)(K_lds + (bf) * SHM_K + kws) = S.st_k0; *(LAS bf16x8*)(K_lds + (bf) * SHM_K + kws + 32 * 256) = S.st_k1; } while (0)
#define SWRITE_HV(bf) do { *(LAS bf16x8*)(V_lds + (bf) * SHM_V + vst0) = S.st_v0; *(LAS bf16x8*)(V_lds + (bf) * SHM_V + vst0 + vst1d) = S.st_v1; } while (0)
#define SWRITE_H(bf) do { SWRITE_HV(bf); SWRITE_HK(bf); } while (0)
DI void fox_prime(const BlockRef& cur, LAS char* lds, Seam& S) {
  int tid = threadIdx.x; asm volatile("" : "+v"(tid));
  const int wid = __builtin_amdgcn_readfirstlane(tid >> 6), lane = tid & 63, r32 = lane & 31, hi = lane >> 5;
  const int sr = tid >> 4, sc = (tid & 15) * 8, kws = KSWZ(sr, sc * 2); LAS char* K_lds = lds + 2 * SHM_V;
  const unsigned rowoff0 = (unsigned)(sr * LD + sc);
  const unsigned qoff = (unsigned)((wid * QBLK + r32) * LD + hi * 8);
#pragma unroll
  for (int d0 = 0; d0 < 8; ++d0) S.qr[d0] = load8(cur.Q + qoff + d0 * 16);
  SLOAD_H(cur.K, cur.V, 0); VMW(); SWRITE_HK(0);
  __syncthreads();
}
DI void fox_block(const BlockRef& cur, int Ln, const Params& P, LAS char* lds, Seam& S) {
  int tid = threadIdx.x; asm volatile("" : "+v"(tid));
  const int wid = __builtin_amdgcn_readfirstlane(tid >> 6), lane = tid & 63, r32 = lane & 31, hi = lane >> 5;
  int j_hi = (cur.P0 + QB - 1) / KVBLK + 1; if (j_hi > cur.skv / KVBLK) j_hi = cur.skv / KVBLK;
  const int NT = j_hi;
  const int qlo = cur.P0 + wid * QBLK, qm = qlo + r32 - 4 * hi;
  LAS char* V_lds = lds; LAS char* K_lds = lds + 2 * SHM_V;
  LAS float* ws = (LAS float*)(lds + 2 * SHM_V + 2 * SHM_K) + wid * 64; LAS float* li_l = ws; LAS float* al_l = ws + 32;
  const LAS float* tab = (const LAS float*)(lds + TAB_OFF);
  float m_reg = -1e30f, l_reg = 0; f32x16 o[4] = {};
  const int sr = tid >> 4, sc = (tid & 15) * 8, vst0 = v_st(sr, sc), kws = KSWZ(sr, sc * 2);
  constexpr int vst1d = 8192;
  const unsigned rowoff0 = (unsigned)(sr * LD + sc);
  const int vb0 = (int)(uintptr_t)V_lds + v_rd_base(lane);
  const bf16_t* Kh = cur.K; const bf16_t* Vh = cur.V;
#define RESC(a) do { if (__any((a) < 1.f)) { if (hi == 0) al_l[r32] = (a); asm volatile("s_waitcnt lgkmcnt(0)" ::: "memory");              \
                     for (int d_ = 0; d_ < 4; ++d_) for (int r = 0; r < 16; ++r) o[d_][r] *= al_l[crow(r, hi)]; } } while (0)
#define KBASE(t) ((t) * KVBLK)
#define MASKT(P0_, P1_, t) do { const int kb_ = KBASE(t); if (kb_ + KVBLK - 1 > qlo) mask_tile(P0_, P1_, qm - kb_, WBIG); } while (0)
#define SEAM_K0() do { VMWN(8); SWRITE_HK(0); SBAR(); } while (0)
  f32x16 pA0, pA1, pB0, pB1; float mnA, mnB, alA, alB; bf16x8 pa0, pa1, pa2, pa3;
  SWRITE_HV(0); SBAR();
  if (NT > 1) { SLOAD_H(Kh, Vh, KBASE(1)); }
  SBAR(); qkt<0>(pA0, pA1, K_lds, tab + KBASE(0), r32, hi, S.qr);
  MASKT(pA0, pA1, 0); partialSM(pA0, pA1, m_reg, mnA, alA);
  if (NT > 1) { VMW(); SWRITE_H(1); }
  __syncthreads();
#define HALF_STEP(PX0, PX1, mnX, alX, PY0, PY1, alY, t, KB, VB, SB) do {                                                      \
        SBAR(); qkt<KB>(PX0, PX1, K_lds, tab + KBASE(t), r32, hi, S.qr);                                             \
        finishSM(PY0, PY1, alY, l_reg, pa0, pa1, pa2, pa3); SBAR();                                                           \
        if ((t) + 1 < NT) { SLOAD_H(Kh, Vh, KBASE((t) + 1)); SBAR(); }                                               \
        pv_tile<VB>(o, vb0, pa0, pa1, pa2, pa3); MASKT(PX0, PX1, (t)); partialSM(PX0, PX1, m_reg, mnX, alX);                                        \
        __syncthreads();                                                                                                      \
        if ((t) + 1 < NT) { VMW(); SWRITE_H(SB); }                                                                          \
        RESC(alX); __syncthreads(); } while (0)
  for (int t = 1; t + 1 < NT; t += 2) {
    HALF_STEP(pB0, pB1, mnB, alB, pA0, pA1, alA, t, 1, 0, 0);
    HALF_STEP(pA0, pA1, mnA, alA, pB0, pB1, alB, t + 1, 0, 1, 1);
  }
  const bool even = (NT & 1) == 0;
  if (even) { SBAR(); qkt<1>(pB0, pB1, K_lds, tab + KBASE(NT - 1), r32, hi, S.qr); SBAR(); }
  const BlockRef nxt = (Ln < NFOX) ? fox_decode(P, Ln) : cur;
  SLOAD_H(nxt.K, nxt.V, 0); SBAR();
  unsigned qoff; { int l2 = lane; asm volatile("" : "+v"(l2)); qoff = (unsigned)((wid * QBLK + (l2 & 31)) * LD + (l2 >> 5) * 8); }
#pragma unroll
  for (int d0 = 0; d0 < 8; ++d0) S.qr[d0] = load8(nxt.Q + qoff + d0 * 16);
  SBAR();
  finishSM(pA0, pA1, alA, l_reg, pa0, pa1, pa2, pa3); SBAR();
  pv_tile<0>(o, vb0, pa0, pa1, pa2, pa3);
  if (even) { MASKT(pB0, pB1, NT - 1); partialSM(pB0, pB1, m_reg, mnB, alB); __syncthreads(); RESC(alB);
    finishSM(pB0, pB1, alB, l_reg, pa0, pa1, pa2, pa3); SBAR(); pv_tile<1>(o, vb0, pa0, pa1, pa2, pa3); }
  SBAR(); SEAM_K0();
  if (hi == 0) li_l[r32] = l_reg; asm volatile("s_waitcnt lgkmcnt(0)" ::: "memory");
  { int lane_o = lane; asm volatile("" : "+v"(lane_o));
    LAS char* stg = lds + OSTG_OFF + wid * 8448;
    const int rw = lane_o >> 4, cw = (lane_o & 15) * 8; const int r32 = lane_o & 31, hi = lane_o >> 5;
#pragma unroll
    for (int half = 0; half < 2; ++half) {
#pragma unroll
      for (int rr = 0; rr < 8; ++rr) { const int r = half * 8 + rr; const int orow = crow(r, hi); const float rl = __builtin_amdgcn_rcpf(li_l[orow]);
#pragma unroll
        for (int d0 = 0; d0 < 4; ++d0) *(LAS float*)(stg + (orow - 16 * half) * 528 + (d0 * 32 + r32) * 4) = o[d0][r] * rl; }
      asm volatile("s_waitcnt lgkmcnt(0)" ::: "memory");
#pragma unroll
      for (int i = 0; i < 4; ++i) { const int lr = i * 4 + rw; const int brow = wid * QBLK + half * 16 + lr;
        const f32x4 v0 = *(const LAS f32x4*)(stg + lr * 528 + cw * 4), v1 = *(const LAS f32x4*)(stg + lr * 528 + cw * 4 + 16);
        const u32x4 gw = *(const u32x4*)(cur.G + (unsigned)(brow * LD + cw));
        u32x4 ow; ow[0] = pk2a(v0[0] * bflo(gw[0]), v0[1] * bfhi(gw[0])); ow[1] = pk2a(v0[2] * bflo(gw[1]), v0[3] * bfhi(gw[1]));
        ow[2] = pk2a(v1[0] * bflo(gw[2]), v1[1] * bfhi(gw[2])); ow[3] = pk2a(v1[2] * bflo(gw[3]), v1[3] * bfhi(gw[3]));
        if (brow < cur.nvalid) *(u32x4*)(cur.O + (unsigned)(brow * LDO + cw)) = ow; }
      asm volatile("s_waitcnt lgkmcnt(0)" ::: "memory");
    } }
  __syncthreads();
#undef RESC
#undef KBASE
#undef MASKT
#undef SEAM_K0
#undef HALF_STEP
}
#undef ROW
#undef VMW
#undef VMWN
#undef SLOAD_H
#undef SWRITE_HK
#undef SWRITE_HV
#undef SWRITE_H
DI void build_bias(const float* src, int nkeys, LAS char* lds) {
  LAS float* tab = (LAS float*)(lds + TAB_OFF); LAS float* wsum = tab + 2048;
  int tid = threadIdx.x; asm volatile("" : "+v"(tid));
  const int lane = tid & 63, wid = tid >> 6;
  f32x4 v = {0.f, 0.f, 0.f, 0.f}; if (tid * 4 < nkeys) v = *(const f32x4*)(src + tid * 4);
  const float s0 = v[0], s1 = s0 + v[1], s2 = s1 + v[2], s3 = s2 + v[3];
  float incl = s3;
#pragma unroll
  for (int o = 1; o < 64; o <<= 1) { const int sl = lane >= o ? lane - o : lane;
    const float t = __int_as_float(__builtin_amdgcn_ds_bpermute(sl * 4, __float_as_int(incl))); if (lane >= o) incl += t; }
  if (lane == 63) wsum[wid] = incl;
  __syncthreads();
  float off = incl - s3;
  for (int w = 0; w < wid; ++w) off += wsum[w];
  const float kk = -11.313708498984761f;
  f32x4 o = {(off + s0) * kk, (off + s1) * kk, (off + s2) * kk, (off + s3) * kk};
  *(LAS f32x4*)(tab + tid * 4) = o;
  __syncthreads();
}
}

DI int fetch_item(unsigned* ctr, LAS char* lds) {
  volatile LAS int* slot = (volatile LAS int*)(lds + LDS_BYTES - 64);
  __syncthreads();
  if (threadIdx.x == 0) *slot = (int)atomicAdd(ctr, 1u);
  __syncthreads();
  return __builtin_amdgcn_readfirstlane(*slot);
}


DI void conv_pass(const Params& P) {
  unsigned char* ws = P.ws;
  int tid = threadIdx.x; asm volatile("" : "+v"(tid));
  const float* wconv = P.in[12]; const float* bconv = P.in[13];
  bf16_t* XCT = (bf16_t*)(ws + W_XCT); bf16_t* BCN = (bf16_t*)(ws + W_BCN); bf16_t* BTT = (bf16_t*)(ws + W_BTT);
  const int lane = tid & 63, wv = blockIdx.x * 8 + (tid >> 6), NWV = gridDim.x * 8;
  const int tg = lane & 7, ccl = lane >> 3;
  for (int it = wv; it < 520 * 48; it += NWV) {
    const int cidx = it / 48, ccg = it - cidx * 48; const int cc = ccg * 8 + ccl; const int ch = cc * 8;
    const bool sample = cidx >= 512; const int b = sample ? cidx - 512 : cidx >> 5, c = sample ? 0 : cidx & 31;
    const bf16_t* xbc = sample ? (const bf16_t*)(ws + W_XBCS) + (size_t)b * 67 * 3072 : (const bf16_t*)(ws + W_XBCP) + (size_t)b * 2051 * 3072;
    const size_t rowbase = sample ? (size_t)MP + b * 64 : (size_t)b * 2048;
    const int t0 = c * 64 + tg * 8;
    u32x4 raw[11];
#pragma unroll
    for (int j = 0; j < 11; ++j) raw[j] = *(const u32x4*)(xbc + (size_t)(t0 + j) * 3072 + ch);
    f32x4 wv4[4][2], bv[2];
#pragma unroll
    for (int i = 0; i < 4; ++i) { wv4[i][0] = *(const f32x4*)(wconv + i * 3072 + ch); wv4[i][1] = *(const f32x4*)(wconv + i * 3072 + ch + 4); }
    bv[0] = *(const f32x4*)(bconv + ch); bv[1] = *(const f32x4*)(bconv + ch + 4);
    unsigned op[8][4];
    u32x4 on[8];
    float prev[8];
#pragma unroll
    for (int j = 0; j < 8; ++j) {
      float o[8];
#pragma unroll
      for (int e = 0; e < 8; ++e) { float a = bv[e >> 2][e & 3];
#pragma unroll
        for (int i = 0; i < 4; ++i) { const unsigned w = raw[j + i][e >> 1]; const float xv = (e & 1) ? bfhi(w) : bflo(w); a += wv4[i][e >> 2][e & 3] * xv; }
        o[e] = siluf_(a); }
      on[j][0] = pk2(o[0], o[1]); on[j][1] = pk2(o[2], o[3]); on[j][2] = pk2(o[4], o[5]); on[j][3] = pk2(o[6], o[7]);
      if (j & 1) {
#pragma unroll
        for (int e = 0; e < 8; ++e) op[e][j >> 1] = pk2(prev[e], o[e]);
      } else {
#pragma unroll
        for (int e = 0; e < 8; ++e) prev[e] = o[e];
      }
    }
    if (ch < 2048) { const int h = ch >> 6, p0 = ch & 63;
      bf16_t* dst = XCT + ((size_t)(cidx * 32 + h) * 64 + p0) * 64 + tg * 8;
#pragma unroll
      for (int e = 0; e < 8; ++e) { u32x4 w = {op[e][0], op[e][1], op[e][2], op[e][3]}; *(u32x4*)(dst + e * 64) = w; }
    } else {
      const int cb = ch - 2048;
      bf16_t* dn = BCN + (rowbase + t0) * 1024 + cb;
#pragma unroll
      for (int j = 0; j < 8; ++j) *(u32x4*)(dn + (size_t)j * 1024) = on[j];
      if (cb < 512) { const int g = cb >> 7, n0 = cb & 127;
        bf16_t* dt_ = BTT + ((size_t)(cidx * 4 + g) * 128 + n0) * 64 + tg * 8;
#pragma unroll
        for (int e = 0; e < 8; ++e) { u32x4 w = {op[e][0], op[e][1], op[e][2], op[e][3]}; *(u32x4*)(dt_ + e * 64) = w; }
      }
    }
  }
}

DI void ssd_item(const Params& P, LAS unsigned char* lds, int item) {
  unsigned char* ws = P.ws;
  int tid = threadIdx.x; asm volatile("" : "+v"(tid));
  const int wid = __builtin_amdgcn_readfirstlane(tid >> 6), lane = tid & 63, r16 = lane & 15, q = lane >> 4;
  const bool sample = item >= 128; const int i2 = sample ? item - 128 : item; const int b = i2 >> 3, g = (i2 >> 1) & 3, hh = i2 & 1;
  const int nch = sample ? 1 : 32;
  const size_t rowbase = sample ? (size_t)MP + b * 64 : (size_t)b * 2048;
  const int h = g * 8 + hh * 4 + (wid >> 1), ph = wid & 1, pb = ph * 32;
  const float A_h = -__expf(P.in[15][h]), dsk = P.in[16][h];
  const float* DT = (const float*)(ws + W_DT); const bf16_t* ZB = (const bf16_t*)(ws + W_ZB); bf16_t* Y3 = (bf16_t*)(ws + W_Y3); float* SSQP = (float*)(ws + W_SSQP);
  LAS unsigned char* Bs = lds; LAS unsigned char* Cs = lds + 17408; LAS unsigned char* BT = lds + 34816;
  LAS unsigned char* XT = lds + 53248 + wid * 4608;
  LAS float* acum_l = (LAS float*)(lds + 90112 + wid * 768); LAS float* dtv_l = acum_l + 64; LAS float* wend_l = acum_l + 128;
  f32x4 hT[8][2];
#pragma unroll
  for (int nt = 0; nt < 8; ++nt)
#pragma unroll
    for (int pt = 0; pt < 2; ++pt) {
      if (sample) hT[nt][pt] = *(const f32x4*)(P.in[6] + ((size_t)(b * 32 + h) * 64 + pb + pt * 16 + r16) * 128 + nt * 16 + 4 * q);
      else hT[nt][pt] = (f32x4){0.f, 0.f, 0.f, 0.f};
    }
  const bf16_t* XCT = (const bf16_t*)(ws + W_XCT); const bf16_t* BCN = (const bf16_t*)(ws + W_BCN); const bf16_t* BTT = (const bf16_t*)(ws + W_BTT);
  float dtl; u32x4 rx[4], rb[2], rc[2], rt[2];
#define SSD_LOAD(c_) do { const int t0_ = (c_) * 64; const int cidx_ = sample ? 512 + b : b * 32 + (c_);                         \
    dtl = DT[(rowbase + t0_ + lane) * 32 + h];                                                                                  \
    const bf16_t* xs_ = XCT + ((size_t)(cidx_ * 32 + h) * 64 + pb) * 64;                                                        \
    _Pragma("unroll") for (int j = 0; j < 4; ++j) rx[j] = *(const u32x4*)(xs_ + (j * 64 + lane) * 8);                           \
    const bf16_t* bts_ = BTT + (size_t)(cidx_ * 4 + g) * 8192;                                                                  \
    _Pragma("unroll") for (int j = 0; j < 2; ++j) { const int id = tid + 512 * j; const int s = id >> 4, k = id & 15;           \
      rb[j] = *(const u32x4*)(BCN + (rowbase + t0_ + s) * 1024 + g * 128 + k * 8);                                              \
      rc[j] = *(const u32x4*)(BCN + (rowbase + t0_ + s) * 1024 + 512 + g * 128 + k * 8);                                        \
      rt[j] = *(const u32x4*)(bts_ + id * 8); } } while (0)
  SSD_LOAD(0);
  for (int c = 0; c < nch; ++c) {
    const int t0 = c * 64;
    float cdec;
    { float ac = dtl * A_h;
#pragma unroll
      for (int o = 1; o < 64; o <<= 1) { const float t = __shfl_up(ac, o); if (lane >= o) ac += t; }
      const float tot = __shfl(ac, 63);
      acum_l[lane] = ac; dtv_l[lane] = dtl; wend_l[lane] = __expf(tot - ac) * dtl; cdec = __expf(tot); }
#pragma unroll
    for (int j = 0; j < 4; ++j) { const int e8 = j * 64 + lane; *(LAS u32x4*)(XT + (e8 >> 3) * 144 + (e8 & 7) * 16) = rx[j]; }
    __syncthreads();
#pragma unroll
    for (int j = 0; j < 2; ++j) { const int id = tid + 512 * j;
      *(LAS u32x4*)(Bs + (id >> 4) * 272 + (id & 15) * 16) = rb[j];
      *(LAS u32x4*)(Cs + (id >> 4) * 272 + (id & 15) * 16) = rc[j];
      *(LAS u32x4*)(BT + (id >> 3) * 144 + (id & 7) * 16) = rt[j]; }
    __syncthreads();
    if (c + 1 < nch) SSD_LOAD(c + 1);
    u32x2 znext[2];
#pragma unroll
    for (int pt = 0; pt < 2; ++pt) znext[pt] = *(const u32x2*)(ZB + (rowbase + t0 + r16) * 2048 + h * 64 + pb + pt * 16 + 4 * q);
#pragma unroll
    for (int lt = 0; lt < 4; ++lt) {
      const int l = lt * 16 + r16;
      const size_t row = rowbase + t0 + l;
      u32x2 zraw[2];
#pragma unroll
      for (int pt = 0; pt < 2; ++pt) zraw[pt] = znext[pt];
      { const int ln = (lt < 3 ? lt + 1 : 3) * 16 + r16;
#pragma unroll
        for (int pt = 0; pt < 2; ++pt) znext[pt] = *(const u32x2*)(ZB + (rowbase + t0 + ln) * 2048 + h * 64 + pb + pt * 16 + 4 * q); }
      f32x4 y[2];
#pragma unroll
      for (int pt = 0; pt < 2; ++pt) y[pt] = (f32x4){0.f, 0.f, 0.f, 0.f};
#pragma unroll
      for (int np = 0; np < 4; ++np) {
        const u32x2 clo = *(const LAS u32x2*)(Cs + l * 272 + (32 * np + 4 * q) * 2), chi = *(const LAS u32x2*)(Cs + l * 272 + (32 * np + 16 + 4 * q) * 2);
        const bf16x8 bfrag = cat8(clo, chi);
#pragma unroll
        for (int pt = 0; pt < 2; ++pt) y[pt] = MFMA16(pack8a(hT[2 * np][pt], hT[2 * np + 1][pt]), bfrag, y[pt]);
      }
      const float al = acum_l[l]; const float el = __expf(al);
#pragma unroll
      for (int pt = 0; pt < 2; ++pt) y[pt] *= el;
      const int nsp = (lt >> 1) + 1;
#pragma unroll
      for (int sp = 0; sp < nsp; ++sp) {
        f32x4 cb0 = {0.f, 0.f, 0.f, 0.f}, cb1 = {0.f, 0.f, 0.f, 0.f};
#pragma unroll
        for (int ks = 0; ks < 4; ++ks) {
          const bf16x8 cf = *(const LAS bf16x8*)(Cs + l * 272 + (32 * ks + 8 * q) * 2);
          const bf16x8 b0 = *(const LAS bf16x8*)(Bs + (32 * sp + r16) * 272 + (32 * ks + 8 * q) * 2);
          const bf16x8 b1 = *(const LAS bf16x8*)(Bs + (32 * sp + 16 + r16) * 272 + (32 * ks + 8 * q) * 2);
          cb0 = MFMA16(b0, cf, cb0); cb1 = MFMA16(b1, cf, cb1);
        }
        const int s0 = 32 * sp + 4 * q, s1 = s0 + 16;
        const f32x4 as0 = *(const LAS f32x4*)(acum_l + s0), as1 = *(const LAS f32x4*)(acum_l + s1);
        const f32x4 d0 = *(const LAS f32x4*)(dtv_l + s0), d1 = *(const LAS f32x4*)(dtv_l + s1);
        f32x4 m0, m1;
#pragma unroll
        for (int e = 0; e < 4; ++e) {
          m0[e] = (s0 + e <= l) ? cb0[e] * __expf(al - as0[e]) * d0[e] : 0.f;
          m1[e] = (s1 + e <= l) ? cb1[e] * __expf(al - as1[e]) * d1[e] : 0.f;
        }
        const bf16x8 mfrag = pack8a(m0, m1);
#pragma unroll
        for (int pt = 0; pt < 2; ++pt) { const int p = pt * 16 + r16;
          const u32x2 xlo = *(const LAS u32x2*)(XT + p * 144 + s0 * 2), xhi = *(const LAS u32x2*)(XT + p * 144 + s1 * 2);
          y[pt] = MFMA16(cat8(xlo, xhi), mfrag, y[pt]); }
      }
      float ssq = 0.f;
#pragma unroll
      for (int pt = 0; pt < 2; ++pt) { const int p0 = pt * 16 + 4 * q;
        const f32x4 zz = {bflo(zraw[pt][0]), bfhi(zraw[pt][0]), bflo(zraw[pt][1]), bfhi(zraw[pt][1])};
        f32x4 v;
#pragma unroll
        for (int e = 0; e < 4; ++e) { const float xv = bf2f(*(const LAS bf16_t*)(XT + (p0 + e) * 144 + l * 2));
          v[e] = (y[pt][e] + dsk * xv) * zz[e]; ssq += v[e] * v[e]; }
        st_bf4a(Y3 + row * 6144 + h * 64 + pb + p0, v); }
      ssq += __shfl_xor(ssq, 16); ssq += __shfl_xor(ssq, 32);
      if (q == 0) SSQP[row * 64 + h * 2 + ph] = ssq;
    }
#pragma unroll
    for (int nt = 0; nt < 8; ++nt)
#pragma unroll
      for (int pt = 0; pt < 2; ++pt) hT[nt][pt] *= cdec;
#pragma unroll
    for (int ks = 0; ks < 2; ++ks) {
      bf16x8 bfr[2];
      const f32x4 w0 = *(const LAS f32x4*)(wend_l + 32 * ks + 8 * q), w1 = *(const LAS f32x4*)(wend_l + 32 * ks + 8 * q + 4);
#pragma unroll
      for (int pt = 0; pt < 2; ++pt) { const int p = pt * 16 + r16;
        const u32x4 xr = *(const LAS u32x4*)(XT + p * 144 + (32 * ks + 8 * q) * 2);
        const f32x4 a = {bflo(xr[0]) * w0[0], bfhi(xr[0]) * w0[1], bflo(xr[1]) * w0[2], bfhi(xr[1]) * w0[3]};
        const f32x4 bq = {bflo(xr[2]) * w1[0], bfhi(xr[2]) * w1[1], bflo(xr[3]) * w1[2], bfhi(xr[3]) * w1[3]};
        bfr[pt] = pack8a(a, bq); }
#pragma unroll
      for (int nt = 0; nt < 8; ++nt) { const bf16x8 af = *(const LAS bf16x8*)(BT + (nt * 16 + r16) * 144 + (32 * ks + 8 * q) * 2);
#pragma unroll
        for (int pt = 0; pt < 2; ++pt) hT[nt][pt] = MFMA16(af, bfr[pt], hT[nt][pt]); }
    }
  }
#undef SSD_LOAD
  float* so = P.out + (sample ? O_SSDS : O_SSDP) + (size_t)(b * 32 + h) * 8192;
#pragma unroll
  for (int nt = 0; nt < 8; ++nt)
#pragma unroll
    for (int pt = 0; pt < 2; ++pt) *(f32x4*)(so + (size_t)(pb + pt * 16 + r16) * 128 + nt * 16 + 4 * q) = hT[nt][pt];
  __syncthreads();
}

__global__ __launch_bounds__(512) void mk_forward(Params Parg) {
#if defined(__HIP_DEVICE_COMPILE__)
  extern __shared__ __attribute__((aligned(16))) unsigned char lds_raw[];
  LAS unsigned char* lds = (LAS unsigned char*)lds_raw;
  cg::grid_group grid = cg::this_grid();
  const int G = gridDim.x, cblk = blockIdx.x;
  typedef __attribute__((address_space(4))) const Params* KP;
  const KP kp = (KP)__builtin_amdgcn_kernarg_segment_ptr();
#define PHASE_PARAMS() KP kq_ = kp; asm volatile("" : "+s"(kq_)); const Params P = *kq_; unsigned char* ws = P.ws; (void)ws
#ifndef PH
#define PH 255
#endif
#ifndef DUPMASK
#define DUPMASK 0
#endif
  for (int rep0_ = 0; rep0_ < ((DUPMASK & 1) ? 2 : 1); ++rep0_)
  if (PH & 1) { PHASE_PARAMS(); phase0(P, lds); }
  grid.sync();
  for (int rep_ = 0; rep_ < ((DUPMASK & 2) ? 2 : 1); ++rep_)
  if (PH & 2) { PHASE_PARAMS();
    SchedP1 S; S.c = cblk; S.G = G; S.XB = (const char*)(ws + W_XB); S.WIN = (const char*)(ws + W_WIN); S.MB = (const char*)(ws + W_MB); S.WMEM = (const char*)(ws + W_WMEM);
    EpiIn E; E.P = P; E.ldsb = lds; pg8::Gemm g; g.lda = 2048; g.ldb = 2048; g.K = 2048; g.delay = 0;
    pg8::gemm_phase(lds, g, S, E);
    if (cblk >= 58) p1_tail_convert(P, cblk - 58, 198); }
  grid.sync();
  { PHASE_PARAMS(); conv_pass(P); }
  grid.sync();
  for (int rep_ = 0; rep_ < 1; ++rep_) {
  if (cblk < 128) { PHASE_PARAMS(); ssd_item(P, lds, cblk); }
  else { PHASE_PARAMS();
    if (cblk < 192) ssd_item(P, lds, cblk);
    SchedS S; S.c = cblk - 128; S.G = 128; S.MQ = (const char*)(ws + W_MQ); S.MKP = (const char*)(ws + W_MKP); S.MKS = (const char*)(ws + W_MKS);
    EpiS E; E.P = P; pg8::Gemm g; g.lda = 2048; g.ldb = 2048; g.K = 512; g.delay = 0;
    pg8::gemm_phase(lds, g, S, E); }
  if (PH & 16) { PHASE_PARAMS(); unsigned* ctl = (unsigned*)(ws + W_CTL) + rep_ * 32;
    LAS char* l8 = (LAS char*)lds_raw;
    int L = fetch_item(ctl + 16, l8);
    if (L < fa::NFOX) {
      fa::BlockRef cur = fa::fox_decode(P, L);
      fa::Seam S;
      fa::build_bias(cur.lf, cur.nkeys, l8);
      fa::fox_prime(cur, l8, S);
      for (;;) {
        const int Ln = fetch_item(ctl + 16, l8);
        fa::fox_block(cur, Ln, P, l8, S);
        if (Ln >= fa::NFOX) break;
        cur = fa::fox_decode(P, Ln);
        fa::build_bias(cur.lf, cur.nkeys, l8);
      }
    }
  }
  }
  grid.sync();
  for (int rep3_ = 0; rep3_ < ((DUPMASK & 32) ? 2 : 1); ++rep3_)
  if (PH & 32) { PHASE_PARAMS();
    { const float* SSQP = (const float*)(ws + W_SSQP); float* RS = (float*)(ws + W_RS);
      int tid = threadIdx.x; asm volatile("" : "+v"(tid));
      for (int r = cblk * 512 + tid; r < MT; r += G * 512) { float s = 0.f;
#pragma unroll
        for (int j = 0; j < 16; ++j) { const f32x4 v = *(const f32x4*)(SSQP + (size_t)r * 64 + 4 * j); s += (v[0] + v[1]) + (v[2] + v[3]); }
        RS[r] = rsqrtf(s * (1.f / 2048.f) + EPS); } }
    SchedPV S; S.c = cblk; S.G = G; S.PM = (const char*)(ws + W_PM); S.VTP = (const char*)(ws + W_VTP); S.VTS = (const char*)(ws + W_VTS);
    EpiPV E; E.P = P; pg8::Gemm g; g.lda = 1024; g.ldb = 256; g.K = 256; g.delay = 0;
    pg8::gemm_phase(lds, g, S, E); }
  grid.sync();
  for (int rep4_ = 0; rep4_ < ((DUPMASK & 64) ? 2 : 1); ++rep4_)
  if (PH & 64) { PHASE_PARAMS();
    SchedMerge S; S.c = cblk; S.G = G; S.A = (const char*)(ws + W_Y3); S.B = (const char*)(ws + W_WO);
    EpiMerge E; E.P = P; pg8::Gemm g; g.lda = 6144; g.ldb = 6144; g.K = 2048; g.delay = 0;
    pg8::gemm_phase(lds, g, S, E); }
  grid.sync();
  { PHASE_PARAMS(); const float* PARTM = (const float*)(ws + W_PARTM); bf16_t* MRG = (bf16_t*)(ws + W_MRG);
    int tid = threadIdx.x; asm volatile("" : "+v"(tid));
    for (int i = cblk * 512 + tid; i < MS * 2048 / 4; i += G * 512) {
      const f32x4 a = *(const f32x4*)(PARTM + (size_t)i * 4), b2 = *(const f32x4*)(PARTM + (size_t)MS * 2048 + (size_t)i * 4), c2 = *(const f32x4*)(PARTM + (size_t)2 * MS * 2048 + (size_t)i * 4);
      st_bf4(MRG + (size_t)MP * 2048 + (size_t)i * 4, a + b2 + c2); } }
  grid.sync();
  if (PH & 128) { PHASE_PARAMS();
    { SchedOutS S; S.c = cblk; S.A = (const char*)(ws + W_MRG); S.B = (const char*)(ws + W_WOUT);
      EpiOut E; E.P = P; pg8::Gemm g; g.lda = 2048; g.ldb = 2048; g.K = 512; g.delay = 0;
      pg8::gemm_phase(lds, g, S, E); }
    { SchedOutP S; S.c = cblk; S.A = (const char*)(ws + W_MRG); S.B = (const char*)(ws + W_WOUT);
      EpiOut E; E.P = P; pg8::Gemm g; g.lda = 2048; g.ldb = 2048; g.K = 2048; g.delay = 0;
      pg8::gemm_phase(lds, g, S, E); } }
  grid.sync();
  { PHASE_PARAMS();
    const float* PARTO = (const float*)(ws + W_PARTO); const float* gf = P.in[25];
    int tid = threadIdx.x; asm volatile("" : "+v"(tid)); const int wid = tid >> 6, lane = tid & 63;
    for (int r = cblk * 8 + wid; r < MT; r += G * 8) {
      f32x4* y = (f32x4*)(P.out + (size_t)r * 2048) + lane; const f32x4* gv = (const f32x4*)gf + lane;
      if (r < MP) {
        const float pv = lane < 32 ? PARTO[(size_t)r * 32 + lane] : 0.f;
        const float sc = rsqrtf(wave_sum(pv) * (1.f / 2048.f) + EPS);
#pragma unroll
        for (int j = 0; j < 8; ++j) { f32x4 v = y[64 * j]; const f32x4 gg = gv[64 * j]; y[64 * j] = v * sc * gg; }
      } else {
        const int rs = r - MP; const f32x4* xr = (const f32x4*)(P.in[1] + (size_t)rs * 2048) + lane;
        const f32x4* p5 = (const f32x4*)((const float*)(ws + W_PART5) + (size_t)rs * 2048) + lane;
        f32x4 v[8]; float ss = 0.f;
#pragma unroll
        for (int j = 0; j < 8; ++j) { v[j] = xr[64 * j];
#pragma unroll
          for (int kq = 0; kq < 4; ++kq) v[j] += p5[(size_t)kq * MS * 512 + 64 * j];
          ss += (v[j][0] * v[j][0] + v[j][1] * v[j][1]) + (v[j][2] * v[j][2] + v[j][3] * v[j][3]); }
        const float sc = rsqrtf(wave_sum(ss) * (1.f / 2048.f) + EPS);
#pragma unroll
        for (int j = 0; j < 8; ++j) y[64 * j] = v[j] * sc * gv[64 * j];
      }
    } }
#endif
}

extern "C" void kernel_launch(void* const* d_in, const int* in_sizes, int n_in,
                              void* d_out, int out_size, void* d_ws, size_t ws_size,
                              hipStream_t stream) {
  static int grid = 0;
  if (grid == 0) {
    int dev = 0, cus = 0, per_cu = 0;
    (void)hipGetDevice(&dev);
    (void)hipDeviceGetAttribute(&cus, hipDeviceAttributeMultiprocessorCount, dev);
    (void)hipFuncSetAttribute((const void*)mk_forward, hipFuncAttributeMaxDynamicSharedMemorySize, LDS_BYTES);
    (void)hipOccupancyMaxActiveBlocksPerMultiprocessor(&per_cu, (const void*)mk_forward, 512, LDS_BYTES);
    if (per_cu < 1) per_cu = 1;
    grid = cus * per_cu;
    if (ws_size < W_END) { fprintf(stderr, "workspace too small: %zu < %zu\n", ws_size, (size_t)W_END); grid = -1; }
  }
  if (grid < 0) return;
  Params p{};
  for (int i = 0; i < 26; ++i) p.in[i] = (const float*)d_in[i];
  p.out = (float*)d_out; p.ws = (unsigned char*)d_ws;
  void* args[] = {&p};
  hipError_t e = hipLaunchCooperativeKernel((const void*)mk_forward, dim3(grid), dim3(512), args, LDS_BYTES, stream);
  if (e != hipSuccess) fprintf(stderr, "cooperative launch failed: %s (grid %d)\n", hipGetErrorString(e), grid);
}
```

```cpp
#include <hip/hip_runtime.h>
#include <hip/hip_cooperative_groups.h>
#include <cstdio>
#include <cstdint>
namespace cg = cooperative_groups;

#define LAS __attribute__((address_space(3)))
#define DI __device__ __forceinline__
typedef unsigned short bf16_t;
typedef short bf16x8 __attribute__((ext_vector_type(8)));
typedef short s16x4 __attribute__((ext_vector_type(4)));
typedef float f32x4 __attribute__((ext_vector_type(4)));
typedef float f32x16 __attribute__((ext_vector_type(16)));
typedef unsigned u32x4 __attribute__((ext_vector_type(4)));
typedef unsigned u32x2 __attribute__((ext_vector_type(2)));

constexpr int DM = 2048;
constexpr int MP = 32768, MS = 512, MT = MP + MS, MPADR = MT + 256;
constexpr int NIN = 23808;
constexpr int LDS_BYTES = 147456;
constexpr float EPS = 1e-6f;

constexpr long O_YP = 0;
constexpr long O_YS = 67108864L;
constexpr long O_FKP = O_YS + 1048576L;
constexpr long O_FVP = O_FKP + 67108864L;
constexpr long O_FLP = O_FVP + 67108864L;
constexpr long O_SSDP = O_FLP + 524288L;
constexpr long O_CONVP = O_SSDP + 4194304L;
constexpr long O_MKP = O_CONVP + 147456L;
constexpr long O_MVP = O_MKP + 8388608L;
constexpr long O_FKS = O_MVP + 8388608L;
constexpr long O_FVS = O_FKS + 1048576L;
constexpr long O_FLS = O_FVS + 1048576L;
constexpr long O_SSDS = O_FLS + 8192L;
constexpr long O_CONVS = O_SSDS + 2097152L;

constexpr size_t al256(size_t x) { return (x + 255) & ~(size_t)255; }
constexpr size_t W_CTL = 0;
constexpr size_t W_R1 = 4096;
constexpr size_t W_RM = al256(W_R1 + (size_t)MT * 4);
constexpr size_t W_RS = al256(W_RM + 4096 * 4);
constexpr size_t W_XB = al256(W_RS + (size_t)MT * 4);
constexpr size_t W_MB = al256(W_XB + (size_t)MT * DM * 2);
constexpr size_t W_WIN = al256(W_MB + (size_t)4096 * DM * 2);
constexpr size_t W_WMEM = al256(W_WIN + (size_t)NIN * DM * 2);
constexpr size_t W_WO = al256(W_WMEM + (size_t)4096 * DM * 2);
constexpr size_t W_WOUT = al256(W_WO + (size_t)2048 * 6144 * 2);
constexpr size_t W_ZB = al256(W_WOUT + (size_t)2048 * 2048 * 2);
constexpr size_t W_XBCP = al256(W_ZB + (size_t)MT * DM * 2);
constexpr size_t W_XBCS = al256(W_XBCP + (size_t)16 * 2051 * 3072 * 2);
constexpr size_t W_DT = al256(W_XBCS + (size_t)8 * 67 * 3072 * 2);
constexpr size_t W_FQ = al256(W_DT + (size_t)MT * 32 * 4);
constexpr size_t W_FK = al256(W_FQ + (size_t)MPADR * DM * 2);
constexpr size_t W_FV = al256(W_FK + (size_t)MP * DM * 2);
constexpr size_t W_KS = al256(W_FV + (size_t)MP * DM * 2);
constexpr size_t W_VS = al256(W_KS + (size_t)8 * 1088 * DM * 2);
constexpr size_t W_FG = al256(W_VS + (size_t)8 * 1088 * DM * 2);
constexpr size_t W_MQ = al256(W_FG + (size_t)MPADR * DM * 2);
constexpr size_t W_MG = al256(W_MQ + (size_t)MPADR * DM * 2);
constexpr size_t W_G3 = al256(W_MG + (size_t)MT * DM * 2);
constexpr size_t W_LFT = al256(W_G3 + (size_t)MT * 6144 * 2);
constexpr size_t W_LFS = al256(W_LFT + (size_t)256 * 2048 * 4);
constexpr size_t W_MKP = al256(W_LFS + (size_t)128 * 1088 * 4);
constexpr size_t W_VTP = al256(W_MKP + (size_t)4096 * DM * 2);
constexpr size_t W_MKS = al256(W_VTP + (size_t)4096 * DM * 2);
constexpr size_t W_VTS = al256(W_MKS + (size_t)2048 * DM * 2);
constexpr size_t W_PM = al256(W_VTS + (size_t)2048 * DM * 2);
constexpr size_t W_PSUM = al256(W_PM + (size_t)MPADR * 1024 * 2);
constexpr size_t W_Y3 = al256(W_PSUM + (size_t)MT * 16 * 4);
constexpr size_t W_SSQP = al256(W_Y3 + (size_t)MT * 6144 * 2);
constexpr size_t W_MRG = al256(W_SSQP + (size_t)MT * 64 * 4);
constexpr size_t W_PARTO = al256(W_MRG + (size_t)MT * DM * 2);
constexpr size_t W_TMP = al256(W_PARTO + (size_t)MT * 32 * 4);
constexpr size_t W_PARTM = al256(W_TMP + (size_t)MT * DM * 4);
constexpr size_t W_PART5 = al256(W_PARTM + (size_t)3 * MS * DM * 4);
constexpr size_t W_XCT = al256(W_PART5 + (size_t)4 * MS * DM * 4);
constexpr size_t W_BCN = al256(W_XCT + (size_t)520 * 32 * 4096 * 2);
constexpr size_t W_BTT = al256(W_BCN + (size_t)MT * 1024 * 2);
constexpr size_t W_END = al256(W_BTT + (size_t)520 * 4 * 8192 * 2);

struct Params { const float* in[26]; float* out; unsigned char* ws; };

typedef __bf16 bf16x2_t __attribute__((ext_vector_type(2)));
typedef float f32x2_t __attribute__((ext_vector_type(2)));
DI unsigned pk2a(float lo, float hi) { unsigned r; asm volatile("v_cvt_pk_bf16_f32 %0, %1, %2" : "=v"(r) : "v"(lo), "v"(hi)); return r; }
DI unsigned pk2(float lo, float hi) { f32x2_t f = {lo, hi}; bf16x2_t v = __builtin_convertvector(f, bf16x2_t); return __builtin_bit_cast(unsigned, v); }
DI float bf2f(unsigned short b) { return __uint_as_float(((unsigned)b) << 16); }
DI float bflo(unsigned w) { return __uint_as_float(w << 16); }
DI float bfhi(unsigned w) { return __uint_as_float(w & 0xffff0000u); }
DI float sigmoidf_(float x) { return __builtin_amdgcn_rcpf(1.f + __builtin_amdgcn_exp2f(-1.4426950408889634f * x)); }
DI float siluf_(float x) { return x * __builtin_amdgcn_rcpf(1.f + __builtin_amdgcn_exp2f(-1.4426950408889634f * x)); }
DI float softplusf_(float x) { return x > 20.f ? x : log1pf(__expf(x)); }
DI float wave_sum(float v) {
#pragma unroll
  for (int o = 1; o < 64; o <<= 1) v += __shfl_xor(v, o);
  return v;
}
DI bf16x8 pack8(f32x4 a, f32x4 b) {
  u32x4 w = {pk2(a[0], a[1]), pk2(a[2], a[3]), pk2(b[0], b[1]), pk2(b[2], b[3])};
  return __builtin_bit_cast(bf16x8, w);
}
DI bf16x8 pack8a(f32x4 a, f32x4 b) {
  u32x4 w = {pk2a(a[0], a[1]), pk2a(a[2], a[3]), pk2a(b[0], b[1]), pk2a(b[2], b[3])};
  return __builtin_bit_cast(bf16x8, w);
}
DI bf16x8 cat8(u32x2 lo, u32x2 hi) { u32x4 w = {lo[0], lo[1], hi[0], hi[1]}; return __builtin_bit_cast(bf16x8, w); }
#define MFMA16(a, b, c) __builtin_amdgcn_mfma_f32_16x16x32_bf16((a), (b), (c), 0, 0, 0)

namespace pg8 {
constexpr int BM = 256, BK = 64, HALF = 128, HTB = HALF * BK * 2, STAGE_BYTES = 8 * HTB, NXCD = 8, WGM = 8;
DI int lds_byte(int r, int c) { const int st = (r >> 4) * 2 + (c >> 5), rr = r & 15, cc = c & 31, ob = rr * 64 + cc * 2; return st * 1024 + (ob ^ (((ob >> 9) & 1) << 5)); }
DI void stage_rc(int b, int& R, int& C) { const int st = b / 1024, sb = b % 1024, swz = sb ^ (((sb >> 9) & 1) << 5); R = (st >> 1) * 16 + swz / 64; C = (st & 1) * 32 + (swz % 64) / 2; }

struct Unit { const char* A; const char* B; int row0, col0, kind, nvalid, aux; };
struct Gemm { int lda, ldb, K; int delay; };

DI void tile_order(int L, int nM, int nN, int& pm, int& pn) {
  const int nwg = nM * nN; int wgid = L;
  { const int q = nwg / NXCD, r = nwg % NXCD, xcd = wgid % NXCD, off = wgid / NXCD; wgid = (xcd < r ? xcd * (q + 1) : r * (q + 1) + (xcd - r) * q) + off; }
  const int nig = WGM * nN, gid = wgid / nig, fm = gid * WGM, gsz = (nM - fm) < WGM ? (nM - fm) : WGM;
  pm = fm + ((wgid % nig) % gsz); pn = (wgid % nig) / gsz;
}

template <class Epi, class Sched>
DI void gemm_phase(LAS unsigned char* lds, const Gemm g, const Sched& S, const Epi& E) {
  int tid = threadIdx.x; asm volatile("" : "+v"(tid));
  const int wid = __builtin_amdgcn_readfirstlane(tid >> 6), lane = tid & 63, wr = wid >> 2, wc = wid & 3, fr = lane & 15, fq = lane >> 4;
  int K = g.K; asm volatile("" : "+s"(K));
  const int nt = K / BK;
  unsigned voffA[2], voffB[2];
#pragma unroll
  for (int i = 0; i < 2; ++i) { int R, C; stage_rc(tid * 16 + i * 8192, R, C);
    voffA[i] = (unsigned)(R * g.lda + C) * 2u; voffB[i] = (unsigned)(R * g.ldb + C) * 2u; }
  const size_t kstep = (size_t)(BK * 2);
  const size_t hstepA = (size_t)HALF * g.lda * 2, hstepB = (size_t)HALF * g.ldb * 2;
  const unsigned ldsw = (unsigned)wid * 1024u;
  const int aoff = lds_byte(wr * 64 + fr, fq * 8), boff = lds_byte(wc * 32 + fr, fq * 8);
#define PG8_SA(b, h) (((b) * 2 + (h)) * HTB)
#define PG8_SB(b, h) ((4 + (b) * 2 + (h)) * HTB)
#define PG8_STAGE(bufoff, gbase, voff) do { _Pragma("unroll") for (int _i = 0; _i < 2; ++_i) \
        __builtin_amdgcn_global_load_lds((const unsigned*)((const char*)(gbase) + (voff)[_i]), (LAS unsigned*)(lds + (bufoff) + ldsw + _i * 8192), 16, 0, 0); } while (0)
#define PG8_LDA(dst, b, h) do { _Pragma("unroll") for (int m = 0; m < 4; ++m) _Pragma("unroll") for (int k = 0; k < 2; ++k) dst[m][k] = *(const LAS bf16x8*)(lds + PG8_SA(b, h) + aoff + m * 2048 + k * 1024); } while (0)
#define PG8_LDB(dst, b, h) do { _Pragma("unroll") for (int n = 0; n < 2; ++n) _Pragma("unroll") for (int k = 0; k < 2; ++k) dst[n][k] = *(const LAS bf16x8*)(lds + PG8_SB(b, h) + boff + n * 2048 + k * 1024); } while (0)
#define PG8_MMA(ai, bj, At, Bt) do { __builtin_amdgcn_s_setprio(1); _Pragma("unroll") for (int m = 0; m < 4; ++m) _Pragma("unroll") for (int n = 0; n < 2; ++n) _Pragma("unroll") for (int k = 0; k < 2; ++k) \
        acc[ai][bj][m][n] = __builtin_amdgcn_mfma_f32_16x16x32_bf16(Bt[n][k], At[m][k], acc[ai][bj][m][n], 0, 0, 0); __builtin_amdgcn_s_setprio(0); } while (0)
#define PG8_WAIT_V(n) asm volatile("s_waitcnt vmcnt(" #n ")" ::: "memory")
#define PG8_WAIT_L(n) asm volatile("s_waitcnt lgkmcnt(" #n ")" ::: "memory")
#define PG8_BAR __builtin_amdgcn_s_barrier()
#define PG8_SCHED __builtin_amdgcn_sched_barrier(0)
  Unit cur, nxt; int ui = 0;
  if (!S.next(0, cur)) return;
  if (g.delay > 0) { const unsigned long long t0_ = __builtin_amdgcn_s_memrealtime(); while ((long long)(__builtin_amdgcn_s_memrealtime() - t0_) < (long long)g.delay) __builtin_amdgcn_s_sleep(16); }
  f32x4 acc[2][2][4][2];
#pragma unroll
  for (int a = 0; a < 2; ++a)
#pragma unroll
    for (int b = 0; b < 2; ++b)
#pragma unroll
      for (int m = 0; m < 4; ++m)
#pragma unroll
        for (int n = 0; n < 2; ++n) acc[a][b][m][n] = (f32x4){0.f, 0.f, 0.f, 0.f};
  bf16x8 At[4][2], B0[2][2], B1[2][2];
  const char* cA = cur.A; const char* cB = cur.B;
  PG8_STAGE(PG8_SB(0, 0), cB, voffB); PG8_STAGE(PG8_SA(0, 0), cA, voffA); PG8_STAGE(PG8_SB(0, 1), cB + hstepB, voffB); PG8_STAGE(PG8_SA(0, 1), cA + hstepA, voffA);
  if (wr == 1) PG8_BAR;
  PG8_WAIT_V(4); PG8_BAR;
  PG8_STAGE(PG8_SB(1, 0), cB + kstep, voffB); PG8_STAGE(PG8_SA(1, 0), cA + kstep, voffA); PG8_STAGE(PG8_SB(1, 1), cB + hstepB + kstep, voffB);
  PG8_WAIT_V(6); PG8_BAR;
  for (;;) {
    const bool has_next = S.next(ui + 1, nxt);
    const char* nA = has_next ? nxt.A : cA; const char* nB = has_next ? nxt.B : cB;
    for (int t = 0; t < nt; t += 2) {
      const bool last = (t == nt - 2);
      if constexpr (Epi::HOOK) { if (t == 32 || t == 64) E.rescale(acc, cur, t >> 5, wr, wc, fr, fq); }
      const char* a1 = cA + (size_t)(t + 1) * kstep;
      const char* a2 = last ? nA : cA + (size_t)(t + 2) * kstep; const char* b2 = last ? nB : cB + (size_t)(t + 2) * kstep;
      const char* a3 = a2 + kstep; const char* b3 = b2 + kstep;
      PG8_LDB(B0, 0, 0); PG8_SCHED; PG8_LDA(At, 0, 0); PG8_STAGE(PG8_SA(1, 1), a1 + hstepA, voffA);
      PG8_WAIT_L(8); PG8_BAR; PG8_WAIT_L(0); PG8_MMA(0, 0, At, B0); PG8_BAR; PG8_SCHED;
      PG8_LDB(B1, 0, 1); PG8_STAGE(PG8_SB(0, 0), b2, voffB);
      PG8_BAR; PG8_WAIT_L(0); PG8_MMA(0, 1, At, B1); PG8_BAR;
      PG8_LDA(At, 0, 1); PG8_STAGE(PG8_SA(0, 0), a2, voffA);
      PG8_BAR; PG8_WAIT_L(0); PG8_MMA(1, 0, At, B0); PG8_BAR; PG8_SCHED;
      PG8_STAGE(PG8_SB(0, 1), b2 + hstepB, voffB);
      PG8_WAIT_V(6); PG8_BAR; PG8_MMA(1, 1, At, B1); PG8_BAR;
      PG8_LDB(B0, 1, 0); PG8_SCHED; PG8_LDA(At, 1, 0); PG8_STAGE(PG8_SA(0, 1), a2 + hstepA, voffA);
      PG8_WAIT_L(8); PG8_BAR; PG8_WAIT_L(0); PG8_MMA(0, 0, At, B0); PG8_BAR; PG8_SCHED;
      PG8_LDB(B1, 1, 1); PG8_STAGE(PG8_SB(1, 0), b3, voffB);
      PG8_BAR; PG8_WAIT_L(0); PG8_MMA(0, 1, At, B1); PG8_BAR;
      PG8_LDA(At, 1, 1); PG8_STAGE(PG8_SA(1, 0), a3, voffA);
      PG8_BAR; PG8_WAIT_L(0); PG8_MMA(1, 0, At, B0); PG8_BAR; PG8_SCHED;
      PG8_STAGE(PG8_SB(1, 1), b3 + hstepB, voffB);
      PG8_WAIT_V(6); PG8_BAR; PG8_MMA(1, 1, At, B1); PG8_BAR;
    }
    E(acc, cur, wr, wc, fr, fq);
    if (!has_next) break;
#pragma unroll
    for (int a = 0; a < 2; ++a)
#pragma unroll
      for (int b = 0; b < 2; ++b)
#pragma unroll
        for (int m = 0; m < 4; ++m)
#pragma unroll
          for (int n = 0; n < 2; ++n) acc[a][b][m][n] = (f32x4){0.f, 0.f, 0.f, 0.f};
    cur = nxt; cA = nA; cB = nB; ++ui;
  }
  PG8_WAIT_V(0);
  if (wr == 0) PG8_BAR;
  PG8_BAR;
#undef PG8_SA
#undef PG8_SB
#undef PG8_STAGE
#undef PG8_LDA
#undef PG8_LDB
#undef PG8_MMA
#undef PG8_WAIT_V
#undef PG8_WAIT_L
#undef PG8_BAR
#undef PG8_SCHED
}
}
using pg8::Unit;
typedef const f32x4 (&AccRef)[2][2][4][2];

DI void st_bf4(bf16_t* p, f32x4 v) { u32x2 w = {pk2(v[0], v[1]), pk2(v[2], v[3])}; *(u32x2*)p = w; }
DI void st_bf4a(bf16_t* p, f32x4 v) { u32x2 w = {pk2a(v[0], v[1]), pk2a(v[2], v[3])}; *(u32x2*)p = w; }
DI f32x4 ld_bf4(const bf16_t* p) { u32x2 w = *(const u32x2*)p; return (f32x4){bflo(w[0]), bfhi(w[0]), bflo(w[1]), bfhi(w[1])}; }

struct EpiIn {
  static constexpr bool HOOK = false;
  Params P; LAS unsigned char* ldsb;
  DI void rescale(f32x4 (&)[2][2][4][2], const Unit&, int, int, int, int, int) const {}
  DI void operator()(AccRef acc, const Unit& u, int wr, int wc, int fr, int fq) const {
    unsigned char* ws = P.ws; float* out = P.out;
    if (u.kind == 1) {
      const bool isV = u.col0 >= 2048; const int cb = isV ? u.col0 - 2048 : u.col0;
      float* fo = out + (isV ? O_MVP : O_MKP);
      bf16_t* MKP = (bf16_t*)(ws + W_MKP); bf16_t* VTP = (bf16_t*)(ws + W_VTP);
#pragma unroll
      for (int ai = 0; ai < 2; ++ai)
#pragma unroll
        for (int m = 0; m < 4; ++m) {
          const int row = u.row0 + ai * 128 + wr * 64 + m * 16 + fr;
#pragma unroll
          for (int bj = 0; bj < 2; ++bj)
#pragma unroll
            for (int n = 0; n < 2; ++n) {
              const int c = cb + bj * 128 + wc * 32 + n * 16 + 4 * fq;
              const f32x4 v = acc[ai][bj][m][n];
              *(f32x4*)(fo + (size_t)row * 2048 + c) = v;
              if (!isV) st_bf4(MKP + (size_t)row * 2048 + c, v);
              else { const int b = row >> 8, key = row & 255, h = c >> 9, d = c & 511;
                bf16_t* vt = VTP + ((size_t)((b * 4 + h) * 512 + d)) * 256 + key;
                const unsigned w0 = pk2(v[0], v[1]), w1 = pk2(v[2], v[3]);
                vt[0] = (bf16_t)(w0 & 0xffff); vt[256] = (bf16_t)(w0 >> 16); vt[512] = (bf16_t)(w1 & 0xffff); vt[768] = (bf16_t)(w1 >> 16); }
            }
        }
      return;
    }
    const bool sample = u.row0 >= MP;
    const int T = sample ? 64 : 2048;
    const int col0 = u.col0;
    if (col0 >= 23552) {
      if (wc > 1) return;
      const float* dtb = P.in[14]; const float* bfg = P.in[18];
      float* DT = (float*)(ws + W_DT);
      float* LFT = (float*)(ws + W_LFT); float* LFS = (float*)(ws + W_LFS);
#pragma unroll
      for (int ai = 0; ai < 2; ++ai)
#pragma unroll
        for (int m = 0; m < 4; ++m) {
          const int row = u.row0 + ai * 128 + wr * 64 + m * 16 + fr;
          const int rs = row - MP; const int b = sample ? (rs >> 6) : (row >> 11), t = sample ? (rs & 63) : (row & 2047);
#pragma unroll
          for (int n = 0; n < 2; ++n) {
            const int c = wc * 32 + n * 16 + 4 * fq;
            const f32x4 v = acc[ai][0][m][n];
            if (c < 32) { f32x4 o;
#pragma unroll
              for (int e = 0; e < 4; ++e) o[e] = softplusf_(v[e] + dtb[c + e]);
              *(f32x4*)(DT + (size_t)row * 32 + c) = o; }
            else if (c < 48) { const int h0 = c - 32; f32x4 o;
#pragma unroll
              for (int e = 0; e < 4; ++e) o[e] = -softplusf_(-(v[e] + bfg[h0 + e]));
              float* lo = sample ? out + O_FLS + (size_t)rs * 16 + h0 : out + O_FLP + (size_t)row * 16 + h0;
              *(f32x4*)lo = o;
#pragma unroll
              for (int e = 0; e < 4; ++e) { if (sample) LFS[(size_t)(b * 16 + h0 + e) * 1088 + 1024 + t] = o[e]; else LFT[(size_t)(b * 16 + h0 + e) * 2048 + t] = o[e]; }
            }
          }
        }
      return;
    }
    const bool smp = sample;
    if (col0 < 2048) seg_store<1, 0, false, false>(acc, u, wr, wc, fr, fq, (bf16_t*)(ws + W_ZB), 2048, col0, nullptr, nullptr, smp);
    else if (col0 < 5120) seg_store<0, 1, false, true>(acc, u, wr, wc, fr, fq, (bf16_t*)(ws + (smp ? W_XBCS : W_XBCP)), 3072, col0 - 2048, nullptr, out + (smp ? O_CONVS : O_CONVP), smp);
    else if (col0 < 7168) seg_store<0, 0, false, false>(acc, u, wr, wc, fr, fq, (bf16_t*)(ws + W_FQ), 2048, col0 - 5120, nullptr, nullptr, smp);
    else if (col0 < 9216) seg_store<0, 2, true, false>(acc, u, wr, wc, fr, fq, (bf16_t*)(ws + (smp ? W_KS : W_FK)), 2048, col0 - 7168, out + (smp ? O_FKS : O_FKP), nullptr, smp);
    else if (col0 < 11264) seg_store<0, 2, true, false>(acc, u, wr, wc, fr, fq, (bf16_t*)(ws + (smp ? W_VS : W_FV)), 2048, col0 - 9216, out + (smp ? O_FVS : O_FVP), nullptr, smp);
    else if (col0 < 13312) seg_store<1, 0, false, false>(acc, u, wr, wc, fr, fq, (bf16_t*)(ws + W_FG), 2048, col0 - 11264, nullptr, nullptr, smp);
    else if (col0 < 15360) seg_store<0, 0, false, false>(acc, u, wr, wc, fr, fq, (bf16_t*)(ws + W_MQ), 2048, col0 - 13312, nullptr, nullptr, smp);
    else if (col0 < 17408) seg_store<1, 0, false, false>(acc, u, wr, wc, fr, fq, (bf16_t*)(ws + W_MG), 2048, col0 - 15360, nullptr, nullptr, smp);
    else seg_store<2, 0, false, false>(acc, u, wr, wc, fr, fq, (bf16_t*)(ws + W_G3), 6144, col0 - 17408, nullptr, nullptr, smp);
  }
  template <int ACT, int ROWMODE, bool HASF, bool HASCONV>
  DI void seg_store(AccRef acc, const Unit& u, int wr, int wc, int fr, int fq, bf16_t* dst, int ld, int c0, float* fout, float* convout, bool sample) const {
    const int T = sample ? 64 : 2048;
    const int cl = c0 + wc * 32 + 4 * fq;
    const int lane = fr + 16 * fq, wid = wr * 4 + wc;
    LAS unsigned char* stg = ldsb + 131072 + wid * 1280;
    const int rS = lane >> 2, cS = (lane & 3) * 8;
#pragma unroll
    for (int ai = 0; ai < 2; ++ai)
#pragma unroll
      for (int m = 0; m < 4; ++m) {
        const int row = u.row0 + ai * 128 + wr * 64 + m * 16 + fr;
        const int rs = row - MP; const int b = sample ? (rs >> 6) : (row >> 11), t = sample ? (rs & 63) : (row & 2047);
        float* fp = HASF ? fout + (sample ? (size_t)rs : (size_t)row) * 2048 + cl : nullptr;
        const bool ctail = HASCONV && t >= T - 3;
        float* cp = HASCONV ? convout + (size_t)(b * 3 + t - (T - 3)) * 3072 + cl : nullptr;
        const int rowS = u.row0 + ai * 128 + wr * 64 + m * 16 + rS;
        size_t drow = (size_t)rowS;
        if (ROWMODE != 0) { const int rsS = rowS - MP; const int bS = sample ? (rsS >> 6) : (rowS >> 11), tS = sample ? (rsS & 63) : (rowS & 2047);
          if (ROWMODE == 1) drow = sample ? (size_t)(bS * 67 + 3 + tS) : (size_t)(bS * 2051 + 3 + tS);
          else drow = sample ? (size_t)(bS * 1088 + 1024 + tS) : (size_t)rowS; }
        bf16_t* dp = dst + drow * ld + c0 + wc * 32 + cS;
#pragma unroll
        for (int bj = 0; bj < 2; ++bj) {
#pragma unroll
          for (int n = 0; n < 2; ++n) {
            const int co = bj * 128 + n * 16;
            f32x4 v = acc[ai][bj][m][n];
            if (HASF) __builtin_nontemporal_store(v, (f32x4*)(fp + co));
            if (HASCONV) { if (ctail) *(f32x4*)(cp + co) = v; }
            if (ACT == 1) {
#pragma unroll
              for (int e = 0; e < 4; ++e) v[e] = siluf_(v[e]);
            } else if (ACT == 2) {
#pragma unroll
              for (int e = 0; e < 4; ++e) v[e] = sigmoidf_(v[e]);
            }
            u32x2 w = {pk2(v[0], v[1]), pk2(v[2], v[3])};
            *(LAS u32x2*)(stg + fr * 80 + n * 32 + fq * 8) = w;
          }
          const u32x4 o = *(const LAS u32x4*)(stg + rS * 80 + cS * 2);
          *(u32x4*)(dp + bj * 128) = o;
        }
      }
  }
};
struct SchedP1 {
  int c, G; const char* XB; const char* WIN; const char* MB; const char* WMEM;
  DI bool next(int i, Unit& u) const {
    const int L = i * G + c;
    constexpr int N1 = 130 * 93;
    if (L < N1) { int pm, pn; pg8::tile_order(L, 130, 93, pm, pn);
      u.A = XB + (size_t)pm * 256 * 2048 * 2; u.B = WIN + (size_t)pn * 256 * 2048 * 2; u.row0 = pm * 256; u.col0 = pn * 256; u.kind = 0; u.nvalid = 256; u.aux = 0; return true; }
    const int L2 = L - N1; if (L2 >= 256) return false;
    int pm, pn; pg8::tile_order(L2, 16, 16, pm, pn);
    u.A = MB + (size_t)pm * 256 * 2048 * 2; u.B = WMEM + (size_t)pn * 256 * 2048 * 2; u.row0 = pm * 256; u.col0 = pn * 256; u.kind = 1; u.nvalid = 256; u.aux = 0; return true;
  }
};

struct EpiS {
  static constexpr bool HOOK = false;
  Params P;
  DI void rescale(f32x4 (&)[2][2][4][2], const Unit&, int, int, int, int, int) const {}
  DI void operator()(AccRef acc, const Unit& u, int wr, int wc, int fr, int fq) const {
    bf16_t* PM = (bf16_t*)(P.ws + W_PM); float* PSUM = (float*)(P.ws + W_PSUM);
    const float c2 = 0.044194173824159216f * 1.4426950408889634f;
    const int h = u.aux;
#pragma unroll
    for (int ai = 0; ai < 2; ++ai)
#pragma unroll
      for (int m = 0; m < 4; ++m) {
        const int rr = ai * 128 + wr * 64 + m * 16 + fr; const int row = u.row0 + rr; const bool ok = rr < u.nvalid;
        float s = 0.f;
#pragma unroll
        for (int bj = 0; bj < 2; ++bj)
#pragma unroll
          for (int n = 0; n < 2; ++n) {
            const int c = bj * 128 + wc * 32 + n * 16 + 4 * fq;
            f32x4 e;
#pragma unroll
            for (int k = 0; k < 4; ++k) { e[k] = __builtin_amdgcn_exp2f(fminf(acc[ai][bj][m][n][k] * c2, 100.f)); s += e[k]; }
            if (ok) st_bf4(PM + (size_t)row * 1024 + h * 256 + c, e);
          }
        s += __shfl_xor(s, 16); s += __shfl_xor(s, 32);
        if (ok && fq == 0) PSUM[(size_t)row * 16 + h * 4 + wc] = s;
      }
  }
};
struct SchedS {
  int c, G; const char* MQ; const char* MKP; const char* MKS;
  DI bool next(int i, Unit& u) const {
    const int L = i * G + c; if (L >= 544) return false;
    u.col0 = 0; u.kind = 0;
    if (L < 512) { const int b = L >> 5, h = (L >> 3) & 3, mt = L & 7; u.row0 = b * 2048 + mt * 256; u.nvalid = 256; u.aux = h;
      u.A = MQ + ((size_t)u.row0 * 2048 + h * 512) * 2; u.B = MKP + ((size_t)(b * 256) * 2048 + h * 512) * 2; }
    else { const int j = L - 512, b = j >> 2, h = j & 3; u.row0 = MP + b * 64; u.nvalid = 64; u.aux = h;
      u.A = MQ + ((size_t)u.row0 * 2048 + h * 512) * 2; u.B = MKS + ((size_t)(b * 256) * 2048 + h * 512) * 2; }
    return true;
  }
};
struct EpiPV {
  static constexpr bool HOOK = false;
  Params P;
  DI void rescale(f32x4 (&)[2][2][4][2], const Unit&, int, int, int, int, int) const {}
  DI void operator()(AccRef acc, const Unit& u, int wr, int wc, int fr, int fq) const {
    const float* PSUM = (const float*)(P.ws + W_PSUM); const bf16_t* MG = (const bf16_t*)(P.ws + W_MG); bf16_t* Y3 = (bf16_t*)(P.ws + W_Y3);
    const int h = u.aux >> 9;
#pragma unroll
    for (int ai = 0; ai < 2; ++ai)
#pragma unroll
      for (int m = 0; m < 4; ++m) {
        int rr = ai * 128 + wr * 64 + m * 16 + fr; asm volatile("" : "+v"(rr)); const int row = u.row0 + rr;
        if (!(m & 1)) __builtin_amdgcn_sched_barrier(0);
        if (rr < u.nvalid) {
          const f32x4 ps = *(const f32x4*)(PSUM + (size_t)row * 16 + h * 4);
          const float inv = 1.f / ((ps[0] + ps[1]) + (ps[2] + ps[3]));
#pragma unroll
          for (int bj = 0; bj < 2; ++bj)
#pragma unroll
            for (int n = 0; n < 2; ++n) {
              const int c = u.aux + bj * 128 + wc * 32 + n * 16 + 4 * fq;
              const f32x4 gte = ld_bf4(MG + (size_t)row * 2048 + c);
              st_bf4(Y3 + (size_t)row * 6144 + 4096 + c, acc[ai][bj][m][n] * gte * inv);
            }
        }
      }
  }
};
struct SchedPV {
  int c, G; const char* PM; const char* VTP; const char* VTS;
  DI bool next(int i, Unit& u) const {
    const int L = i * G + c; if (L >= 1088) return false;
    u.col0 = 0; u.kind = 0;
    if (L < 1024) { const int b = L >> 6, h = (L >> 4) & 3, mt = (L >> 1) & 7, n2 = L & 1; u.row0 = b * 2048 + mt * 256; u.nvalid = 256; u.aux = h * 512 + n2 * 256;
      u.A = PM + ((size_t)u.row0 * 1024 + h * 256) * 2; u.B = VTP + ((size_t)((b * 4 + h) * 512 + n2 * 256) * 256) * 2; }
    else { const int j = L - 1024, b = j >> 3, h = (j >> 1) & 3, n2 = j & 1; u.row0 = MP + b * 64; u.nvalid = 64; u.aux = h * 512 + n2 * 256;
      u.A = PM + ((size_t)u.row0 * 1024 + h * 256) * 2; u.B = VTS + ((size_t)((b * 4 + h) * 512 + n2 * 256) * 256) * 2; }
    return true;
  }
};

struct EpiMerge {
  static constexpr bool HOOK = false;
  Params P;
  DI void rescale(f32x4 (&)[2][2][4][2], const Unit&, int, int, int, int, int) const {}
  DI void operator()(AccRef acc, const Unit& u, int wr, int wc, int fr, int fq) const {
    const bf16_t* G3 = (const bf16_t*)(P.ws + W_G3); bf16_t* MRG = (bf16_t*)(P.ws + W_MRG); bf16_t* TMP = (bf16_t*)(P.ws + W_TMP);
    float* PARTM = (float*)(P.ws + W_PARTM);
    const float* RS = (const float*)(P.ws + W_RS);
    const int seg = u.kind >= 3 ? u.kind - 3 : u.kind; const bool part = u.kind >= 3;
#pragma unroll
    for (int ai = 0; ai < 2; ++ai)
#pragma unroll
      for (int m = 0; m < 4; ++m) {
        int row = u.row0 + ai * 128 + wr * 64 + m * 16 + fr; asm volatile("" : "+v"(row));
        const float rs = (seg == 0) ? RS[row] : 1.f;
#pragma unroll
        for (int bj = 0; bj < 2; ++bj)
#pragma unroll
          for (int n = 0; n < 2; ++n) {
            const int c = u.col0 + bj * 128 + wc * 32 + n * 16 + 4 * fq;
            const f32x4 gte = ld_bf4(G3 + (size_t)row * 6144 + seg * 2048 + c);
            f32x4 v = acc[ai][bj][m][n] * gte * rs;
            const size_t to = (size_t)row * 2048 + c;
            if (part) { *(f32x4*)(PARTM + ((size_t)seg * MS + (row - MP)) * 2048 + c) = v; }
            else {
              if (seg > 0) v += ld_bf4(TMP + to);
              if (seg < 2) st_bf4(TMP + to, v); else st_bf4(MRG + to, v);
            }
          }
        if (m & 1) __builtin_amdgcn_sched_barrier(0);
      }
  }
};
struct SchedMerge {
  int c, G; const char* A; const char* B;
  DI bool next(int i, Unit& u) const {
    int pm, pn, seg, kind;
    if (i < 12) { const int ti = i / 3; seg = i - ti * 3; const int L = ti * 256 + c; pm = (L >> 6) * 8 + (L & 7); pn = (L >> 3) & 7; kind = seg; }
    else if (i == 12 && c < 48) { const int e = c / 3; seg = c - e * 3; pm = 128 + (e >> 3); pn = e & 7; kind = 3 + seg; }
    else return false;
    u.A = A + ((size_t)pm * 256 * 6144 + seg * 2048) * 2; u.B = B + ((size_t)pn * 256 * 6144 + seg * 2048) * 2; u.row0 = pm * 256; u.col0 = pn * 256; u.kind = kind; u.nvalid = 256; u.aux = pn; return true;
  }
};
struct SchedOutP {
  int c; const char* A; const char* B;
  DI bool next(int i, Unit& u) const {
    if (i >= 4) return false;
    const int L = i * 256 + c; const int pm = (L >> 6) * 8 + (L & 7), pn = (L >> 3) & 7;
    u.A = A + (size_t)pm * 256 * 2048 * 2; u.B = B + (size_t)pn * 256 * 2048 * 2; u.row0 = pm * 256; u.col0 = pn * 256; u.kind = 0; u.nvalid = 256; u.aux = pn; return true;
  }
};
struct SchedOutS {
  int c; const char* A; const char* B;
  DI bool next(int i, Unit& u) const {
    if (i >= 1 || c >= 64) return false;
    const int e = c >> 2, kq = c & 3; const int pm = 128 + (e >> 3), pn = e & 7;
    u.A = A + ((size_t)pm * 256 * 2048 + kq * 512) * 2; u.B = B + ((size_t)pn * 256 * 2048 + kq * 512) * 2; u.row0 = pm * 256; u.col0 = pn * 256; u.kind = 1; u.nvalid = kq; u.aux = pn; return true;
  }
};
struct SchedTile {
  int c, G, nM, nN; const char* A; const char* B; size_t astep, bstep;
  DI bool next(int i, Unit& u) const {
    const int L = i * G + c; if (L >= nM * nN) return false;
    int pm, pn; pg8::tile_order(L, nM, nN, pm, pn);
    u.A = A + (size_t)pm * astep; u.B = B + (size_t)pn * bstep; u.row0 = pm * 256; u.col0 = pn * 256; u.kind = 0; u.nvalid = 256; u.aux = pn; return true;
  }
};
struct EpiOut {
  static constexpr bool HOOK = false;
  Params P;
  DI void rescale(f32x4 (&)[2][2][4][2], const Unit&, int, int, int, int, int) const {}
  DI void operator()(AccRef acc, const Unit& u, int wr, int wc, int fr, int fq) const {
    float* out = P.out; float* PARTO = (float*)(P.ws + W_PARTO);
    if (u.kind == 1) {
      float* PART5 = (float*)(P.ws + W_PART5) + (size_t)u.nvalid * MS * 2048;
#pragma unroll
      for (int ai = 0; ai < 2; ++ai)
#pragma unroll
        for (int m = 0; m < 4; ++m) {
          const int row = u.row0 + ai * 128 + wr * 64 + m * 16 + fr - MP;
#pragma unroll
          for (int bj = 0; bj < 2; ++bj)
#pragma unroll
            for (int n = 0; n < 2; ++n) *(f32x4*)(PART5 + (size_t)row * 2048 + u.col0 + bj * 128 + wc * 32 + n * 16 + 4 * fq) = acc[ai][bj][m][n];
        }
      return;
    }
    const float* xin = P.in[0];
#pragma unroll
    for (int ai = 0; ai < 2; ++ai)
#pragma unroll
      for (int m = 0; m < 4; ++m) {
        const int row = u.row0 + ai * 128 + wr * 64 + m * 16 + fr;
        float s = 0.f;
#pragma unroll
        for (int bj = 0; bj < 2; ++bj)
#pragma unroll
          for (int n = 0; n < 2; ++n) {
            const int c = u.col0 + bj * 128 + wc * 32 + n * 16 + 4 * fq;
            const f32x4 xo = acc[ai][bj][m][n] + *(const f32x4*)(xin + (size_t)row * 2048 + c);
            *(f32x4*)(out + (size_t)row * 2048 + c) = xo;
            s += xo[0] * xo[0] + xo[1] * xo[1] + xo[2] * xo[2] + xo[3] * xo[3];
          }
        s += __shfl_xor(s, 16); s += __shfl_xor(s, 32);
        if (fq == 0) PARTO[(size_t)row * 32 + u.aux * 4 + wc] = s;
      }
  }
};

DI void row_to_bf16(const float* src, bf16_t* dst, float* rs, int lane) {
  const f32x4* s = (const f32x4*)src + lane; f32x4 v[8]; float ss = 0.f;
#pragma unroll
  for (int j = 0; j < 8; ++j) { v[j] = s[64 * j]; ss += (v[j][0] * v[j][0] + v[j][1] * v[j][1]) + (v[j][2] * v[j][2] + v[j][3] * v[j][3]); }
  float sc = 1.f;
  if (rs) { ss = wave_sum(ss); sc = rsqrtf(ss * (1.f / 2048.f) + EPS); }
  u32x2* d = (u32x2*)dst + lane;
#pragma unroll
  for (int j = 0; j < 8; ++j) { u32x2 w = {pk2(v[j][0] * sc, v[j][1] * sc), pk2(v[j][2] * sc, v[j][3] * sc)}; d[64 * j] = w; }
}
DI void transpose_item(const float* W, int ldw, int scol0, int nvalid, const float* scale, bf16_t* WT, int ldd, int drow0, int dcol0, int kb, LAS float* scr, int lane) {
  const int k0 = 64 * kb;
  float tv[32];
  const bool ok_ = (lane & 31) < nvalid;
#pragma unroll
  for (int i = 0; i < 32; ++i) { const int kk = 2 * i + (lane >> 5); tv[i] = ok_ ? W[(size_t)(k0 + kk) * ldw + scol0 + (lane & 31)] : 0.f; }
#pragma unroll
  for (int i = 0; i < 32; ++i) { const int kk = 2 * i + (lane >> 5), n = lane & 31;
    float v = tv[i]; if (scale) v *= scale[k0 + kk];
    scr[kk * 33 + n] = v; }
  asm volatile("s_waitcnt lgkmcnt(0)" ::: "memory");
  const int c = lane & 7;
#pragma unroll
  for (int j = 0; j < 4; ++j) { const int n = (lane >> 3) + 8 * j; const LAS float* s = scr + (8 * c) * 33 + n;
    u32x4 o; o[0] = pk2(s[0 * 33], s[1 * 33]); o[1] = pk2(s[2 * 33], s[3 * 33]); o[2] = pk2(s[4 * 33], s[5 * 33]); o[3] = pk2(s[6 * 33], s[7 * 33]);
    *(u32x4*)(WT + (size_t)(drow0 + n) * ldd + dcol0 + k0 + 8 * c) = o; }
  asm volatile("s_waitcnt lgkmcnt(0)" ::: "memory");
}
DI void phase0(const Params& P, LAS unsigned char* lds) {
  unsigned char* ws = P.ws;
  int tid = threadIdx.x; asm volatile("" : "+v"(tid));
  const int wid = tid >> 6, lane = tid & 63;
  const int gw = blockIdx.x * 8 + wid, NGW = gridDim.x * 8;
  if (blockIdx.x == 0 && tid < 64) ((unsigned*)(ws + W_CTL))[tid] = 0u;
  constexpr int NR = MT + 4096 + 8192;
  for (int r = gw; r < NR; r += NGW) {
    if (r < MP) row_to_bf16(P.in[0] + (size_t)r * 2048, (bf16_t*)(ws + W_XB) + (size_t)r * 2048, (float*)(ws + W_R1), lane);
    else if (r < MT) row_to_bf16(P.in[1] + (size_t)(r - MP) * 2048, (bf16_t*)(ws + W_XB) + (size_t)r * 2048, (float*)(ws + W_R1), lane);
    else if (r < MT + 4096) { const int q = r - MT; row_to_bf16(P.in[2] + (size_t)q * 2048, (bf16_t*)(ws + W_MB) + (size_t)q * 2048, (float*)(ws + W_RM), lane); }
    else if (r < MT + 4096 + 8192) { const int q = r - MT - 4096, b = q >> 10, j = q & 1023; row_to_bf16(P.in[3] + (size_t)q * 2048, (bf16_t*)(ws + W_KS) + (size_t)(b * 1088 + j) * 2048, nullptr, lane); }
    else if (r < MT + 4096 + 16384) { continue; }
    else { continue; }
  }
  LAS float* scr = (LAS float*)(lds + wid * 8448);
  constexpr int I_IN = 744 * 32, I_MEM = 128 * 32, I_O = 64 * 32;
  constexpr int NITEMS = I_IN + I_MEM + 4 * I_O;
  for (int it = gw; it < NITEMS; it += NGW) {
    int r = it;
    if (r < I_IN) { const int nb = r >> 5, kb = r & 31, d = nb * 32; int src, nv = 32;
      if (d < 5120) src = d; else if (d < 13312) src = d + 32; else if (d < 23552) src = d + 48;
      else if (d == 23552) src = 5120; else if (d == 23584) { src = 13344; nv = 16; } else { src = 0; nv = 0; }
      transpose_item(P.in[11], 23600, src, nv, P.in[10], (bf16_t*)(ws + W_WIN), 2048, d, 0, kb, scr, lane); continue; }
    r -= I_IN;
    if (r < I_MEM) { const int nb = r >> 5, kb = r & 31; transpose_item(P.in[20], 4096, nb * 32, 32, P.in[19], (bf16_t*)(ws + W_WMEM), 2048, nb * 32, 0, kb, scr, lane); continue; }
    r -= I_MEM;
    if (r < I_O) { const int nb = r >> 5, kb = r & 31; transpose_item(P.in[21], 2048, nb * 32, 32, P.in[17], (bf16_t*)(ws + W_WO), 6144, nb * 32, 0, kb, scr, lane); continue; }
    r -= I_O;
    if (r < I_O) { const int nb = r >> 5, kb = r & 31; transpose_item(P.in[22], 2048, nb * 32, 32, nullptr, (bf16_t*)(ws + W_WO), 6144, nb * 32, 2048, kb, scr, lane); continue; }
    r -= I_O;
    if (r < I_O) { const int nb = r >> 5, kb = r & 31; transpose_item(P.in[23], 2048, nb * 32, 32, nullptr, (bf16_t*)(ws + W_WO), 6144, nb * 32, 4096, kb, scr, lane); continue; }
    r -= I_O;
    { const int nb = r >> 5, kb = r & 31; transpose_item(P.in[24], 2048, nb * 32, 32, nullptr, (bf16_t*)(ws + W_WOUT), 2048, nb * 32, 0, kb, scr, lane); }
  }
  const long gt = (long)blockIdx.x * 512 + tid, NT = (long)gridDim.x * 512;
  for (long i = gt; i < 8L * 1024 * 16; i += NT) { const int h = (int)(i & 15), j = (int)((i >> 4) & 1023), b = (int)(i >> 14);
    ((float*)(ws + W_LFS))[(size_t)(b * 16 + h) * 1088 + j] = P.in[5][i]; }
  for (long i = gt; i < 8L * 3 * 3072; i += NT) { const int c = (int)(i % 3072), r = (int)((i / 3072) % 3), b = (int)(i / 9216);
    ((bf16_t*)(ws + W_XBCS))[(size_t)(b * 67 + r) * 3072 + c] = (bf16_t)(pk2(P.in[7][i], 0.f) & 0xffff); }
  for (long i = gt; i < 16L * 3 * 3072; i += NT) { const int c = (int)(i % 3072), r = (int)((i / 3072) % 3), b = (int)(i / 9216);
    ((bf16_t*)(ws + W_XBCP))[(size_t)(b * 2051 + r) * 3072 + c] = 0; }
}

DI void p1_tail_convert(const Params& P, int part, int nparts) {
  unsigned char* ws = P.ws;
  int tid = threadIdx.x; asm volatile("" : "+v"(tid));
  const int wid = tid >> 6, lane = tid & 63;
  for (int q = part * 8 + wid; q < 8192; q += nparts * 8) { const int b = q >> 10, j = q & 1023;
    row_to_bf16(P.in[4] + (size_t)q * 2048, (bf16_t*)(ws + W_VS) + (size_t)(b * 1088 + j) * 2048, nullptr, lane); }
  for (int q = part * 8 + wid; q < 2048; q += nparts * 8) row_to_bf16(P.in[8] + (size_t)q * 2048, (bf16_t*)(ws + W_MKS) + (size_t)q * 2048, nullptr, lane);
  const long gt = (long)part * 512 + tid, NT = (long)nparts * 512;
  for (long i = gt; i < 8L * 32 * 2048; i += NT) {
    const int hd = (int)(i & 2047), kg = (int)((i >> 11) & 31), b = (int)(i >> 16);
    const float* s = P.in[9] + ((size_t)(b * 256 + kg * 8) * 2048 + hd);
    u32x4 o; o[0] = pk2(s[0], s[2048]); o[1] = pk2(s[2 * 2048], s[3 * 2048]); o[2] = pk2(s[4 * 2048], s[5 * 2048]); o[3] = pk2(s[6 * 2048], s[7 * 2048]);
    *(u32x4*)((bf16_t*)(ws + W_VTS) + ((size_t)(b * 2048 + hd)) * 256 + kg * 8) = o;
  }
}

namespace fa {
constexpr int D = 128, LD = 2048, LDO = 6144;
constexpr float SCALE = 0.08838834764831845f;
constexpr float THR = 8.f;
constexpr int NW = 8, QBLK = 32, KVBLK = 64, QB = NW * QBLK;
constexpr int SHM_V = KVBLK * D * 2, SHM_K = KVBLK * D * 2;
constexpr int TAB_OFF = 2 * SHM_V + 2 * SHM_K + NW * 64 * 4;
constexpr unsigned WBIG = 0x7fffffffu;
constexpr int OSTG_OFF = 77824;
#define KSWZ(row, colB) ((row) * 256 + ((colB) ^ (((row) & 7) << 4)))
#define SBAR() __builtin_amdgcn_sched_barrier(0)
DI int v_st(int k, int c) { const int kk = (k & ~0xC) | ((k & 4) << 1) | ((k & 8) >> 1); return ((kk >> 3) * 4 + (c >> 5)) * 512 + ((kk & 7) * 32 + (c & 31)) * 2; }
DI int v_rd_base(int lane) { return ((lane & 3) << 3) | (((lane >> 2) & 3) << 6) | (((lane >> 4) & 1) << 5) | (((lane >> 5) & 1) << 8); }
constexpr int v_rd_off(int d0, int ks, int half) { return d0 * 512 + ks * 4096 + half * 2048; }
DI int crow(int r, int hi) { return (r & 3) + 8 * (r >> 2) + 4 * hi; }
DI bf16x8 load8(const bf16_t* p) { return *reinterpret_cast<const bf16x8*>(p); }
DI void mask_tile(f32x16& p0, f32x16& p1, int dq, unsigned W) {
  const float NEG = -__builtin_inff();
#pragma unroll
  for (int r = 0; r < 16; ++r) {
    const int c = (r & 3) + 8 * (r >> 2);
    if ((unsigned)(dq - c) >= W) p0[r] = NEG;
    if ((unsigned)(dq - c - 32) >= W) p1[r] = NEG;
  }
}
DI void partialSM(f32x16& p0, f32x16& p1, float& m_reg, float& mn, float& alpha) {
  float pmax = p0[0];
#pragma unroll
  for (int r = 1; r < 16; ++r) pmax = fmaxf(pmax, p0[r]);
#pragma unroll
  for (int r = 0; r < 16; ++r) pmax = fmaxf(pmax, p1[r]);
  { auto rr = __builtin_amdgcn_permlane32_swap(__float_as_uint(pmax), __float_as_uint(pmax), false, false);
    pmax = fmaxf(__uint_as_float(rr[0]), __uint_as_float(rr[1])); }
  constexpr float C2 = 1.4426950408889634f * SCALE;
  if (__builtin_expect(__all((pmax - m_reg) * SCALE <= THR), 1)) { mn = m_reg; alpha = 1.f; }
  else { mn = fmaxf(m_reg, pmax); alpha = __builtin_amdgcn_exp2f((m_reg - mn) * C2); m_reg = mn; }
  const float mnL = -mn * C2;
#pragma unroll
  for (int r = 0; r < 16; ++r) p0[r] = fmaf(p0[r], C2, mnL);
#pragma unroll
  for (int r = 0; r < 16; ++r) p1[r] = fmaf(p1[r], C2, mnL);
#pragma unroll
  for (int r = 0; r < 16; ++r) p0[r] = __builtin_amdgcn_exp2f(p0[r]);
}
DI void finishSM(f32x16& p0, f32x16& p1, float alpha, float& l_reg, bf16x8& pa0, bf16x8& pa1, bf16x8& pa2, bf16x8& pa3) {
#pragma unroll
  for (int r = 0; r < 16; ++r) p1[r] = __builtin_amdgcn_exp2f(p1[r]);
  float ps = 0;
#pragma unroll
  for (int r = 0; r < 16; ++r) ps += p0[r];
#pragma unroll
  for (int r = 0; r < 16; ++r) ps += p1[r];
  { auto rr = __builtin_amdgcn_permlane32_swap(__float_as_uint(ps), __float_as_uint(ps), false, false);
    ps = __uint_as_float(rr[0]) + __uint_as_float(rr[1]); }
  l_reg = l_reg * alpha + ps;
#define PK4(P, B_, OUT) do { unsigned a0 = pk2a(P[B_+0], P[B_+1]), a1 = pk2a(P[B_+2], P[B_+3]);                          \
        unsigned b0 = pk2a(P[B_+4], P[B_+5]), b1 = pk2a(P[B_+6], P[B_+7]);                                             \
        auto r0 = __builtin_amdgcn_permlane32_swap(a0, b0, false, false); auto r1 = __builtin_amdgcn_permlane32_swap(a1, b1, false, false); \
        u32x4 w = {r0[0], r1[0], r0[1], r1[1]}; OUT = *reinterpret_cast<bf16x8*>(&w); } while (0)
  PK4(p0, 0, pa0); PK4(p0, 8, pa1); PK4(p1, 0, pa2); PK4(p1, 8, pa3);
#undef PK4
}
template <int KB>
DI void qkt(f32x16& p0, f32x16& p1, const LAS char* K_lds, const LAS float* tabk, int r32, int hi, const bf16x8* qr) {
#pragma unroll
  for (int g = 0; g < 4; ++g) { const f32x4 t0 = *(const LAS f32x4*)(tabk + 8 * g + 4 * hi), t1 = *(const LAS f32x4*)(tabk + 32 + 8 * g + 4 * hi);
#pragma unroll
    for (int e = 0; e < 4; ++e) { p0[4 * g + e] = t0[e]; p1[4 * g + e] = t1[e]; } }
  const LAS char* kb[4];
#pragma unroll
  for (int dd = 0; dd < 4; ++dd) kb[dd] = K_lds + KB * SHM_K + KSWZ(r32, (dd * 16 + hi * 8) * 2);
#pragma unroll
  for (int d0 = 0; d0 < 8; ++d0) { const LAS char* a = kb[d0 & 3] + (d0 >> 2) * 128;
    bf16x8 b0 = *(const LAS bf16x8*)(a);
    bf16x8 b1 = *(const LAS bf16x8*)(a + 32 * 256);
    p0 = __builtin_amdgcn_mfma_f32_32x32x16_bf16(b0, qr[d0], p0, 0, 0, 0);
    p1 = __builtin_amdgcn_mfma_f32_32x32x16_bf16(b1, qr[d0], p1, 0, 0, 0); }
}
template <int VB>
DI void pv_tile(f32x16* o, int vb0, bf16x8 pa0, bf16x8 pa1, bf16x8 pa2, bf16x8 pa3) {
#define TRRD(dst, off) asm volatile("ds_read_b64_tr_b16 %0, %1 offset:%2" : "=&v"(dst) : "v"(vb0), "i"(off) : "memory")
#define PV_D0(d0) do { s16x4 l0, l1, l2, l3, h0, h1, h2, h3; constexpr int b_ = VB * SHM_V + v_rd_off(d0, 0, 0); \
        TRRD(l0, b_); TRRD(h0, b_ + 2048); TRRD(l1, b_ + 4096); TRRD(h1, b_ + 6144); TRRD(l2, b_ + 8192); TRRD(h2, b_ + 10240); TRRD(l3, b_ + 12288); TRRD(h3, b_ + 14336); \
        asm volatile("s_waitcnt lgkmcnt(0)" ::: "memory"); SBAR();   \
        o[d0] = __builtin_amdgcn_mfma_f32_32x32x16_bf16(pa0, (bf16x8){l0[0], l0[1], l0[2], l0[3], h0[0], h0[1], h0[2], h0[3]}, o[d0], 0, 0, 0);   \
        o[d0] = __builtin_amdgcn_mfma_f32_32x32x16_bf16(pa1, (bf16x8){l1[0], l1[1], l1[2], l1[3], h1[0], h1[1], h1[2], h1[3]}, o[d0], 0, 0, 0);   \
        o[d0] = __builtin_amdgcn_mfma_f32_32x32x16_bf16(pa2, (bf16x8){l2[0], l2[1], l2[2], l2[3], h2[0], h2[1], h2[2], h2[3]}, o[d0], 0, 0, 0);   \
        o[d0] = __builtin_amdgcn_mfma_f32_32x32x16_bf16(pa3, (bf16x8){l3[0], l3[1], l3[2], l3[3], h3[0], h3[1], h3[2], h3[3]}, o[d0], 0, 0, 0); } while (0)
  PV_D0(0); PV_D0(1); PV_D0(2); PV_D0(3);
#undef PV_D0
#undef TRRD
}
struct BlockRef { const bf16_t* Q; const bf16_t* K; const bf16_t* V; bf16_t* O; const bf16_t* G; const float* lf; int P0, skv, nvalid, nkeys; };
struct Seam { bf16x8 qr[8]; bf16x8 st_v0, st_v1, st_k0, st_k1; };
constexpr int NFOX = 2048 + 128;
DI BlockRef fox_decode(const Params& P, int L) {
  unsigned char* ws = P.ws; BlockRef r;
  const bf16_t* FQ = (const bf16_t*)(ws + W_FQ); const bf16_t* FG = (const bf16_t*)(ws + W_FG); bf16_t* Y3 = (bf16_t*)(ws + W_Y3);
  if (L < 2048) { const int bh = L >> 3, qb = 7 - (L & 7), b = bh >> 4, h = bh & 15;
    const size_t row = (size_t)b * 2048 + qb * 256;
    r.lf = (const float*)(ws + W_LFT) + (size_t)bh * 2048; r.nkeys = 2048;
    r.Q = FQ + row * 2048 + h * 128; r.K = (const bf16_t*)(ws + W_FK) + (size_t)b * 2048 * 2048 + h * 128; r.V = (const bf16_t*)(ws + W_FV) + (size_t)b * 2048 * 2048 + h * 128;
    r.O = Y3 + row * 6144 + 2048 + h * 128; r.G = FG + row * 2048 + h * 128; r.P0 = qb * 256; r.skv = 2048; r.nvalid = 256;
  } else { const int j = L - 2048, b = j >> 4, h = j & 15;
    r.lf = (const float*)(ws + W_LFS) + (size_t)j * 1088; r.nkeys = 1088;
    const size_t row = (size_t)MP + b * 64;
    r.Q = FQ + row * 2048 + h * 128; r.K = (const bf16_t*)(ws + W_KS) + (size_t)b * 1088 * 2048 + h * 128; r.V = (const bf16_t*)(ws + W_VS) + (size_t)b * 1088 * 2048 + h * 128;
    r.O = Y3 + row * 6144 + 2048 + h * 128; r.G = FG + row * 2048 + h * 128; r.P0 = 1024; r.skv = 1088; r.nvalid = 64; }
  return r;
}

#define ROW(p, k0, rr) ((p) + (size_t)((k0) + 32 * (rr)) * LD + rowoff0)
#define VMW() asm volatile("s_waitcnt vmcnt(0)" ::: "memory")
#define VMWN(n) asm volatile("s_waitcnt vmcnt(%0)" :: "i"(n) : "memory")
#define SLOAD_H(Kp, Vp, k0) do { S.st_v0 = load8(ROW(Vp, k0, 0)); S.st_v1 = load8(ROW(Vp, k0, 1));              \
                         S.st_k0 = load8(ROW(Kp, k0, 0)); S.st_k1 = load8(ROW(Kp, k0, 1)); } while (0)
#define SWRITE_HK(bf) do { *(LAS bf16x8*)(K_lds + (bf) * SHM_K + kws) = S.st_k0; *(LAS bf16x8*)(K_lds + (bf) * SHM_K + kws + 32 * 256) = S.st_k1; } while (0)
#define SWRITE_HV(bf) do { *(LAS bf16x8*)(V_lds + (bf) * SHM_V + vst0) = S.st_v0; *(LAS bf16x8*)(V_lds + (bf) * SHM_V + vst0 + vst1d) = S.st_v1; } while (0)
#define SWRITE_H(bf) do { SWRITE_HV(bf); SWRITE_HK(bf); } while (0)
DI void fox_prime(const BlockRef& cur, LAS char* lds, Seam& S) {
  int tid = threadIdx.x; asm volatile("" : "+v"(tid));
  const int wid = __builtin_amdgcn_readfirstlane(tid >> 6), lane = tid & 63, r32 = lane & 31, hi = lane >> 5;
  const int sr = tid >> 4, sc = (tid & 15) * 8, kws = KSWZ(sr, sc * 2); LAS char* K_lds = lds + 2 * SHM_V;
  const unsigned rowoff0 = (unsigned)(sr * LD + sc);
  const unsigned qoff = (unsigned)((wid * QBLK + r32) * LD + hi * 8);
#pragma unroll
  for (int d0 = 0; d0 < 8; ++d0) S.qr[d0] = load8(cur.Q + qoff + d0 * 16);
  SLOAD_H(cur.K, cur.V, 0); VMW(); SWRITE_HK(0);
  __syncthreads();
}
DI void fox_block(const BlockRef& cur, int Ln, const Params& P, LAS char* lds, Seam& S) {
  int tid = threadIdx.x; asm volatile("" : "+v"(tid));
  const int wid = __builtin_amdgcn_readfirstlane(tid >> 6), lane = tid & 63, r32 = lane & 31, hi = lane >> 5;
  int j_hi = (cur.P0 + QB - 1) / KVBLK + 1; if (j_hi > cur.skv / KVBLK) j_hi = cur.skv / KVBLK;
  const int NT = j_hi;
  const int qlo = cur.P0 + wid * QBLK, qm = qlo + r32 - 4 * hi;
  LAS char* V_lds = lds; LAS char* K_lds = lds + 2 * SHM_V;
  LAS float* ws = (LAS float*)(lds + 2 * SHM_V + 2 * SHM_K) + wid * 64; LAS float* li_l = ws; LAS float* al_l = ws + 32;
  const LAS float* tab = (const LAS float*)(lds + TAB_OFF);
  float m_reg = -1e30f, l_reg = 0; f32x16 o[4] = {};
  const int sr = tid >> 4, sc = (tid & 15) * 8, vst0 = v_st(sr, sc), kws = KSWZ(sr, sc * 2);
  constexpr int vst1d = 8192;
  const unsigned rowoff0 = (unsigned)(sr * LD + sc);
  const int vb0 = (int)(uintptr_t)V_lds + v_rd_base(lane);
  const bf16_t* Kh = cur.K; const bf16_t* Vh = cur.V;
#define RESC(a) do { if (__any((a) < 1.f)) { if (hi == 0) al_l[r32] = (a); asm volatile("s_waitcnt lgkmcnt(0)" ::: "memory");              \
                     for (int d_ = 0; d_ < 4; ++d_) for (int r = 0; r < 16; ++r) o[d_][r] *= al_l[crow(r, hi)]; } } while (0)
#define KBASE(t) ((t) * KVBLK)
#define MASKT(P0_, P1_, t) do { const int kb_ = KBASE(t); if (kb_ + KVBLK - 1 > qlo) mask_tile(P0_, P1_, qm - kb_, WBIG); } while (0)
#define SEAM_K0() do { VMWN(8); SWRITE_HK(0); SBAR(); } while (0)
  f32x16 pA0, pA1, pB0, pB1; float mnA, mnB, alA, alB; bf16x8 pa0, pa1, pa2, pa3;
  SWRITE_HV(0); SBAR();
  if (NT > 1) { SLOAD_H(Kh, Vh, KBASE(1)); }
  SBAR(); qkt<0>(pA0, pA1, K_lds, tab + KBASE(0), r32, hi, S.qr);
  MASKT(pA0, pA1, 0); partialSM(pA0, pA1, m_reg, mnA, alA);
  if (NT > 1) { VMW(); SWRITE_H(1); }
  __syncthreads();
#define HALF_STEP(PX0, PX1, mnX, alX, PY0, PY1, alY, t, KB, VB, SB) do {                                                      \
        SBAR(); qkt<KB>(PX0, PX1, K_lds, tab + KBASE(t), r32, hi, S.qr);                                             \
        finishSM(PY0, PY1, alY, l_reg, pa0, pa1, pa2, pa3); SBAR();                                                           \
        if ((t) + 1 < NT) { SLOAD_H(Kh, Vh, KBASE((t) + 1)); SBAR(); }                                               \
        pv_tile<VB>(o, vb0, pa0, pa1, pa2, pa3); MASKT(PX0, PX1, (t)); partialSM(PX0, PX1, m_reg, mnX, alX);                                        \
        __syncthreads();                                                                                                      \
        if ((t) + 1 < NT) { VMW(); SWRITE_H(SB); }                                                                          \
        RESC(alX); __syncthreads(); } while (0)
  for (int t = 1; t + 1 < NT; t += 2) {
    HALF_STEP(pB0, pB1, mnB, alB, pA0, pA1, alA, t, 1, 0, 0);
    HALF_STEP(pA0, pA1, mnA, alA, pB0, pB1, alB, t + 1, 0, 1, 1);
  }
  const bool even = (NT & 1) == 0;
  if (even) { SBAR(); qkt<1>(pB0, pB1, K_lds, tab + KBASE(NT - 1), r32, hi, S.qr); SBAR(); }
  const BlockRef nxt = (Ln < NFOX) ? fox_decode(P, Ln) : cur;
  SLOAD_H(nxt.K, nxt.V, 0); SBAR();
  unsigned qoff; { int l2 = lane; asm volatile("" : "+v"(l2)); qoff = (unsigned)((wid * QBLK + (l2 & 31)) * LD + (l2 >> 5) * 8); }
#pragma unroll
  for (int d0 = 0; d0 < 8; ++d0) S.qr[d0] = load8(nxt.Q + qoff + d0 * 16);
  SBAR();
  finishSM(pA0, pA1, alA, l_reg, pa0, pa1, pa2, pa3); SBAR();
  pv_tile<0>(o, vb0, pa0, pa1, pa2, pa3);
  if (even) { MASKT(pB0, pB1, NT - 1); partialSM(pB0, pB1, m_reg, mnB, alB); __syncthreads(); RESC(alB);
    finishSM(pB0, pB1, alB, l_reg, pa0, pa1, pa2, pa3); SBAR(); pv_tile<1>(o, vb0, pa0, pa1, pa2, pa3); }
  SBAR(); SEAM_K0();
  if (hi == 0) li_l[r32] = l_reg; asm volatile("s_waitcnt lgkmcnt(0)" ::: "memory");
  { int lane_o = lane; asm volatile("" : "+v"(lane_o));
    LAS char* stg = lds + OSTG_OFF + wid * 8448;
    const int rw = lane_o >> 4, cw = (lane_o & 15) * 8; const int r32 = lane_o & 31, hi = lane_o >> 5;
#pragma unroll
    for (int half = 0; half < 2; ++half) {
#pragma unroll
      for (int rr = 0; rr < 8; ++rr) { const int r = half * 8 + rr; const int orow = crow(r, hi); const float rl = __builtin_amdgcn_rcpf(li_l[orow]);
#pragma unroll
        for (int d0 = 0; d0 < 4; ++d0) *(LAS float*)(stg + (orow - 16 * half) * 528 + (d0 * 32 + r32) * 4) = o[d0][r] * rl; }
      asm volatile("s_waitcnt lgkmcnt(0)" ::: "memory");
#pragma unroll
      for (int i = 0; i < 4; ++i) { const int lr = i * 4 + rw; const int brow = wid * QBLK + half * 16 + lr;
        const f32x4 v0 = *(const LAS f32x4*)(stg + lr * 528 + cw * 4), v1 = *(const LAS f32x4*)(stg + lr * 528 + cw * 4 + 16);
        const u32x4 gw = *(const u32x4*)(cur.G + (unsigned)(brow * LD + cw));
        u32x4 ow; ow[0] = pk2a(v0[0] * bflo(gw[0]), v0[1] * bfhi(gw[0])); ow[1] = pk2a(v0[2] * bflo(gw[1]), v0[3] * bfhi(gw[1]));
        ow[2] = pk2a(v1[0] * bflo(gw[2]), v1[1] * bfhi(gw[2])); ow[3] = pk2a(v1[2] * bflo(gw[3]), v1[3] * bfhi(gw[3]));
        if (brow < cur.nvalid) *(u32x4*)(cur.O + (unsigned)(brow * LDO + cw)) = ow; }
      asm volatile("s_waitcnt lgkmcnt(0)" ::: "memory");
    } }
  __syncthreads();
#undef RESC
#undef KBASE
#undef MASKT
#undef SEAM_K0
#undef HALF_STEP
}
#undef ROW
#undef VMW
#undef VMWN
#undef SLOAD_H
#undef SWRITE_HK
#undef SWRITE_HV
#undef SWRITE_H
DI void build_bias(const float* src, int nkeys, LAS char* lds) {
  LAS float* tab = (LAS float*)(lds + TAB_OFF); LAS float* wsum = tab + 2048;
  int tid = threadIdx.x; asm volatile("" : "+v"(tid));
  const int lane = tid & 63, wid = tid >> 6;
  f32x4 v = {0.f, 0.f, 0.f, 0.f}; if (tid * 4 < nkeys) v = *(const f32x4*)(src + tid * 4);
  const float s0 = v[0], s1 = s0 + v[1], s2 = s1 + v[2], s3 = s2 + v[3];
  float incl = s3;
#pragma unroll
  for (int o = 1; o < 64; o <<= 1) { const int sl = lane >= o ? lane - o : lane;
    const float t = __int_as_float(__builtin_amdgcn_ds_bpermute(sl * 4, __float_as_int(incl))); if (lane >= o) incl += t; }
  if (lane == 63) wsum[wid] = incl;
  __syncthreads();
  float off = incl - s3;
  for (int w = 0; w < wid; ++w) off += wsum[w];
  const float kk = -11.313708498984761f;
  f32x4 o = {(off + s0) * kk, (off + s1) * kk, (off + s2) * kk, (off + s3) * kk};
  *(LAS f32x4*)(tab + tid * 4) = o;
  __syncthreads();
}
}

DI int fetch_item(unsigned* ctr, LAS char* lds) {
  volatile LAS int* slot = (volatile LAS int*)(lds + LDS_BYTES - 64);
  __syncthreads();
  if (threadIdx.x == 0) *slot = (int)atomicAdd(ctr, 1u);
  __syncthreads();
  return __builtin_amdgcn_readfirstlane(*slot);
}


DI void conv_pass(const Params& P) {
  unsigned char* ws = P.ws;
  int tid = threadIdx.x; asm volatile("" : "+v"(tid));
  const float* wconv = P.in[12]; const float* bconv = P.in[13];
  bf16_t* XCT = (bf16_t*)(ws + W_XCT); bf16_t* BCN = (bf16_t*)(ws + W_BCN); bf16_t* BTT = (bf16_t*)(ws + W_BTT);
  const int lane = tid & 63, wv = blockIdx.x * 8 + (tid >> 6), NWV = gridDim.x * 8;
  const int tg = lane & 7, ccl = lane >> 3;
  for (int it = wv; it < 520 * 48; it += NWV) {
    const int cidx = it / 48, ccg = it - cidx * 48; const int cc = ccg * 8 + ccl; const int ch = cc * 8;
    const bool sample = cidx >= 512; const int b = sample ? cidx - 512 : cidx >> 5, c = sample ? 0 : cidx & 31;
    const bf16_t* xbc = sample ? (const bf16_t*)(ws + W_XBCS) + (size_t)b * 67 * 3072 : (const bf16_t*)(ws + W_XBCP) + (size_t)b * 2051 * 3072;
    const size_t rowbase = sample ? (size_t)MP + b * 64 : (size_t)b * 2048;
    const int t0 = c * 64 + tg * 8;
    u32x4 raw[11];
#pragma unroll
    for (int j = 0; j < 11; ++j) raw[j] = *(const u32x4*)(xbc + (size_t)(t0 + j) * 3072 + ch);
    f32x4 wv4[4][2], bv[2];
#pragma unroll
    for (int i = 0; i < 4; ++i) { wv4[i][0] = *(const f32x4*)(wconv + i * 3072 + ch); wv4[i][1] = *(const f32x4*)(wconv + i * 3072 + ch + 4); }
    bv[0] = *(const f32x4*)(bconv + ch); bv[1] = *(const f32x4*)(bconv + ch + 4);
    unsigned op[8][4];
    u32x4 on[8];
    float prev[8];
#pragma unroll
    for (int j = 0; j < 8; ++j) {
      float o[8];
#pragma unroll
      for (int e = 0; e < 8; ++e) { float a = bv[e >> 2][e & 3];
#pragma unroll
        for (int i = 0; i < 4; ++i) { const unsigned w = raw[j + i][e >> 1]; const float xv = (e & 1) ? bfhi(w) : bflo(w); a += wv4[i][e >> 2][e & 3] * xv; }
        o[e] = siluf_(a); }
      on[j][0] = pk2(o[0], o[1]); on[j][1] = pk2(o[2], o[3]); on[j][2] = pk2(o[4], o[5]); on[j][3] = pk2(o[6], o[7]);
      if (j & 1) {
#pragma unroll
        for (int e = 0; e < 8; ++e) op[e][j >> 1] = pk2(prev[e], o[e]);
      } else {
#pragma unroll
        for (int e = 0; e < 8; ++e) prev[e] = o[e];
      }
    }
    if (ch < 2048) { const int h = ch >> 6, p0 = ch & 63;
      bf16_t* dst = XCT + ((size_t)(cidx * 32 + h) * 64 + p0) * 64 + tg * 8;
#pragma unroll
      for (int e = 0; e < 8; ++e) { u32x4 w = {op[e][0], op[e][1], op[e][2], op[e][3]}; *(u32x4*)(dst + e * 64) = w; }
    } else {
      const int cb = ch - 2048;
      bf16_t* dn = BCN + (rowbase + t0) * 1024 + cb;
#pragma unroll
      for (int j = 0; j < 8; ++j) *(u32x4*)(dn + (size_t)j * 1024) = on[j];
      if (cb < 512) { const int g = cb >> 7, n0 = cb & 127;
        bf16_t* dt_ = BTT + ((size_t)(cidx * 4 + g) * 128 + n0) * 64 + tg * 8;
#pragma unroll
        for (int e = 0; e < 8; ++e) { u32x4 w = {op[e][0], op[e][1], op[e][2], op[e][3]}; *(u32x4*)(dt_ + e * 64) = w; }
      }
    }
  }
}

DI void ssd_item(const Params& P, LAS unsigned char* lds, int item) {
  unsigned char* ws = P.ws;
  int tid = threadIdx.x; asm volatile("" : "+v"(tid));
  const int wid = __builtin_amdgcn_readfirstlane(tid >> 6), lane = tid & 63, r16 = lane & 15, q = lane >> 4;
  const bool sample = item >= 128; const int i2 = sample ? item - 128 : item; const int b = i2 >> 3, g = (i2 >> 1) & 3, hh = i2 & 1;
  const int nch = sample ? 1 : 32;
  const size_t rowbase = sample ? (size_t)MP + b * 64 : (size_t)b * 2048;
  const int h = g * 8 + hh * 4 + (wid >> 1), ph = wid & 1, pb = ph * 32;
  const float A_h = -__expf(P.in[15][h]), dsk = P.in[16][h];
  const float* DT = (const float*)(ws + W_DT); const bf16_t* ZB = (const bf16_t*)(ws + W_ZB); bf16_t* Y3 = (bf16_t*)(ws + W_Y3); float* SSQP = (float*)(ws + W_SSQP);
  LAS unsigned char* Bs = lds; LAS unsigned char* Cs = lds + 17408; LAS unsigned char* BT = lds + 34816;
  LAS unsigned char* XT = lds + 53248 + wid * 4608;
  LAS float* acum_l = (LAS float*)(lds + 90112 + wid * 768); LAS float* dtv_l = acum_l + 64; LAS float* wend_l = acum_l + 128;
  f32x4 hT[8][2];
#pragma unroll
  for (int nt = 0; nt < 8; ++nt)
#pragma unroll
    for (int pt = 0; pt < 2; ++pt) {
      if (sample) hT[nt][pt] = *(const f32x4*)(P.in[6] + ((size_t)(b * 32 + h) * 64 + pb + pt * 16 + r16) * 128 + nt * 16 + 4 * q);
      else hT[nt][pt] = (f32x4){0.f, 0.f, 0.f, 0.f};
    }
  const bf16_t* XCT = (const bf16_t*)(ws + W_XCT); const bf16_t* BCN = (const bf16_t*)(ws + W_BCN); const bf16_t* BTT = (const bf16_t*)(ws + W_BTT);
  float dtl; u32x4 rx[4], rb[2], rc[2], rt[2];
#define SSD_LOAD(c_) do { const int t0_ = (c_) * 64; const int cidx_ = sample ? 512 + b : b * 32 + (c_);                         \
    dtl = DT[(rowbase + t0_ + lane) * 32 + h];                                                                                  \
    const bf16_t* xs_ = XCT + ((size_t)(cidx_ * 32 + h) * 64 + pb) * 64;                                                        \
    _Pragma("unroll") for (int j = 0; j < 4; ++j) rx[j] = *(const u32x4*)(xs_ + (j * 64 + lane) * 8);                           \
    const bf16_t* bts_ = BTT + (size_t)(cidx_ * 4 + g) * 8192;                                                                  \
    _Pragma("unroll") for (int j = 0; j < 2; ++j) { const int id = tid + 512 * j; const int s = id >> 4, k = id & 15;           \
      rb[j] = *(const u32x4*)(BCN + (rowbase + t0_ + s) * 1024 + g * 128 + k * 8);                                              \
      rc[j] = *(const u32x4*)(BCN + (rowbase + t0_ + s) * 1024 + 512 + g * 128 + k * 8);                                        \
      rt[j] = *(const u32x4*)(bts_ + id * 8); } } while (0)
  SSD_LOAD(0);
  for (int c = 0; c < nch; ++c) {
    const int t0 = c * 64;
    float cdec;
    { float ac = dtl * A_h;
#pragma unroll
      for (int o = 1; o < 64; o <<= 1) { const float t = __shfl_up(ac, o); if (lane >= o) ac += t; }
      const float tot = __shfl(ac, 63);
      acum_l[lane] = ac; dtv_l[lane] = dtl; wend_l[lane] = __expf(tot - ac) * dtl; cdec = __expf(tot); }
#pragma unroll
    for (int j = 0; j < 4; ++j) { const int e8 = j * 64 + lane; *(LAS u32x4*)(XT + (e8 >> 3) * 144 + (e8 & 7) * 16) = rx[j]; }
    __syncthreads();
#pragma unroll
    for (int j = 0; j < 2; ++j) { const int id = tid + 512 * j;
      *(LAS u32x4*)(Bs + (id >> 4) * 272 + (id & 15) * 16) = rb[j];
      *(LAS u32x4*)(Cs + (id >> 4) * 272 + (id & 15) * 16) = rc[j];
      *(LAS u32x4*)(BT + (id >> 3) * 144 + (id & 7) * 16) = rt[j]; }
    __syncthreads();
    if (c + 1 < nch) SSD_LOAD(c + 1);
    u32x2 znext[2];
#pragma unroll
    for (int pt = 0; pt < 2; ++pt) znext[pt] = *(const u32x2*)(ZB + (rowbase + t0 + r16) * 2048 + h * 64 + pb + pt * 16 + 4 * q);
#pragma unroll
    for (int lt = 0; lt < 4; ++lt) {
      const int l = lt * 16 + r16;
      const size_t row = rowbase + t0 + l;
      u32x2 zraw[2];
#pragma unroll
      for (int pt = 0; pt < 2; ++pt) zraw[pt] = znext[pt];
      { const int ln = (lt < 3 ? lt + 1 : 3) * 16 + r16;
#pragma unroll
        for (int pt = 0; pt < 2; ++pt) znext[pt] = *(const u32x2*)(ZB + (rowbase + t0 + ln) * 2048 + h * 64 + pb + pt * 16 + 4 * q); }
      f32x4 y[2];
#pragma unroll
      for (int pt = 0; pt < 2; ++pt) y[pt] = (f32x4){0.f, 0.f, 0.f, 0.f};
#pragma unroll
      for (int np = 0; np < 4; ++np) {
        const u32x2 clo = *(const LAS u32x2*)(Cs + l * 272 + (32 * np + 4 * q) * 2), chi = *(const LAS u32x2*)(Cs + l * 272 + (32 * np + 16 + 4 * q) * 2);
        const bf16x8 bfrag = cat8(clo, chi);
#pragma unroll
        for (int pt = 0; pt < 2; ++pt) y[pt] = MFMA16(pack8a(hT[2 * np][pt], hT[2 * np + 1][pt]), bfrag, y[pt]);
      }
      const float al = acum_l[l]; const float el = __expf(al);
#pragma unroll
      for (int pt = 0; pt < 2; ++pt) y[pt] *= el;
      const int nsp = (lt >> 1) + 1;
#pragma unroll
      for (int sp = 0; sp < nsp; ++sp) {
        f32x4 cb0 = {0.f, 0.f, 0.f, 0.f}, cb1 = {0.f, 0.f, 0.f, 0.f};
#pragma unroll
        for (int ks = 0; ks < 4; ++ks) {
          const bf16x8 cf = *(const LAS bf16x8*)(Cs + l * 272 + (32 * ks + 8 * q) * 2);
          const bf16x8 b0 = *(const LAS bf16x8*)(Bs + (32 * sp + r16) * 272 + (32 * ks + 8 * q) * 2);
          const bf16x8 b1 = *(const LAS bf16x8*)(Bs + (32 * sp + 16 + r16) * 272 + (32 * ks + 8 * q) * 2);
          cb0 = MFMA16(b0, cf, cb0); cb1 = MFMA16(b1, cf, cb1);
        }
        const int s0 = 32 * sp + 4 * q, s1 = s0 + 16;
        const f32x4 as0 = *(const LAS f32x4*)(acum_l + s0), as1 = *(const LAS f32x4*)(acum_l + s1);
        const f32x4 d0 = *(const LAS f32x4*)(dtv_l + s0), d1 = *(const LAS f32x4*)(dtv_l + s1);
        f32x4 m0, m1;
#pragma unroll
        for (int e = 0; e < 4; ++e) {
          m0[e] = (s0 + e <= l) ? cb0[e] * __expf(al - as0[e]) * d0[e] : 0.f;
          m1[e] = (s1 + e <= l) ? cb1[e] * __expf(al - as1[e]) * d1[e] : 0.f;
        }
        const bf16x8 mfrag = pack8a(m0, m1);
#pragma unroll
        for (int pt = 0; pt < 2; ++pt) { const int p = pt * 16 + r16;
          const u32x2 xlo = *(const LAS u32x2*)(XT + p * 144 + s0 * 2), xhi = *(const LAS u32x2*)(XT + p * 144 + s1 * 2);
          y[pt] = MFMA16(cat8(xlo, xhi), mfrag, y[pt]); }
      }
      float ssq = 0.f;
#pragma unroll
      for (int pt = 0; pt < 2; ++pt) { const int p0 = pt * 16 + 4 * q;
        const f32x4 zz = {bflo(zraw[pt][0]), bfhi(zraw[pt][0]), bflo(zraw[pt][1]), bfhi(zraw[pt][1])};
        f32x4 v;
#pragma unroll
        for (int e = 0; e < 4; ++e) { const float xv = bf2f(*(const LAS bf16_t*)(XT + (p0 + e) * 144 + l * 2));
          v[e] = (y[pt][e] + dsk * xv) * zz[e]; ssq += v[e] * v[e]; }
        st_bf4a(Y3 + row * 6144 + h * 64 + pb + p0, v); }
      ssq += __shfl_xor(ssq, 16); ssq += __shfl_xor(ssq, 32);
      if (q == 0) SSQP[row * 64 + h * 2 + ph] = ssq;
    }
#pragma unroll
    for (int nt = 0; nt < 8; ++nt)
#pragma unroll
      for (int pt = 0; pt < 2; ++pt) hT[nt][pt] *= cdec;
#pragma unroll
    for (int ks = 0; ks < 2; ++ks) {
      bf16x8 bfr[2];
      const f32x4 w0 = *(const LAS f32x4*)(wend_l + 32 * ks + 8 * q), w1 = *(const LAS f32x4*)(wend_l + 32 * ks + 8 * q + 4);
#pragma unroll
      for (int pt = 0; pt < 2; ++pt) { const int p = pt * 16 + r16;
        const u32x4 xr = *(const LAS u32x4*)(XT + p * 144 + (32 * ks + 8 * q) * 2);
        const f32x4 a = {bflo(xr[0]) * w0[0], bfhi(xr[0]) * w0[1], bflo(xr[1]) * w0[2], bfhi(xr[1]) * w0[3]};
        const f32x4 bq = {bflo(xr[2]) * w1[0], bfhi(xr[2]) * w1[1], bflo(xr[3]) * w1[2], bfhi(xr[3]) * w1[3]};
        bfr[pt] = pack8a(a, bq); }
#pragma unroll
      for (int nt = 0; nt < 8; ++nt) { const bf16x8 af = *(const LAS bf16x8*)(BT + (nt * 16 + r16) * 144 + (32 * ks + 8 * q) * 2);
#pragma unroll
        for (int pt = 0; pt < 2; ++pt) hT[nt][pt] = MFMA16(af, bfr[pt], hT[nt][pt]); }
    }
  }
#undef SSD_LOAD
  float* so = P.out + (sample ? O_SSDS : O_SSDP) + (size_t)(b * 32 + h) * 8192;
#pragma unroll
  for (int nt = 0; nt < 8; ++nt)
#pragma unroll
    for (int pt = 0; pt < 2; ++pt) *(f32x4*)(so + (size_t)(pb + pt * 16 + r16) * 128 + nt * 16 + 4 * q) = hT[nt][pt];
  __syncthreads();
}

__global__ __launch_bounds__(512) void mk_forward(Params Parg) {
#if defined(__HIP_DEVICE_COMPILE__)
  extern __shared__ __attribute__((aligned(16))) unsigned char lds_raw[];
  LAS unsigned char* lds = (LAS unsigned char*)lds_raw;
  cg::grid_group grid = cg::this_grid();
  const int G = gridDim.x, cblk = blockIdx.x;
  typedef __attribute__((address_space(4))) const Params* KP;
  const KP kp = (KP)__builtin_amdgcn_kernarg_segment_ptr();
#define PHASE_PARAMS() KP kq_ = kp; asm volatile("" : "+s"(kq_)); const Params P = *kq_; unsigned char* ws = P.ws; (void)ws
#ifndef PH
#define PH 255
#endif
#ifndef DUPMASK
#define DUPMASK 0
#endif
  for (int rep0_ = 0; rep0_ < ((DUPMASK & 1) ? 2 : 1); ++rep0_)
  if (PH & 1) { PHASE_PARAMS(); phase0(P, lds); }
  grid.sync();
  for (int rep_ = 0; rep_ < ((DUPMASK & 2) ? 2 : 1); ++rep_)
  if (PH & 2) { PHASE_PARAMS();
    SchedP1 S; S.c = cblk; S.G = G; S.XB = (const char*)(ws + W_XB); S.WIN = (const char*)(ws + W_WIN); S.MB = (const char*)(ws + W_MB); S.WMEM = (const char*)(ws + W_WMEM);
    EpiIn E; E.P = P; E.ldsb = lds; pg8::Gemm g; g.lda = 2048; g.ldb = 2048; g.K = 2048; g.delay = 0;
    pg8::gemm_phase(lds, g, S, E);
    if (cblk >= 58) p1_tail_convert(P, cblk - 58, 198); }
  grid.sync();
  { PHASE_PARAMS(); conv_pass(P); }
  grid.sync();
  for (int rep_ = 0; rep_ < 1; ++rep_) {
  if (cblk < 128) { PHASE_PARAMS(); ssd_item(P, lds, cblk); }
  else { PHASE_PARAMS();
    if (cblk < 192) ssd_item(P, lds, cblk);
    SchedS S; S.c = cblk - 128; S.G = 128; S.MQ = (const char*)(ws + W_MQ); S.MKP = (const char*)(ws + W_MKP); S.MKS = (const char*)(ws + W_MKS);
    EpiS E; E.P = P; pg8::Gemm g; g.lda = 2048; g.ldb = 2048; g.K = 512; g.delay = 0;
    pg8::gemm_phase(lds, g, S, E); }
  if (PH & 16) { PHASE_PARAMS(); unsigned* ctl = (unsigned*)(ws + W_CTL) + rep_ * 32;
    LAS char* l8 = (LAS char*)lds_raw;
    int L = fetch_item(ctl + 16, l8);
    if (L < fa::NFOX) {
      fa::BlockRef cur = fa::fox_decode(P, L);
      fa::Seam S;
      fa::build_bias(cur.lf, cur.nkeys, l8);
      fa::fox_prime(cur, l8, S);
      for (;;) {
        const int Ln = fetch_item(ctl + 16, l8);
        fa::fox_block(cur, Ln, P, l8, S);
        if (Ln >= fa::NFOX) break;
        cur = fa::fox_decode(P, Ln);
        fa::build_bias(cur.lf, cur.nkeys, l8);
      }
    }
  }
  }
  grid.sync();
  for (int rep3_ = 0; rep3_ < ((DUPMASK & 32) ? 2 : 1); ++rep3_)
  if (PH & 32) { PHASE_PARAMS();
    { const float* SSQP = (const float*)(ws + W_SSQP); float* RS = (float*)(ws + W_RS);
      int tid = threadIdx.x; asm volatile("" : "+v"(tid));
      for (int r = cblk * 512 + tid; r < MT; r += G * 512) { float s = 0.f;
#pragma unroll
        for (int j = 0; j < 16; ++j) { const f32x4 v = *(const f32x4*)(SSQP + (size_t)r * 64 + 4 * j); s += (v[0] + v[1]) + (v[2] + v[3]); }
        RS[r] = rsqrtf(s * (1.f / 2048.f) + EPS); } }
    SchedPV S; S.c = cblk; S.G = G; S.PM = (const char*)(ws + W_PM); S.VTP = (const char*)(ws + W_VTP); S.VTS = (const char*)(ws + W_VTS);
    EpiPV E; E.P = P; pg8::Gemm g; g.lda = 1024; g.ldb = 256; g.K = 256; g.delay = 0;
    pg8::gemm_phase(lds, g, S, E); }
  grid.sync();
  for (int rep4_ = 0; rep4_ < ((DUPMASK & 64) ? 2 : 1); ++rep4_)
  if (PH & 64) { PHASE_PARAMS();
    SchedMerge S; S.c = cblk; S.G = G; S.A = (const char*)(ws + W_Y3); S.B = (const char*)(ws + W_WO);
    EpiMerge E; E.P = P; pg8::Gemm g; g.lda = 6144; g.ldb = 6144; g.K = 2048; g.delay = 0;
    pg8::gemm_phase(lds, g, S, E); }
  grid.sync();
  { PHASE_PARAMS(); const float* PARTM = (const float*)(ws + W_PARTM); bf16_t* MRG = (bf16_t*)(ws + W_MRG);
    int tid = threadIdx.x; asm volatile("" : "+v"(tid));
    for (int i = cblk * 512 + tid; i < MS * 2048 / 4; i += G * 512) {
      const f32x4 a = *(const f32x4*)(PARTM + (size_t)i * 4), b2 = *(const f32x4*)(PARTM + (size_t)MS * 2048 + (size_t)i * 4), c2 = *(const f32x4*)(PARTM + (size_t)2 * MS * 2048 + (size_t)i * 4);
      st_bf4(MRG + (size_t)MP * 2048 + (size_t)i * 4, a + b2 + c2); } }
  grid.sync();
  if (PH & 128) { PHASE_PARAMS();
    { SchedOutS S; S.c = cblk; S.A = (const char*)(ws + W_MRG); S.B = (const char*)(ws + W_WOUT);
      EpiOut E; E.P = P; pg8::Gemm g; g.lda = 2048; g.ldb = 2048; g.K = 512; g.delay = 0;
      pg8::gemm_phase(lds, g, S, E); }
    { SchedOutP S; S.c = cblk; S.A = (const char*)(ws + W_MRG); S.B = (const char*)(ws + W_WOUT);
      EpiOut E; E.P = P; pg8::Gemm g; g.lda = 2048; g.ldb = 2048; g.K = 2048; g.delay = 0;
      pg8::gemm_phase(lds, g, S, E); } }
  grid.sync();
  { PHASE_PARAMS();
    const float* PARTO = (const float*)(ws + W_PARTO); const float* gf = P.in[25];
    int tid = threadIdx.x; asm volatile("" : "+v"(tid)); const int wid = tid >> 6, lane = tid & 63;
    for (int r = cblk * 8 + wid; r < MT; r += G * 8) {
      f32x4* y = (f32x4*)(P.out + (size_t)r * 2048) + lane; const f32x4* gv = (const f32x4*)gf + lane;
      if (r < MP) {
        const float pv = lane < 32 ? PARTO[(size_t)r * 32 + lane] : 0.f;
        const float sc = rsqrtf(wave_sum(pv) * (1.f / 2048.f) + EPS);
#pragma unroll
        for (int j = 0; j < 8; ++j) { f32x4 v = y[64 * j]; const f32x4 gg = gv[64 * j]; y[64 * j] = v * sc * gg; }
      } else {
        const int rs = r - MP; const f32x4* xr = (const f32x4*)(P.in[1] + (size_t)rs * 2048) + lane;
        const f32x4* p5 = (const f32x4*)((const float*)(ws + W_PART5) + (size_t)rs * 2048) + lane;
        f32x4 v[8]; float ss = 0.f;
#pragma unroll
        for (int j = 0; j < 8; ++j) { v[j] = xr[64 * j];
#pragma unroll
          for (int kq = 0; kq < 4; ++kq) v[j] += p5[(size_t)kq * MS * 512 + 64 * j];
          ss += (v[j][0] * v[j][0] + v[j][1] * v[j][1]) + (v[j][2] * v[j][2] + v[j][3] * v[j][3]); }
        const float sc = rsqrtf(wave_sum(ss) * (1.f / 2048.f) + EPS);
#pragma unroll
        for (int j = 0; j < 8; ++j) y[64 * j] = v[j] * sc * gv[64 * j];
      }
    } }
#endif
}

extern "C" void kernel_launch(void* const* d_in, const int* in_sizes, int n_in,
                              void* d_out, int out_size, void* d_ws, size_t ws_size,
                              hipStream_t stream) {
  static int grid = 0;
  if (grid == 0) {
    int dev = 0, cus = 0, per_cu = 0;
    (void)hipGetDevice(&dev);
    (void)hipDeviceGetAttribute(&cus, hipDeviceAttributeMultiprocessorCount, dev);
    (void)hipFuncSetAttribute((const void*)mk_forward, hipFuncAttributeMaxDynamicSharedMemorySize, LDS_BYTES);
    (void)hipOccupancyMaxActiveBlocksPerMultiprocessor(&per_cu, (const void*)mk_forward, 512, LDS_BYTES);
    if (per_cu < 1) per_cu = 1;
    grid = cus * per_cu;
    if (ws_size < W_END) { fprintf(stderr, "workspace too small: %zu < %zu\n", ws_size, (size_t)W_END); grid = -1; }
  }
  if (grid < 0) return;
  Params p{};
  for (int i = 0; i < 26; ++i) p.in[i] = (const float*)d_in[i];
  p.out = (float*)d_out; p.ws = (unsigned char*)d_ws;
  void* args[] = {&p};
  hipError_t e = hipLaunchCooperativeKernel((const void*)mk_forward, dim3(grid), dim3(512), args, LDS_BYTES, stream);
  if (e != hipSuccess) fprintf(stderr, "cooperative launch failed: %s (grid %d)\n", hipGetErrorString(e), grid);
}
```
